# Optimizing an MI355X kernel written in HIP

```python
import math
import jax
import jax.numpy as jnp
from jax import lax
import numpy as np

D_MODEL = 1024
BATCH = 2
SEQ = 8192
DEPTH = 2

GRID_W = 64
CTX_LEN = 256
EPS = 1e-6
HG_HEADS = 4
HG_DK = 128
HG_DV = 128
HG_W = HG_HEADS * HG_DK
HG_VW = HG_HEADS * HG_DV
HG_CHUNK = 64
NA_HEADS = 8
NA_HD = 64
NA_W = NA_HEADS * NA_HD
NA_WIN_R = 8
NA_WIN_C = 16
ROPE_THETA = 10000.0
HY_W = 512
HY_BANDS = 16
HY_PE_DIM = 1 + 2 * HY_BANDS
HY_FILT_HID = 64
HY_FAST_DECAY = 0.3
HY_SLOW_DECAY = 1.5
HY_TARGET = 1e-2
OFF_FF = 0
OFF_FB = OFF_FF + HG_W
OFF_I = OFF_FB + HG_W
OFF_NK = OFF_I + HG_VW
OFF_NV = OFF_NK + NA_W
OFF_HQ = OFF_NV + NA_W
OFF_NQ = OFF_HQ + HG_W
OFF_HG = OFF_NQ + NA_W
OFF_HY = OFF_HG + HG_VW
OFF_GATE = OFF_HY + 3 * HY_W
IN_COLS = OFF_GATE + 3 * D_MODEL
CTX_STATE_COLS = OFF_HQ
N_EXPERTS = 16
EC_CAP_FACTOR = 2
D_FF_EXPERT = 2816

kernel_name = 'hybrid_hgrn2_natten_hyena_ec_block'

f32 = jnp.float32


def _rms(x):
    xf = x.astype(f32)
    return (xf * lax.rsqrt(jnp.mean(xf * xf, axis=-1, keepdims=True) + EPS)).astype(x.dtype)


def rms_norm(x, g):
    return _rms(x) * g


def modulate(x, g, shift, scale):
    return rms_norm(x, g) * (1 + scale) + shift


def heads(t, h):
    return t.reshape(t.shape[0], t.shape[1], h, -1)


def rev(t):
    return jnp.flip(t, axis=1)


def log_forget(z, lower):
    return jnp.logaddexp(jnp.log(lower), jnp.log1p(-lower) + jax.nn.log_sigmoid(z.astype(f32)))


def gla_chunk_scan(logf, v, s0, q=None):
    B, N, H, _ = logf.shape
    n = N // HG_CHUNK

    def blocks(t):
        return t.reshape(B, n, HG_CHUNK, H, t.shape[-1]).transpose(1, 0, 3, 2, 4)

    incl = jnp.tril(jnp.ones((HG_CHUNK, HG_CHUNK), bool))[:, :, None]

    def step(S, blk):
        lf, vc = blk[0], blk[1]
        b = jnp.cumsum(lf, axis=2)
        kc = -jnp.expm1(lf)
        b_end = b[:, :, -1:, :]
        S_new = (jnp.exp(b_end[:, :, 0])[..., None] * S
                 + jnp.einsum('bhsk,bhsv->bhkv', kc * jnp.exp(b_end - b), vc))
        if q is None:
            return S_new, None
        qc = blk[2]
        o = jnp.einsum('bhtk,bhkv->bhtv', qc * jnp.exp(b), S)
        diff = jnp.where(incl, b[:, :, :, None, :] - b[:, :, None, :, :], -jnp.inf)
        att = jnp.einsum('bhtk,bhsk,bhtsk->bhts', qc, kc, jnp.exp(diff))
        o = o + jnp.einsum('bhts,bhsv->bhtv', att, vc)
        return S_new, o

    xs = (blocks(logf), blocks(v)) if q is None else (blocks(logf), blocks(v), blocks(q))
    S, o = lax.scan(step, s0, xs)
    if q is None:
        return None, S
    return o.transpose(1, 0, 3, 2, 4).reshape(B, N, H, v.shape[-1]), S


def hgrn2_readout(o, g, w):
    B, N = o.shape[:2]
    o = _rms(o).reshape(B, N, -1).astype(g.dtype)
    return (o * jax.nn.silu(g)) @ w


def _rope_1d(x, pos):
    n = x.shape[-1] // 2
    inv = ROPE_THETA ** (-jnp.arange(n, dtype=f32) / n)
    ang = pos.astype(f32)[:, None] * inv
    cos = jnp.cos(ang)[None, :, None, :].astype(x.dtype)
    sin = jnp.sin(ang)[None, :, None, :].astype(x.dtype)
    a, b = x[..., :n], x[..., n:]
    return jnp.concatenate([a * cos - b * sin, a * sin + b * cos], axis=-1)


def axial_rope(x, row_pos, col_pos):
    half = x.shape[-1] // 2
    return jnp.concatenate([_rope_1d(x[..., :half], row_pos), _rope_1d(x[..., half:], col_pos)], axis=-1)


def neighbourhood_attention(q, q_rot, k_rot, v, k_ctx, v_ctx, rpb):
    B, L, H, d = q.shape
    rows = L // GRID_W
    wr = min(NA_WIN_R, rows)
    scale = d ** -0.5

    def grid(t):
        return t.reshape(B, rows, GRID_W, H, d)

    qg, qrg, krg, vg = grid(q), grid(q_rot), grid(k_rot), grid(v)
    col = jnp.arange(GRID_W)
    col_idx = jnp.clip(col - NA_WIN_C // 2, 0, GRID_W - NA_WIN_C)[:, None] + jnp.arange(NA_WIN_C)
    dc = col_idx - col[:, None] + (NA_WIN_C - 1)

    def row_block(r):
        rs = jnp.clip(r - wr // 2, 0, rows - wr)
        q_r = lax.dynamic_index_in_dim(qrg, r, axis=1, keepdims=False)
        q_p = lax.dynamic_index_in_dim(qg, r, axis=1, keepdims=False)
        k_win = lax.dynamic_slice_in_dim(krg, rs, wr, axis=1)[:, :, col_idx]
        v_win = lax.dynamic_slice_in_dim(vg, rs, wr, axis=1)[:, :, col_idx]
        dr = rs + jnp.arange(wr) - r + (NA_WIN_R - 1)
        bias = rpb[:, dr[:, None, None], dc[None]].transpose(0, 2, 1, 3)
        s_win = jnp.einsum('bqhd,brqjhd->bhqrj', q_r, k_win).astype(f32) * scale + bias
        s_ctx = jnp.einsum('bqhd,bnhd->bhqn', q_p, k_ctx).astype(f32) * scale
        s = jnp.concatenate([s_win.reshape(B, H, GRID_W, wr * NA_WIN_C), s_ctx], axis=-1)
        p = jax.nn.softmax(s, axis=-1).astype(v.dtype)
        p_win = p[..., :wr * NA_WIN_C].reshape(B, H, GRID_W, wr, NA_WIN_C)
        return (jnp.einsum('bhqrj,brqjhd->bqhd', p_win, v_win)
                + jnp.einsum('bhqn,bnhd->bqhd', p[..., wr * NA_WIN_C:], v_ctx))

    o = lax.map(row_block, jnp.arange(rows))
    return o.transpose(1, 0, 2, 3, 4).reshape(B, L, H * d)


def context_attention(q, k, v):
    B, N, H, d = q.shape
    s = jnp.einsum('bqhd,bkhd->bhqk', q, k).astype(f32) * (d ** -0.5)
    p = jax.nn.softmax(s, axis=-1).astype(v.dtype)
    return jnp.einsum('bhqk,bkhd->bqhd', p, v).reshape(B, N, H * d)


def short_conv3(u, w, b):
    up = jnp.pad(u, ((0, 0), (1, 1), (0, 0)))
    return up[:, :-2] * w[0] + up[:, 1:-1] * w[1] + up[:, 2:] * w[2] + b


def implicit_filter(n, w1, b1, fr1, w2, b2, fr2, w3):
    t = jnp.linspace(0.0, 1.0, n, dtype=f32)[:, None]
    w = 2 * math.pi * jnp.arange(n, dtype=f32)[:, None] / n
    f = jnp.linspace(1e-4, HY_BANDS - 1, HY_BANDS, dtype=f32)[None]
    z = jnp.concatenate([t, jnp.cos(f * w), -jnp.sin(f * w)], axis=-1)
    h = jnp.sin(fr1.astype(f32) * (z @ w1.astype(f32) + b1.astype(f32)))
    h = jnp.sin(fr2.astype(f32) * (h @ w2.astype(f32) + b2.astype(f32)))
    h = h @ w3.astype(f32)
    deltas = jnp.abs(jnp.linspace(math.log(HY_TARGET) / HY_SLOW_DECAY, math.log(HY_TARGET) / HY_FAST_DECAY,
                                  2 * HY_W, dtype=f32))
    return h * jnp.exp(-t * deltas)


def bidir_fft_conv(u, h, skip):
    n, C = u.shape[1], u.shape[-1]
    hf, hb = h[:, :C], h[:, C:]
    k = jnp.concatenate([hf, jnp.zeros((1, C), f32), hb[:0:-1]], axis=0)
    k = k / jnp.sum(jnp.abs(k), axis=0, keepdims=True)
    uf = u.astype(f32)
    y = jnp.fft.irfft(jnp.fft.rfft(uf, n=2 * n, axis=1) * jnp.fft.rfft(k, axis=0)[None], n=2 * n, axis=1)[:, :n]
    return (y + uf * skip.astype(f32)).astype(u.dtype)


def hyena_operator(p, conv_w, conv_b, filt, skip):
    u = short_conv3(p, conv_w, conv_b)
    x0, x1, v = jnp.split(u, 3, axis=-1)
    h = implicit_filter(p.shape[1], *filt)
    return x0 * bidir_fft_conv(x1 * v, h, skip)


def gated_merge(graw, ya, yb, yc, w_out):
    ga, gb, gc = jnp.split(jax.nn.sigmoid(graw), 3, axis=-1)
    return (ga * ya + gb * yb + gc * yc) @ w_out


def expert_choice_ffn(h, w_router, w_gate, w_up, w_down):
    B, N, D = h.shape
    cap = EC_CAP_FACTOR * N // N_EXPERTS
    aff = jax.nn.softmax((h @ w_router).astype(f32), axis=-1)
    g, idx = lax.top_k(jnp.swapaxes(aff, 1, 2), cap)

    def per_set(hs, idx_s, g_s):
        xg = hs[idx_s]
        a = jnp.einsum('ecd,edf->ecf', xg, w_gate)
        u = jnp.einsum('ecd,edf->ecf', xg, w_up)
        y = jnp.einsum('ecf,efd->ecd', jax.nn.silu(a) * u, w_down) * g_s[..., None].astype(hs.dtype)
        return jnp.zeros_like(hs).at[idx_s.reshape(-1)].add(y.reshape(-1, D))

    return jax.vmap(per_set)(h, idx, g)


def mixing_sublayer(hx, hc, need_ctx, lb, w_in, q_gain, k_gain, rpb, conv_w, conv_b, filt, skip,
                    w_a, w_b, w_c, w_out):
    L = hx.shape[1]
    px = hx @ w_in
    pc = hc @ (w_in if need_ctx else w_in[:, :CTX_STATE_COLS])
    s0 = jnp.zeros((hc.shape[0], HG_HEADS, HG_DK, HG_DV), f32)

    lff_c = heads(log_forget(pc[..., OFF_FF:OFF_FB], lb[0]), HG_HEADS)
    lfb_c = heads(log_forget(pc[..., OFF_FB:OFF_I], lb[1]), HG_HEADS)
    i_c = heads(pc[..., OFF_I:OFF_NK].astype(f32), HG_HEADS)
    q_c = heads(jax.nn.silu(pc[..., OFF_HQ:OFF_NQ]).astype(f32), HG_HEADS) if need_ctx else None
    oc_f, s_f = gla_chunk_scan(lff_c, i_c, s0, q_c)
    oc_b, s_b = gla_chunk_scan(rev(lfb_c), rev(i_c), s0, None if q_c is None else rev(q_c))
    lff_x = heads(log_forget(px[..., OFF_FF:OFF_FB], lb[0]), HG_HEADS)
    lfb_x = heads(log_forget(px[..., OFF_FB:OFF_I], lb[1]), HG_HEADS)
    i_x = heads(px[..., OFF_I:OFF_NK].astype(f32), HG_HEADS)
    q_x = heads(jax.nn.silu(px[..., OFF_HQ:OFF_NQ]).astype(f32), HG_HEADS)
    ox_f, _ = gla_chunk_scan(lff_x, i_x, s_f, q_x)
    ox_b, _ = gla_chunk_scan(rev(lfb_x), rev(i_x), s_b, rev(q_x))
    ya_x = hgrn2_readout(ox_f + rev(ox_b), px[..., OFF_HG:OFF_HY], w_a)

    kc = rms_norm(heads(pc[..., OFF_NK:OFF_NV], NA_HEADS), k_gain)
    vc = heads(pc[..., OFF_NV:OFF_HQ], NA_HEADS)
    qn = rms_norm(heads(px[..., OFF_NQ:OFF_HG], NA_HEADS), q_gain)
    kn = rms_norm(heads(px[..., OFF_NK:OFF_NV], NA_HEADS), k_gain)
    vn = heads(px[..., OFF_NV:OFF_HQ], NA_HEADS)
    pos = jnp.arange(L)
    prow, pcol = pos // GRID_W, pos % GRID_W
    yb_x = neighbourhood_attention(qn, axial_rope(qn, prow, pcol), axial_rope(kn, prow, pcol), vn, kc, vc, rpb) @ w_b

    yc_x = hyena_operator(px[..., OFF_HY:OFF_GATE], conv_w, conv_b, filt, skip) @ w_c
    out_x = gated_merge(px[..., OFF_GATE:], ya_x, yb_x, yc_x, w_out)
    if not need_ctx:
        return out_x, None

    ya_c = hgrn2_readout(oc_f + rev(oc_b), pc[..., OFF_HG:OFF_HY], w_a)
    qnc = rms_norm(heads(pc[..., OFF_NQ:OFF_HG], NA_HEADS), q_gain)
    yb_c = context_attention(qnc, kc, vc) @ w_b
    yc_c = hyena_operator(pc[..., OFF_HY:OFF_GATE], conv_w, conv_b, filt, skip) @ w_c
    out_c = gated_merge(pc[..., OFF_GATE:], ya_c, yb_c, yc_c, w_out)
    return out_x, out_c


def setup_inputs(seed: int = 0) -> dict:
    key = jax.random.key(seed)
    ks = iter(jax.random.split(key, 40))

    def nrm(shape, scale):
        return jax.random.normal(next(ks), shape, f32) * scale

    D = D_MODEL
    return {
        'x': nrm((BATCH, SEQ, D), 1.0),
        'c': nrm((BATCH, D), 1.0),
        'ctx': nrm((BATCH, CTX_LEN, D), 1.0),
        'c_ctx': nrm((D,), 1.0),
        'w_mod': nrm((DEPTH, D, 6 * D), 0.5 * D ** -0.5),
        'b_mod': nrm((DEPTH, 6 * D), 0.01),
        'norm_mix': 1.0 + nrm((DEPTH, D), 0.02),
        'norm_ffn': 1.0 + nrm((DEPTH, D), 0.02),
        'w_in': nrm((DEPTH, D, IN_COLS), D ** -0.5),
        'hg_lb': nrm((DEPTH, 2, HG_W), 1.0),
        'na_q_gain': 1.0 + nrm((DEPTH, NA_HD), 0.02),
        'na_k_gain': 1.0 + nrm((DEPTH, NA_HD), 0.02),
        'na_rpb': nrm((DEPTH, NA_HEADS, 2 * NA_WIN_R - 1, 2 * NA_WIN_C - 1), 0.02),
        'hy_conv_w': nrm((DEPTH, 3, 3 * HY_W), 3 ** -0.5),
        'hy_conv_b': nrm((DEPTH, 3 * HY_W), 0.01),
        'hy_pe_w1': nrm((DEPTH, HY_PE_DIM, HY_FILT_HID), HY_PE_DIM ** -0.5),
        'hy_pe_b1': nrm((DEPTH, HY_FILT_HID), 0.01),
        'hy_pe_freq1': 1.0 + nrm((DEPTH, HY_FILT_HID), 0.01),
        'hy_pe_w2': nrm((DEPTH, HY_FILT_HID, HY_FILT_HID), HY_FILT_HID ** -0.5),
        'hy_pe_b2': nrm((DEPTH, HY_FILT_HID), 0.01),
        'hy_pe_freq2': 1.0 + nrm((DEPTH, HY_FILT_HID), 0.01),
        'hy_pe_w3': nrm((DEPTH, HY_FILT_HID, 2 * HY_W), HY_FILT_HID ** -0.5),
        'hy_skip': nrm((DEPTH, HY_W), 0.5),
        'w_branch_a': nrm((DEPTH, HG_VW, D), HG_VW ** -0.5),
        'w_branch_b': nrm((DEPTH, NA_W, D), NA_W ** -0.5),
        'w_branch_c': nrm((DEPTH, HY_W, D), HY_W ** -0.5),
        'w_out': nrm((DEPTH, D, D), D ** -0.5),
        'w_router': nrm((DEPTH, D, N_EXPERTS), D ** -0.5),
        'w_e_gate': nrm((DEPTH, N_EXPERTS, D, D_FF_EXPERT), D ** -0.5),
        'w_e_up': nrm((DEPTH, N_EXPERTS, D, D_FF_EXPERT), D ** -0.5),
        'w_e_down': nrm((DEPTH, N_EXPERTS, D_FF_EXPERT, D), D_FF_EXPERT ** -0.5),
    }


def reference(x, c, ctx, c_ctx, w_mod, b_mod, norm_mix, norm_ffn, w_in, hg_lb, na_q_gain, na_k_gain, na_rpb,
              hy_conv_w, hy_conv_b, hy_pe_w1, hy_pe_b1, hy_pe_freq1, hy_pe_w2, hy_pe_b2, hy_pe_freq2, hy_pe_w3,
              hy_skip, w_branch_a, w_branch_b, w_branch_c, w_out, w_router, w_e_gate, w_e_up, w_e_down):
    lb_all = jnp.cumsum(jax.nn.softmax(hg_lb.astype(f32), axis=0), axis=0)
    lb_all = lb_all - lb_all[:1]
    sc = jax.nn.silu(c)
    scc = jax.nn.silu(c_ctx)
    for l in range(DEPTH):
        need_ctx = l < DEPTH - 1
        mx = jnp.split((sc @ w_mod[l] + b_mod[l])[:, None, :], 6, axis=-1)
        mc = jnp.split(scc @ w_mod[l] + b_mod[l], 6, axis=-1)
        hx = modulate(x, norm_mix[l], mx[0], mx[1])
        hc = modulate(ctx, norm_mix[l], mc[0], mc[1])
        filt = (hy_pe_w1[l], hy_pe_b1[l], hy_pe_freq1[l], hy_pe_w2[l], hy_pe_b2[l], hy_pe_freq2[l], hy_pe_w3[l])
        yx, yc = mixing_sublayer(hx, hc, need_ctx, lb_all[l], w_in[l], na_q_gain[l], na_k_gain[l], na_rpb[l],
                                 hy_conv_w[l], hy_conv_b[l], filt, hy_skip[l],
                                 w_branch_a[l], w_branch_b[l], w_branch_c[l], w_out[l])
        x = x + mx[2] * yx
        hx = modulate(x, norm_ffn[l], mx[3], mx[4])
        x = x + mx[5] * expert_choice_ffn(hx, w_router[l], w_e_gate[l], w_e_up[l], w_e_down[l])
        if need_ctx:
            ctx = ctx + mc[2] * yc
            hc = modulate(ctx, norm_ffn[l], mc[3], mc[4])
            ctx = ctx + mc[5] * expert_choice_ffn(hc, w_router[l], w_e_gate[l], w_e_up[l], w_e_down[l])
    return x
```

```cpp
#include <hip/hip_runtime.h>
#include <stdint.h>
#include <stdio.h>

#ifndef N_LAUNCH_MODE
#define N_LAUNCH_MODE 1
#endif

#ifndef SUB_DUP
#define SUB_DUP 0
#endif
#define SREP(k) for (int srep = 0; srep < ((((SUB_DUP) >> (k)) & 1) ? 2 : 1); ++srep)
#define LAS __attribute__((address_space(3)))
#define GAS __attribute__((address_space(1)))
#define CAS __attribute__((address_space(4)))
typedef unsigned short bf16_t;
typedef short bf16x8 __attribute__((ext_vector_type(8)));
typedef short bf16x4 __attribute__((ext_vector_type(4)));
typedef float f32x4 __attribute__((ext_vector_type(4)));
typedef float f32x16 __attribute__((ext_vector_type(16)));
typedef unsigned u32x4 __attribute__((ext_vector_type(4)));
typedef unsigned u32x2 __attribute__((ext_vector_type(2)));
typedef float f2 __attribute__((ext_vector_type(2)));
__device__ __forceinline__ f2 mk2(float x, float y) { f2 r; r.x = x; r.y = y; return r; }

constexpr int D = 1024, NB = 2, SEQ = 8192, CTX = 256, GW = 64, GROWS = 128;
constexpr int RL = NB * SEQ;
constexpr int RC = NB * CTX;
constexpr int R = RL + RC;
constexpr int INC = 8704;
constexpr int PC = 7680;
constexpr int P_I = 0, P_NK = 512, P_NV = 1024, P_HQ = 1536, P_NQ = 2048, P_HG = 2560, P_HY = 3072, P_GATE = 4608;
constexpr int NE = 16, FF = 2816, CAP = 1024, CAPC = 32;
constexpr int XROWS = 2304;
constexpr int NCH = 132;
constexpr int NCHAIN = 16;
constexpr int NT = 512;
constexpr float EPS = 1e-6f;

constexpr size_t WS_CTL  = 0;
constexpr size_t WS_MOD  = 16384;
constexpr size_t WS_LBC  = WS_MOD + 147456;
constexpr size_t WS_TW   = WS_LBC + 16384;
constexpr size_t WS_ROPE = WS_TW + 131072;
constexpr size_t WS_PS   = WS_ROPE + 24576;
constexpr size_t WS_PSC  = WS_PS + 262144;
constexpr size_t WS_HTC  = WS_PSC + 4096;
constexpr size_t WS_HT   = WS_HTC + 1048576;
constexpr size_t WS_KF   = WS_HT + 67108864;
constexpr size_t WS_WIN  = WS_KF + 67108864;
constexpr size_t WS_WBR  = WS_WIN + 35651584;
constexpr size_t WS_WO3  = WS_WBR + 6291456;
constexpr size_t WS_WGU  = WS_WO3 + 12582912;
constexpr size_t WS_WDN  = WS_WGU + 184549376;
constexpr size_t WS_HX   = WS_WDN + 92274688;
constexpr size_t WS_XM   = WS_HX + 34603008;
constexpr size_t WS_AFF  = WS_XM + 69206016;
constexpr size_t WS_SLOT = WS_AFF + 1048576 + 32768;
constexpr size_t WS_IDX  = WS_SLOT + 1081344;
constexpr size_t WS_T    = WS_IDX + 131072 + 4096;
constexpr size_t WS_MIX  = WS_T + 103809024;
constexpr size_t WS_REG  = WS_MIX + 51904512;
constexpr size_t WS_LF   = WS_REG;
constexpr size_t WS_P    = WS_LF + 69206016;
constexpr size_t WS_DS   = WS_P + 259522560;
constexpr size_t WS_DEC  = WS_DS + 138412032;
constexpr size_t WS_ST   = WS_DEC + 1081344;
constexpr size_t WS_OH   = WS_ST + 69206016;
constexpr size_t WS_UT   = WS_OH + 69206016;
constexpr size_t WS_YT   = WS_UT + 33554432;
constexpr size_t WS_END1 = WS_YT + 33554432;
constexpr size_t WS_XG   = WS_REG;
constexpr size_t WS_H    = WS_XG + 75497472;
constexpr size_t WS_Y    = WS_H + 207618048;
constexpr size_t WS_END2 = WS_Y + 75497472;
constexpr size_t WS_END  = WS_END1 > WS_END2 ? WS_END1 : WS_END2;
static_assert(WS_END <= 1476395008ull, "workspace map exceeds the guaranteed d_ws size");
static_assert((WS_REG & 255) == 0 && (WS_P & 255) == 0 && (WS_DS & 255) == 0 && (WS_ST & 255) == 0, "alignment");

constexpr int LDS_STAGE = 131072;
constexpr int LDS_MISC = 139264;
constexpr int LDS_BYTES = LDS_MISC + 1024;

__device__ __forceinline__ float bf2f(bf16_t b) { return __uint_as_float(((unsigned)b) << 16); }
__device__ __forceinline__ bf16_t f2bf(float f) { unsigned u = __float_as_uint(f); u += 0x7FFFu + ((u >> 16) & 1u); return (bf16_t)(u >> 16); }
typedef float f32x2n __attribute__((ext_vector_type(2)));
typedef __bf16 bf16x2n __attribute__((ext_vector_type(2)));
__device__ __forceinline__ unsigned pk2(float lo, float hi) { f32x2n v; v.x = lo; v.y = hi; const bf16x2n b = __builtin_convertvector(v, bf16x2n); unsigned r; __builtin_memcpy(&r, &b, 4); return r; }
__device__ __forceinline__ float lo16(unsigned w) { return __uint_as_float(w << 16); }
__device__ __forceinline__ float hi16(unsigned w) { return __uint_as_float(w & 0xFFFF0000u); }
__device__ __forceinline__ float sigmoidf_(float x) { return __builtin_amdgcn_rcpf(1.f + __expf(-x)); }
__device__ __forceinline__ float siluf_(float x) { return x * __builtin_amdgcn_rcpf(1.f + __expf(-x)); }
__device__ __forceinline__ float logsigf_(float z) { return fminf(z, 0.f) - log1pf(__expf(-fabsf(z))); }
__device__ __forceinline__ float wave_sum(float v) {
#pragma unroll
    for (int o = 32; o >= 1; o >>= 1) v += __shfl_xor(v, o);
    return v;
}

#define XB_TMO      128
#define XB_XCNT(j)  (256  + 64 * (j))
#define XB_XSUB(j)  (1280 + 64 * (j))
#define XB_XGEN(j)  (2304 + 64 * (j))
#define XB_TOP      3328
#define XB_TOPGEN   3392
#define XCD_BAR_WORDS 3456
#define XB_SPIN_CAP (1u << 22)

__device__ __forceinline__ unsigned xb_ld(unsigned* p)              { return __hip_atomic_load(p, __ATOMIC_RELAXED, __HIP_MEMORY_SCOPE_AGENT); }
__device__ __forceinline__ unsigned xb_add(unsigned* p, unsigned v) { return __hip_atomic_fetch_add(p, v, __ATOMIC_RELAXED, __HIP_MEMORY_SCOPE_AGENT); }
__device__ __forceinline__ unsigned xb_xcc_id() { return (unsigned)__builtin_amdgcn_s_getreg((3 << 11) | 20) & 0xFu; }
#define XB_SPIN(cond, bar) do { unsigned _sp = 0; while (cond) { __builtin_amdgcn_s_sleep(1); \
    if ((++_sp & 255u) == 0u) { if (xb_ld(&(bar)[XB_TMO])) break; if (_sp > XB_SPIN_CAP) { atomicAdd(&(bar)[XB_TMO], 1u); break; } } } } while (0)

struct XcdBarrier { unsigned* bar; unsigned x; volatile LAS unsigned* st; };

__device__ __forceinline__ XcdBarrier xcd_barrier_post(unsigned* bar, volatile LAS unsigned* st) {
    XcdBarrier b; b.bar = bar; b.x = xb_xcc_id(); b.st = st;
    if (threadIdx.x == 0) (void)xb_add(&bar[XB_XCNT(b.x)], 1u);
    return b;
}
__device__ __forceinline__ void xcd_barrier_complete(unsigned* bar, unsigned x, unsigned& nloc, unsigned& nx) {
    const unsigned G = gridDim.x * gridDim.y * gridDim.z;
    unsigned sum, cnt, mine, sp = 0u;
    for (;;) {
        sum = 0u; cnt = 0u; mine = 0u;
#pragma unroll
        for (unsigned j = 0; j < 16; ++j) { const unsigned c = xb_ld(&bar[XB_XCNT(j)]); sum += c; cnt += (c > 0u) ? 1u : 0u; mine = (j == x) ? c : mine; }
        if (sum == G) break;
        __builtin_amdgcn_s_sleep(1);
        if ((++sp & 255u) == 0u) { if (xb_ld(&bar[XB_TMO])) break; if (sp > XB_SPIN_CAP) { atomicAdd(&bar[XB_TMO], 1u); break; } }
    }
    nloc = mine > 0u ? mine : 1u; nx = cnt > 0u ? cnt : 1u;
}
__device__ __forceinline__ void xcd_barrier(const XcdBarrier& b) {
    asm volatile("s_waitcnt vmcnt(0)" ::: "memory");
    __syncthreads();
    if (threadIdx.x == 0) {
        unsigned* bar = b.bar;
        __builtin_amdgcn_s_waitcnt(0);
        unsigned nloc = b.st[0], nx = b.st[1];
        if (nloc == 0u) { xcd_barrier_complete(bar, b.x, nloc, nx); b.st[0] = nloc; b.st[1] = nx; }
        const unsigned old = xb_add(&bar[XB_XSUB(b.x)], 1u);
        const unsigned gen = old / nloc;
        if (old + 1u == (gen + 1u) * nloc) {
            __builtin_amdgcn_fence(__ATOMIC_RELEASE, "agent");
            asm volatile("s_waitcnt vmcnt(0)" ::: "memory");
            const unsigned og = xb_add(&bar[XB_TOP], 1u);
            const unsigned tg = og / nx;
            if (og + 1u == (tg + 1u) * nx) xb_add(&bar[XB_TOPGEN], 1u);
            else XB_SPIN(xb_ld(&bar[XB_TOPGEN]) == tg, bar);
            __builtin_amdgcn_fence(__ATOMIC_ACQUIRE, "agent");
            xb_add(&bar[XB_XGEN(b.x)], 1u);
            asm volatile("s_waitcnt vmcnt(0)" ::: "memory");
        } else {
            XB_SPIN(xb_ld(&bar[XB_XGEN(b.x)]) == gen, bar);
            __builtin_amdgcn_fence(__ATOMIC_ACQUIRE, "agent");
            asm volatile("s_waitcnt vmcnt(0)" ::: "memory");
        }
    }
    __syncthreads();
}

namespace pg8 {
constexpr int BM = 256, BK = 64, HALF = 128, HTB = HALF * BK * 2, STAGE_BYTES = 8 * HTB, NXCD = 8, WGM = 8;
__device__ __forceinline__ int lds_byte(int r, int c) { const int st = (r >> 4) * 2 + (c >> 5), rr = r & 15, cc = c & 31, ob = rr * 64 + cc * 2; return st * 1024 + (ob ^ (((ob >> 9) & 1) << 5)); }
__device__ __forceinline__ void stage_rc(int b, int& Rr, int& C) { const int st = b / 1024, sb = b % 1024, swz = sb ^ (((sb >> 9) & 1) << 5); Rr = (st >> 1) * 16 + swz / 64; C = (st & 1) * 32 + (swz % 64) / 2; }
__device__ __forceinline__ int perm32(int rho) { const int n = rho >> 4, i = rho & 15; return 8 * (i >> 2) + 4 * n + (i & 3); }

struct Unit { int pm, pn, g; };
struct Gemm { int lda, ldb, K; };

__device__ __forceinline__ void tile_order(int L, int nM, int nN, int& pm, int& pn) {
    const int nwg = nM * nN; int wgid = L;
    { const int q = nwg / NXCD, r = nwg % NXCD, xcd = wgid % NXCD, off = wgid / NXCD; wgid = (xcd < r ? xcd * (q + 1) : r * (q + 1) + (xcd - r) * q) + off; }
    const int nig = WGM * nN, gid = wgid / nig, fm = gid * WGM, gsz = (nM - fm) < WGM ? (nM - fm) : WGM;
    pm = fm + ((wgid % nig) % gsz); pn = (wgid % nig) / gsz;
}

template <class Epi, class Sched>
__device__ __forceinline__ void gemm_phase(LAS unsigned char* lds, const Gemm g, const Sched& S, const Epi& E, const bool perm) {
    int tid = threadIdx.x; asm volatile("" : "+v"(tid));
    const int wid = __builtin_amdgcn_readfirstlane(tid >> 6), lane = tid & 63, wr = wid >> 2, wc = wid & 3, fr = lane & 15, fq = lane >> 4;
    const int K = g.K, nt = K / BK;
    unsigned voffA[2], voffB[2];
#pragma unroll
    for (int i = 0; i < 2; ++i) { int Rr, C; stage_rc(tid * 16 + i * 8192, Rr, C); const int Rb = perm ? ((Rr & ~31) + perm32(Rr & 31)) : Rr;
        voffA[i] = (unsigned)(Rr * g.lda + C) * 2u; voffB[i] = (unsigned)(Rb * g.ldb + C) * 2u; }
    const size_t kstep = (size_t)(BK * 2);
    const size_t hstepA = (size_t)HALF * g.lda * 2, hstepB = (size_t)HALF * g.ldb * 2;
    const unsigned ldsw = (unsigned)wid * 1024u;
    const int aoff = lds_byte(wr * 64 + fr, fq * 8), boff = lds_byte(wc * 32 + fr, fq * 8);
#define PG8_SA(b, h) (((b) * 2 + (h)) * HTB)
#define PG8_SB(b, h) ((4 + (b) * 2 + (h)) * HTB)
#define PG8_STAGE(bufoff, gbase, voff) do { _Pragma("unroll") for (int _i = 0; _i < 2; ++_i) \
        __builtin_amdgcn_global_load_lds((const unsigned*)((const char*)(gbase) + (voff)[_i]), (LAS unsigned*)(lds + (bufoff) + ldsw + _i * 8192), 16, 0, 0); } while (0)
#define PG8_LDA(dst, b, h) do { _Pragma("unroll") for (int m = 0; m < 4; ++m) _Pragma("unroll") for (int k = 0; k < 2; ++k) dst[m][k] = *(const LAS bf16x8*)(lds + PG8_SA(b, h) + aoff + m * 2048 + k * 1024); } while (0)
#define PG8_LDB(dst, b, h) do { _Pragma("unroll") for (int n = 0; n < 2; ++n) _Pragma("unroll") for (int k = 0; k < 2; ++k) dst[n][k] = *(const LAS bf16x8*)(lds + PG8_SB(b, h) + boff + n * 2048 + k * 1024); } while (0)
#define PG8_MMA(ai, bj, At, Bt) do { __builtin_amdgcn_s_setprio(1); _Pragma("unroll") for (int m = 0; m < 4; ++m) _Pragma("unroll") for (int n = 0; n < 2; ++n) _Pragma("unroll") for (int k = 0; k < 2; ++k) \
        acc[ai][bj][m][n] = __builtin_amdgcn_mfma_f32_16x16x32_bf16(Bt[n][k], At[m][k], acc[ai][bj][m][n], 0, 0, 0); __builtin_amdgcn_s_setprio(0); } while (0)
#define PG8_WAIT_V(n) asm volatile("s_waitcnt vmcnt(" #n ")" ::: "memory")
#define PG8_WAIT_L(n) asm volatile("s_waitcnt lgkmcnt(" #n ")" ::: "memory")
#define PG8_BAR __builtin_amdgcn_s_barrier()
#define PG8_SCHED __builtin_amdgcn_sched_barrier(0)
    Unit cur, nxt; int ui = 0;
    if (!S.next(0, cur)) return;
    f32x4 acc[2][2][4][2];
#pragma unroll
    for (int a = 0; a < 2; ++a)
#pragma unroll
        for (int b = 0; b < 2; ++b)
#pragma unroll
            for (int m = 0; m < 4; ++m)
#pragma unroll
                for (int n = 0; n < 2; ++n) acc[a][b][m][n] = (f32x4){0.f, 0.f, 0.f, 0.f};
    bf16x8 At[4][2], B0[2][2], B1[2][2];
    const char* cA = S.a_ptr(cur); const char* cB = S.b_ptr(cur);
    PG8_STAGE(PG8_SB(0, 0), cB, voffB); PG8_STAGE(PG8_SA(0, 0), cA, voffA); PG8_STAGE(PG8_SB(0, 1), cB + hstepB, voffB); PG8_STAGE(PG8_SA(0, 1), cA + hstepA, voffA);
    if (wr == 1) PG8_BAR;
    PG8_WAIT_V(4); PG8_BAR;
    PG8_STAGE(PG8_SB(1, 0), cB + kstep, voffB); PG8_STAGE(PG8_SA(1, 0), cA + kstep, voffA); PG8_STAGE(PG8_SB(1, 1), cB + hstepB + kstep, voffB);
    PG8_WAIT_V(6); PG8_BAR;
    for (;;) {
        const bool has_next = S.next(ui + 1, nxt);
        const char* nA = has_next ? S.a_ptr(nxt) : cA; const char* nB = has_next ? S.b_ptr(nxt) : cB;
        for (int t = 0; t < nt; t += 2) {
            const bool last = (t == nt - 2);
            const char* a1 = cA + (size_t)(t + 1) * kstep;
            const char* a2 = last ? nA : cA + (size_t)(t + 2) * kstep; const char* b2 = last ? nB : cB + (size_t)(t + 2) * kstep;
            const char* a3 = a2 + kstep; const char* b3 = b2 + kstep;
            PG8_LDB(B0, 0, 0); PG8_SCHED; PG8_LDA(At, 0, 0); PG8_STAGE(PG8_SA(1, 1), a1 + hstepA, voffA);
            PG8_WAIT_L(8); PG8_BAR; PG8_WAIT_L(0); PG8_MMA(0, 0, At, B0); PG8_BAR; PG8_SCHED;
            PG8_LDB(B1, 0, 1); PG8_STAGE(PG8_SB(0, 0), b2, voffB);
            PG8_BAR; PG8_WAIT_L(0); PG8_MMA(0, 1, At, B1); PG8_BAR;
            PG8_LDA(At, 0, 1); PG8_STAGE(PG8_SA(0, 0), a2, voffA);
            PG8_BAR; PG8_WAIT_L(0); PG8_MMA(1, 0, At, B0); PG8_BAR; PG8_SCHED;
            PG8_STAGE(PG8_SB(0, 1), b2 + hstepB, voffB);
            PG8_WAIT_V(6); PG8_BAR; PG8_MMA(1, 1, At, B1); PG8_BAR;
            PG8_LDB(B0, 1, 0); PG8_SCHED; PG8_LDA(At, 1, 0); PG8_STAGE(PG8_SA(0, 1), a2 + hstepA, voffA);
            PG8_WAIT_L(8); PG8_BAR; PG8_WAIT_L(0); PG8_MMA(0, 0, At, B0); PG8_BAR; PG8_SCHED;
            PG8_LDB(B1, 1, 1); PG8_STAGE(PG8_SB(1, 0), b3, voffB);
            PG8_BAR; PG8_WAIT_L(0); PG8_MMA(0, 1, At, B1); PG8_BAR;
            PG8_LDA(At, 1, 1); PG8_STAGE(PG8_SA(1, 0), a3, voffA);
            PG8_BAR; PG8_WAIT_L(0); PG8_MMA(1, 0, At, B0); PG8_BAR; PG8_SCHED;
            PG8_STAGE(PG8_SB(1, 1), b3 + hstepB, voffB);
            PG8_WAIT_V(6); PG8_BAR; PG8_MMA(1, 1, At, B1); PG8_BAR;
        }
        E(acc, cur, wr, wc, fr, fq);
        if (!has_next) break;
#pragma unroll
        for (int a = 0; a < 2; ++a)
#pragma unroll
            for (int b = 0; b < 2; ++b)
#pragma unroll
                for (int m = 0; m < 4; ++m)
#pragma unroll
                    for (int n = 0; n < 2; ++n) acc[a][b][m][n] = (f32x4){0.f, 0.f, 0.f, 0.f};
        cur = nxt; cA = nA; cB = nB; ++ui;
    }
    PG8_WAIT_V(0);
    if (wr == 0) PG8_BAR;
    PG8_BAR;
#undef PG8_SA
#undef PG8_SB
#undef PG8_STAGE
#undef PG8_LDA
#undef PG8_LDB
#undef PG8_MMA
#undef PG8_WAIT_V
#undef PG8_WAIT_L
#undef PG8_BAR
#undef PG8_SCHED
}
}

struct KArgs { const float* in[31]; float* out; unsigned char* ws; int ph_lo, ph_hi; };
enum { I_X = 0, I_C, I_CTX, I_CCTX, I_WMOD, I_BMOD, I_NMIX, I_NFFN, I_WIN, I_HGLB, I_QG, I_KG, I_RPB, I_CW, I_CB, I_PW1, I_PB1, I_PF1, I_PW2, I_PB2, I_PF2, I_PW3, I_SKIP,
       I_WA, I_WB, I_WC, I_WOUT, I_WR, I_WEG, I_WEU, I_WED };

struct Frame {
    const GAS float* LAS* in; GAS float* out; GAS unsigned char* ws; LAS unsigned char* lds; int tid, lane, wave, G, bid;
};
#define WSP(T, off) ((GAS T*)(F.ws + (off)))

struct SchedIn {
    const char* A; const char* B; int G, c, nctx;
    __device__ __forceinline__ bool next(int i, pg8::Unit& u) const {
        const int L = i * G + c;
        if (L < 64 * 34) { pg8::tile_order(L, 64, 34, u.pm, u.pn); u.g = 0; return true; }
        const int e = L - 64 * 34; if (e >= 2 * nctx) return false;
        const int hi_ = e >= nctx ? 1 : 0; u.pm = 64 + hi_; u.pn = e - hi_ * nctx; u.g = 0; return true;
    }
    __device__ __forceinline__ const char* a_ptr(const pg8::Unit& u) const { return A + (size_t)u.pm * 256 * 1024 * 2; }
    __device__ __forceinline__ const char* b_ptr(const pg8::Unit& u) const { return B + (size_t)u.pn * 256 * 1024 * 2; }
};
struct SchedBr {
    const char* A; const char* B; int G, c, nM;
    __device__ __forceinline__ bool next(int i, pg8::Unit& u) const {
        const int L = i * G + c; if (L >= nM * 12) return false;
        pg8::tile_order(L, nM, 12, u.pm, u.pn); u.g = u.pn >> 2; return true;
    }
    __device__ __forceinline__ const char* a_ptr(const pg8::Unit& u) const { return A + ((size_t)u.pm * 256 * 1536 + (size_t)u.g * 512) * 2; }
    __device__ __forceinline__ const char* b_ptr(const pg8::Unit& u) const { return B + (size_t)u.pn * 256 * 512 * 2; }
};
struct SchedOut {
    const char* A; const char* B; int G, c, nM;
    __device__ __forceinline__ bool next(int i, pg8::Unit& u) const {
        const int L = i * G + c; if (L >= nM * 4) return false;
        pg8::tile_order(L, nM, 4, u.pm, u.pn); u.g = 0; return true;
    }
    __device__ __forceinline__ const char* a_ptr(const pg8::Unit& u) const { return A + (size_t)u.pm * 256 * 1024 * 2; }
    __device__ __forceinline__ const char* b_ptr(const pg8::Unit& u) const { return B + (size_t)u.pn * 256 * 3072 * 2; }
};
struct SchedGU {
    const char* A; const char* B; int G, c, nMt;
    __device__ __forceinline__ bool next(int i, pg8::Unit& u) const {
        const int L = (G % 8 == 0) ? ((i * 8 + (c & 7)) * (G >> 3) + (c >> 3)) : (i * G + c);
         const int per = nMt * 22; if (L >= NE * per) return false;
        u.g = nMt == 8 ? L / 176 : L / 198; const int rem = L - u.g * per; u.pn = nMt == 8 ? (rem >> 3) : rem / 9; u.pm = rem - u.pn * nMt; return true;
    }
    __device__ __forceinline__ const char* a_ptr(const pg8::Unit& u) const { return A + ((size_t)u.g * XROWS + (size_t)u.pm * 256) * 1024 * 2; }
    __device__ __forceinline__ const char* b_ptr(const pg8::Unit& u) const { return B + ((size_t)u.g * 5632 + (size_t)u.pn * 256) * 1024 * 2; }
};
struct SchedDn {
    const char* A; const char* B; int G, c, nMt;
    __device__ __forceinline__ bool next(int i, pg8::Unit& u) const {
        const int L = (G % 8 == 0) ? ((i * 8 + (c & 7)) * (G >> 3) + (c >> 3)) : (i * G + c);
         const int per = nMt * 4; if (L >= NE * per) return false;
        u.g = nMt == 8 ? (L >> 5) : L / 36; const int rem = L - u.g * per; u.pn = nMt == 8 ? (rem >> 3) : rem / 9; u.pm = rem - u.pn * nMt; return true;
    }
    __device__ __forceinline__ const char* a_ptr(const pg8::Unit& u) const { return A + ((size_t)u.g * XROWS + (size_t)u.pm * 256) * FF * 2; }
    __device__ __forceinline__ const char* b_ptr(const pg8::Unit& u) const { return B + ((size_t)u.g * 1024 + (size_t)u.pn * 256) * FF * 2; }
};

__device__ __forceinline__ float log_forget(float z, f2 c) {
    return __logf(c.x + c.y * sigmoidf_(fmaxf(z, -60.f)));
}
struct EpiIn {
    static constexpr bool PERM = true;
    GAS float* LF; GAS bf16_t* P; const GAS f2* lbc;
    template <int BJ> __device__ __forceinline__ void part(const f32x4 (&acc)[2][2][4][2], int pn, int row0, int wc, int fq) const {
        const int act = (pn == 10 || pn == 11 || pn == 14 || pn == 15) ? 1 : (pn >= 22 ? 2 : 0);
        const int c0 = pn * 256 + BJ * 128 + wc * 32 + 8 * fq;
        if (pn < 4) {
            f2 cc[8];
#pragma unroll
            for (int e = 0; e < 8; ++e) cc[e] = lbc[c0 + e];
#pragma unroll
            for (int ai = 0; ai < 2; ++ai)
#pragma unroll
                for (int m = 0; m < 4; ++m) {
                    const int row = row0 + ai * 128 + m * 16;
                    f32x4 v0 = acc[ai][BJ][m][0], v1 = acc[ai][BJ][m][1];
#pragma unroll
                    for (int e = 0; e < 4; ++e) { v0[e] = log_forget(v0[e], cc[e]); v1[e] = log_forget(v1[e], cc[4 + e]); }
                    GAS float* p = LF + (size_t)row * 1024 + c0;
                    *(GAS f32x4*)p = v0; *(GAS f32x4*)(p + 4) = v1;
                }
        } else {
#pragma unroll
            for (int ai = 0; ai < 2; ++ai)
#pragma unroll
                for (int m = 0; m < 4; ++m) {
                    const int row = row0 + ai * 128 + m * 16;
                    f32x4 v0 = acc[ai][BJ][m][0], v1 = acc[ai][BJ][m][1];
                    if (act == 1) {
#pragma unroll
                        for (int e = 0; e < 4; ++e) { v0[e] = siluf_(v0[e]); v1[e] = siluf_(v1[e]); }
                    } else if (act == 2) {
#pragma unroll
                        for (int e = 0; e < 4; ++e) { v0[e] = sigmoidf_(v0[e]); v1[e] = sigmoidf_(v1[e]); }
                    }
                    u32x4 w; w.x = pk2(v0[0], v0[1]); w.y = pk2(v0[2], v0[3]); w.z = pk2(v1[0], v1[1]); w.w = pk2(v1[2], v1[3]);
                    *(GAS u32x4*)(P + (size_t)row * PC + (c0 - 1024)) = w;
                }
        }
    }
    __device__ __forceinline__ void operator()(const f32x4 (&acc)[2][2][4][2], const pg8::Unit& u, int wr, int wc, int fr, int fq) const {
        const int row0 = u.pm * 256 + wr * 64 + fr;
        part<0>(acc, u.pn, row0, wc, fq);
        part<1>(acc, u.pn, row0, wc, fq);
    }
};
struct EpiBr {
    static constexpr bool PERM = true;
    GAS bf16_t* T; const GAS bf16_t* P;
    __device__ __forceinline__ void operator()(const f32x4 (&acc)[2][2][4][2], const pg8::Unit& u, int wr, int wc, int fr, int fq) const {
        const int row0 = u.pm * 256 + wr * 64 + fr;
#pragma unroll
        for (int ai = 0; ai < 2; ++ai)
#pragma unroll
            for (int m = 0; m < 4; ++m) {
                const int row = row0 + ai * 128 + m * 16;
#pragma unroll
                for (int bj = 0; bj < 2; ++bj) {
                    const int c0 = u.pn * 256 + bj * 128 + wc * 32 + 8 * fq;
                    const f32x4 v0 = acc[ai][bj][m][0], v1 = acc[ai][bj][m][1];
                    u32x4 w; w.x = pk2(v0[0], v0[1]); w.y = pk2(v0[2], v0[3]); w.z = pk2(v1[0], v1[1]); w.w = pk2(v1[2], v1[3]);
                    *(GAS u32x4*)(T + (size_t)row * 3072 + c0) = w;
                }
            }
    }
};
struct EpiOut {
    static constexpr bool PERM = true;
    GAS bf16_t* DL;
    __device__ __forceinline__ void operator()(const f32x4 (&acc)[2][2][4][2], const pg8::Unit& u, int wr, int wc, int fr, int fq) const {
        const int row0 = u.pm * 256 + wr * 64 + fr;
#pragma unroll
        for (int ai = 0; ai < 2; ++ai)
#pragma unroll
            for (int m = 0; m < 4; ++m) {
                const int row = row0 + ai * 128 + m * 16;
#pragma unroll
                for (int bj = 0; bj < 2; ++bj) {
                    const int c0 = u.pn * 256 + bj * 128 + wc * 32 + 8 * fq;
                    const f32x4 v0 = acc[ai][bj][m][0], v1 = acc[ai][bj][m][1];
                    u32x4 w; w.x = pk2(v0[0], v0[1]); w.y = pk2(v0[2], v0[3]); w.z = pk2(v1[0], v1[1]); w.w = pk2(v1[2], v1[3]);
                    *(GAS u32x4*)(DL + (size_t)row * 1024 + c0) = w;
                }
            }
    }
};
struct EpiGU {
    static constexpr bool PERM = true;
    GAS bf16_t* H;
    __device__ __forceinline__ void operator()(const f32x4 (&acc)[2][2][4][2], const pg8::Unit& u, int wr, int wc, int fr, int fq) const {
        const int row0 = u.g * XROWS + u.pm * 256 + wr * 64 + fr;
        const int hc = u.pn * 128 + wc * 32 + 8 * fq;
#pragma unroll
        for (int ai = 0; ai < 2; ++ai)
#pragma unroll
            for (int m = 0; m < 4; ++m) {
                const int row = row0 + ai * 128 + m * 16;
                const f32x4 g0 = acc[ai][0][m][0], g1 = acc[ai][0][m][1], u0 = acc[ai][1][m][0], u1 = acc[ai][1][m][1];
                u32x4 w; w.x = pk2(siluf_(g0[0]) * u0[0], siluf_(g0[1]) * u0[1]); w.y = pk2(siluf_(g0[2]) * u0[2], siluf_(g0[3]) * u0[3]);
                w.z = pk2(siluf_(g1[0]) * u1[0], siluf_(g1[1]) * u1[1]); w.w = pk2(siluf_(g1[2]) * u1[2], siluf_(g1[3]) * u1[3]);
                *(GAS u32x4*)(H + (size_t)row * FF + hc) = w;
            }
    }
};
struct EpiDn {
    static constexpr bool PERM = true;
    GAS bf16_t* Y;
    __device__ __forceinline__ void operator()(const f32x4 (&acc)[2][2][4][2], const pg8::Unit& u, int wr, int wc, int fr, int fq) const {
        const int row0 = u.g * XROWS + u.pm * 256 + wr * 64 + fr;
#pragma unroll
        for (int ai = 0; ai < 2; ++ai)
#pragma unroll
            for (int m = 0; m < 4; ++m) {
                const int row = row0 + ai * 128 + m * 16;
#pragma unroll
                for (int bj = 0; bj < 2; ++bj) {
                    const int c0 = u.pn * 256 + bj * 128 + wc * 32 + 8 * fq;
                    const f32x4 v0 = acc[ai][bj][m][0], v1 = acc[ai][bj][m][1];
                    u32x4 w; w.x = pk2(v0[0], v0[1]); w.y = pk2(v0[2], v0[3]); w.z = pk2(v1[0], v1[1]); w.w = pk2(v1[2], v1[3]);
                    *(GAS u32x4*)(Y + (size_t)row * 1024 + c0) = w;
                }
            }
    }
};

#define MFMA32(a, b, c) __builtin_amdgcn_mfma_f32_32x32x16_bf16((a), (b), (c), 0, 0, 0)
#define MFMA16(a, b, c) __builtin_amdgcn_mfma_f32_16x16x32_bf16((a), (b), (c), 0, 0, 0)
struct CJob { const GAS float* src; GAS bf16_t* dst; int N, k0, n0, ldd, rmap, coff; };
__device__ __forceinline__ CJob conv_job_ne(const Frame& F, int jj) {
    const int l = jj / 704, j = jj - l * 704; CJob d;
    if (j < 544) { const int kt = j / 68, nt = j % 68;
        d.src = F.in[I_WIN] + (size_t)l * 1024 * INC; d.N = INC; d.k0 = kt * 128; d.n0 = nt * 128; d.dst = WSP(bf16_t, WS_WIN) + (size_t)l * INC * 1024; d.ldd = 1024; d.rmap = 0; d.coff = 0;
    } else if (j < 640) { const int q = j - 544; const int g = q >> 5, r = q & 31; const int kt = r >> 3, nt = r & 7;
        d.src = (g == 0 ? F.in[I_WA] : (g == 1 ? F.in[I_WB] : F.in[I_WC])) + (size_t)l * 512 * 1024; d.N = 1024; d.k0 = kt * 128; d.n0 = nt * 128;
        d.dst = WSP(bf16_t, WS_WBR) + (size_t)(l * 3 + g) * 1024 * 512; d.ldd = 512; d.rmap = 0; d.coff = 0;
    } else { const int q = j - 640; const int rep = q >> 6, r = q & 63; const int kt = r >> 3, nt = r & 7;
        d.src = F.in[I_WOUT] + (size_t)l * 1024 * 1024; d.N = 1024; d.k0 = kt * 128; d.n0 = nt * 128; d.dst = WSP(bf16_t, WS_WO3) + (size_t)l * 1024 * 3072; d.ldd = 3072; d.rmap = 0; d.coff = rep * 1024; }
    return d;
}
__device__ __forceinline__ CJob conv_job_ex(const Frame& F, int l, int j) {
    CJob d;
    if (j < 5632) { const int up = j >= 2816; const int q = j - up * 2816; const int e = q / 176, r = q % 176; const int kt = r / 22, nt = r % 22;
        d.src = (up ? F.in[I_WEU] : F.in[I_WEG]) + ((size_t)(l * NE + e) * 1024) * FF; d.N = FF; d.k0 = kt * 128; d.n0 = nt * 128;
        d.dst = WSP(bf16_t, WS_WGU) + (size_t)e * 5632 * 1024; d.ldd = 1024; d.rmap = 1 + up; d.coff = 0;
    } else { const int q = j - 5632; const int e = q / 176, r = q % 176; const int kt = r >> 3, nt = r & 7;
        d.src = F.in[I_WED] + ((size_t)(l * NE + e) * FF) * 1024; d.N = 1024; d.k0 = kt * 128; d.n0 = nt * 128; d.dst = WSP(bf16_t, WS_WDN) + (size_t)e * 1024 * FF; d.ldd = FF; d.rmap = 0; d.coff = 0; }
    return d;
}
static __device__ __noinline__ void conv_stream(const Frame F, int kind, int l, int first, int total, int stride) {
    LAS unsigned char* lds = F.lds;
    const int t = F.tid, lane = t & 63; const int w = __builtin_amdgcn_readfirstlane(t >> 6);
    kind = __builtin_amdgcn_readfirstlane(kind); l = __builtin_amdgcn_readfirstlane(l); first = __builtin_amdgcn_readfirstlane(first); total = __builtin_amdgcn_readfirstlane(total); stride = __builtin_amdgcn_readfirstlane(stride);
    if (first >= total) return;
    const int nmy = (total - first + stride - 1) / stride;
    __syncthreads();
    const int krow = lane >> 5, c0 = ((lane & 31) ^ (2 * w)) * 4, c1 = ((lane & 31) ^ (2 * w + 1)) * 4;
    const int kg = lane & 15, qn = lane >> 4;
#define CONV_JOB(J) (kind ? conv_job_ex(F, l, (J)) : conv_job_ne(F, (J)))
#define CONV_LOAD(D, BUF) do { const unsigned vo0 = (unsigned)(krow * (D).N + c0) * 4u, vo1 = (unsigned)(krow * (D).N + c1) * 4u; \
        const char* gb = (const char*)((D).src + (size_t)((D).k0 + 16 * w) * (D).N + (D).n0); const size_t rs2 = (size_t)(D).N * 8; \
        _Pragma("unroll") for (int pi = 0; pi < 8; ++pi) \
            __builtin_amdgcn_global_load_lds((const unsigned*)(gb + pi * rs2 + (pi < 4 ? vo0 : vo1)), (LAS unsigned*)(lds + (BUF) * 65536 + (w * 8 + pi) * 1024), 16, 0, 0); } while (0)
#define CONV_OUT(D, BUF) do { _Pragma("unroll") for (int jj = 0; jj < 4; ++jj) { const int j4 = 4 * w + jj; \
        const LAS float* rp = (const LAS float*)(lds + (BUF) * 65536) + kg * 1024 + ((j4 ^ kg) * 4) + qn; \
        float v[8]; _Pragma("unroll") for (int e = 0; e < 8; ++e) v[e] = rp[e * 128]; \
        u32x4 wv; wv.x = pk2(v[0], v[1]); wv.y = pk2(v[2], v[3]); wv.z = pk2(v[4], v[5]); wv.w = pk2(v[6], v[7]); \
        const int n = (D).n0 + 4 * j4 + qn; const int row = (D).rmap == 0 ? n : (((n >> 7) << 8) + (n & 127) + ((D).rmap == 2 ? 128 : 0)); \
        *(GAS u32x4*)((D).dst + (size_t)row * (D).ldd + (D).coff + (D).k0 + kg * 8) = wv; } } while (0)
#define CONV_WAITV(n) asm volatile("s_waitcnt vmcnt(" #n ")" ::: "memory")
#define CONV_BAR do { asm volatile("s_waitcnt lgkmcnt(0)" ::: "memory"); __builtin_amdgcn_s_barrier(); asm volatile("" ::: "memory"); } while (0)
    { const CJob d = CONV_JOB(first); CONV_LOAD(d, 0); }
    if (nmy > 1) { const CJob d = CONV_JOB(first + stride); CONV_LOAD(d, 1); }
    for (int q = 0; q < nmy; q += 2) {
        const int j = first + q * stride;
        if (q + 1 < nmy) { if (q) CONV_WAITV(12); else CONV_WAITV(8); } else CONV_WAITV(0);
        CONV_BAR;
        { const CJob d = CONV_JOB(j); CONV_OUT(d, 0); }
        if (q + 2 < nmy) { CONV_BAR; const CJob d = CONV_JOB(j + 2 * stride); CONV_LOAD(d, 0); }
        if (q + 1 < nmy) {
            if (q + 2 < nmy) CONV_WAITV(12); else CONV_WAITV(0);
            CONV_BAR;
            { const CJob d = CONV_JOB(j + stride); CONV_OUT(d, 1); }
            if (q + 3 < nmy) { CONV_BAR; const CJob d = CONV_JOB(j + 3 * stride); CONV_LOAD(d, 1); }
        }
    }
#undef CONV_LOAD
#undef CONV_OUT
#undef CONV_JOB
#undef CONV_WAITV
#undef CONV_BAR
    __syncthreads();
}
static __device__ __noinline__ void mod_unit(const Frame F, int u) {
    const int l = u / 96, jb = (u % 96) * 64; const int t = F.tid, cg = t & 15, ds = t >> 4;
    const GAS float* W = F.in[I_WMOD] + (size_t)l * 1024 * 6144;
    f32x4 acc0 = {0, 0, 0, 0}, acc1 = {0, 0, 0, 0}, acc2 = {0, 0, 0, 0};
    for (int dd = 0; dd < 32; ++dd) {
        const int d = ds * 32 + dd;
        const f32x4 w = *(const GAS f32x4*)(W + (size_t)d * 6144 + jb + cg * 4);
        const float s0 = siluf_(F.in[I_C][d]), s1 = siluf_(F.in[I_C][1024 + d]), s2 = siluf_(F.in[I_CCTX][d]);
        acc0 += w * s0; acc1 += w * s1; acc2 += w * s2;
    }
    LAS float* red = (LAS float*)F.lds;
#pragma unroll
    for (int e = 0; e < 4; ++e) { red[(ds * 3 + 0) * 64 + cg * 4 + e] = acc0[e]; red[(ds * 3 + 1) * 64 + cg * 4 + e] = acc1[e]; red[(ds * 3 + 2) * 64 + cg * 4 + e] = acc2[e]; }
    __syncthreads();
    if (t < 192) { const int r = t >> 6, c = t & 63; float s = 0.f;
        for (int q = 0; q < 32; ++q) s += red[(q * 3 + r) * 64 + c];
        WSP(float, WS_MOD)[(size_t)(l * 3 + r) * 6144 + jb + c] = s + F.in[I_BMOD][(size_t)l * 6144 + jb + c]; }
    __syncthreads();
}
__device__ __forceinline__ const CAS float* ucp(const GAS float* p) {
    const unsigned long long a = (unsigned long long)p; const unsigned lo = __builtin_amdgcn_readfirstlane((unsigned)a), hi = __builtin_amdgcn_readfirstlane((unsigned)(a >> 32));
    return (const CAS float*)(((unsigned long long)hi << 32) | lo);
}
__device__ __forceinline__ void f1_unit(const Frame F, int l, int pb, int cb, int n, GAS float* HT, GAS float* PS) {
    LAS float* h1s = (LAS float*)F.lds; LAS float* h2s = h1s + 64 * 256;
    const int t = F.tid, pos = t & 255, p = pb * 256 + pos; const int half = __builtin_amdgcn_readfirstlane(t >> 8);
    l = __builtin_amdgcn_readfirstlane(l); cb = __builtin_amdgcn_readfirstlane(cb);
    const CAS float* w1 = ucp(F.in[I_PW1] + (size_t)l * 33 * 64); const CAS float* b1 = ucp(F.in[I_PB1] + l * 64); const CAS float* fr1 = ucp(F.in[I_PF1] + l * 64);
    const CAS float* w2 = ucp(F.in[I_PW2] + (size_t)l * 64 * 64); const CAS float* b2 = ucp(F.in[I_PB2] + l * 64); const CAS float* fr2 = ucp(F.in[I_PF2] + l * 64);
    const CAS float* w3 = ucp(F.in[I_PW3] + (size_t)l * 64 * 1024);
    const float tn = (float)p * (1.0f / (float)(n - 1));
    const float rev = (float)p / (float)n;
    const float inv2pi = 0.15915494309189535f;
    float z[33];
    z[0] = tn;
#pragma unroll
    for (int j = 0; j < 16; ++j) { const float fj = 1e-4f + (float)j * ((15.0f - 1e-4f) / 15.0f); const float a = fj * rev; z[1 + j] = __builtin_amdgcn_cosf(a); z[17 + j] = -__builtin_amdgcn_sinf(a); }
    for (int mm = 0; mm < 32; ++mm) { const int m = half * 32 + mm; float acc = b1[m];
#pragma unroll
        for (int i = 0; i < 33; ++i) acc += z[i] * w1[i * 64 + m];
        h1s[m * 256 + pos] = __builtin_amdgcn_sinf(fr1[m] * acc * inv2pi); }
    __syncthreads();
    for (int q = 0; q < 2; ++q) { const int m0 = half * 32 + q * 16; float acc[16];
#pragma unroll
      for (int mm = 0; mm < 16; ++mm) acc[mm] = b2[m0 + mm];
      for (int i = 0; i < 64; ++i) { const float hv = h1s[i * 256 + pos];
#pragma unroll
          for (int mm = 0; mm < 16; ++mm) acc[mm] += hv * w2[i * 64 + m0 + mm]; }
#pragma unroll
      for (int mm = 0; mm < 16; ++mm) h2s[(m0 + mm) * 256 + pos] = __builtin_amdgcn_sinf(fr2[m0 + mm] * acc[mm] * inv2pi); }
    __syncthreads();
    LAS bf16_t* w3t = (LAS bf16_t*)F.lds;
    { const GAS float* w3g = F.in[I_PW3] + (size_t)l * 64 * 1024 + cb * 256;
#pragma unroll 8
      for (int i = 0; i < 32; ++i) { const int idx = t + 512 * i; const int m = idx >> 8, c = idx & 255; w3t[c * 72 + m] = (bf16_t)(pk2(w3g[(size_t)m * 1024 + c], 0.f) & 0xFFFFu); } }
    __syncthreads();
    { const int r = F.lane & 31, hh = F.lane >> 5, ct = F.wave;
      const float da = -3.0701134573253945f, db = -15.350567286626973f;
      bf16x8 Af[4];
#pragma unroll
      for (int ks = 0; ks < 4; ++ks) Af[ks] = *(const LAS bf16x8*)(w3t + (32 * ct + r) * 72 + 16 * ks + 8 * hh);
      float delta[16], asum[16];
#pragma unroll
      for (int e = 0; e < 16; ++e) { const int col = cb * 256 + 32 * ct + (e & 3) + 8 * (e >> 2) + 4 * hh; delta[e] = fabsf(da + (float)col * ((db - da) / 1023.0f)); asum[e] = 0.f; }
      for (int pt = 0; pt < 8; ++pt) {
          f32x16 acc;
#pragma unroll
          for (int e = 0; e < 16; ++e) acc[e] = 0.f;
#pragma unroll
          for (int ks = 0; ks < 4; ++ks) { const LAS float* hp = h2s + (16 * ks + 8 * hh) * 256 + 32 * pt + r;
              u32x4 bw; bw.x = pk2(hp[0], hp[256]); bw.y = pk2(hp[512], hp[768]); bw.z = pk2(hp[1024], hp[1280]); bw.w = pk2(hp[1536], hp[1792]);
              bf16x8 Bf; __builtin_memcpy(&Bf, &bw, 16); acc = MFMA32(Af[ks], Bf, acc); }
          const int pp = pb * 256 + 32 * pt + r; const float tnp = (float)pp * (1.0f / (float)(n - 1));
#pragma unroll
          for (int e = 0; e < 16; ++e) { const int col = cb * 256 + 32 * ct + (e & 3) + 8 * (e >> 2) + 4 * hh;
              const float val = acc[e] * __expf(-tnp * delta[e]); HT[(size_t)col * n + pp] = val; asum[e] += fabsf(val); } }
#pragma unroll
      for (int e = 0; e < 16; ++e) { float sa = asum[e]; sa += __shfl_xor(sa, 1); sa += __shfl_xor(sa, 2); sa += __shfl_xor(sa, 4); sa += __shfl_xor(sa, 8); sa += __shfl_xor(sa, 16);
          if (r == 0) PS[(size_t)pb * 1024 + cb * 256 + 32 * ct + (e & 3) + 8 * (e >> 2) + 4 * hh] = sa; } }
    __syncthreads();
}
__device__ __forceinline__ void prologue_phase(const Frame F) {
    constexpr int U_TW = 32, U_ROPE = 6, U_LBC = 4, U_MOD = 192, U_F1 = 256, U_F1C = 4;
    constexpr int O_ROPE = U_TW, O_LBC = O_ROPE + U_ROPE, O_MOD = O_LBC + U_LBC, O_F1 = O_MOD + U_MOD, O_F1C = O_F1 + U_F1, TOTAL = O_F1C + U_F1C;
    for (int st = 0; st < 2; ++st) {
      const bool do_conv = ((F.bid & 1) != 0) == (st == 0);
      if (do_conv) { conv_stream(F, 0, 0, F.bid, 1408, F.G); }
      else {
    for (int u = (F.bid + 22) % F.G; u < TOTAL; u += F.G) {
        if (u < O_ROPE) { const int m = u * 512 + F.tid; float sn, c; sincospif((float)m * (1.0f / 8192.0f), &sn, &c); WSP(f2, WS_TW)[m] = mk2(c, -sn); }
        else if (u < O_LBC) { const int idx = (u - O_ROPE) * 512 + F.tid; const int pp = idx >> 4, i = idx & 15; const int pos = pp < 128 ? pp : pp - 128;
            const float inv = powf(10000.0f, -(float)i / 16.0f); const float ang = (float)pos * inv; WSP(f2, WS_ROPE)[idx] = mk2(cosf(ang), sinf(ang)); }
        else if (u < O_MOD) { const int idx = (u - O_LBC) * 512 + F.tid; const int l = idx >> 10, rem = idx & 1023;
            const float a0 = F.in[I_HGLB][rem], a1 = F.in[I_HGLB][1024 + rem];
            f2 o; if (l == 0) o = mk2(0.f, 1.f); else o = mk2(sigmoidf_(a1 - a0), sigmoidf_(a0 - a1));
            WSP(f2, WS_LBC)[idx] = o; }
        else if (u < O_F1) mod_unit(F, u - O_MOD);
        else { const int j = u - O_F1; const bool isc = j >= U_F1; const int l = isc ? 0 : (j >> 7), pb = isc ? 0 : ((j >> 2) & 31), cb = j & 3;
            f1_unit(F, l, pb, cb, isc ? 256 : 8192, isc ? WSP(float, WS_HTC) : WSP(float, WS_HT) + (size_t)l * 1024 * 8192, isc ? WSP(float, WS_PSC) : WSP(float, WS_PS) + (size_t)l * 32 * 1024); }
    }
      }
    }

}

constexpr int MF_FI = 34816, MF_U = 69632, MF_UI = MF_U + 34816;
__device__ __forceinline__ bf16x8 mf_frag(const LAS bf16_t* M, int row, int k0) { return *(const LAS bf16x8*)(M + row * 136 + k0); }
__device__ __forceinline__ bf16x8 mf_frag_perm(const LAS bf16_t* M, int row, int s, int g) {
    const u32x2 lo = *(const LAS u32x2*)(M + row * 136 + 32 * s + 4 * g), hi = *(const LAS u32x2*)(M + row * 136 + 32 * s + 16 + 4 * g);
    u32x4 w; w.x = lo.x; w.y = lo.y; w.z = hi.x; w.w = hi.y; bf16x8 r; __builtin_memcpy(&r, &w, 16); return r; }
__device__ __forceinline__ bf16x8 mf_pack4(unsigned a, unsigned b, unsigned c, unsigned d) { u32x4 w; w.x = a; w.y = b; w.z = c; w.w = d; bf16x8 r; __builtin_memcpy(&r, &w, 16); return r; }
__device__ __forceinline__ void mf_build_F(const Frame& F) {
    LAS bf16_t* FR = (LAS bf16_t*)F.lds; LAS bf16_t* FI = (LAS bf16_t*)(F.lds + MF_FI);
    for (int idx = F.tid; idx < 8192; idx += NT) { const int a = idx >> 6, b2 = (idx & 63) * 2;
        const float r0 = (float)((a * b2) & 127) * (1.0f / 128.0f), r1 = (float)((a * (b2 + 1)) & 127) * (1.0f / 128.0f);
        *(LAS unsigned*)(FR + a * 136 + b2) = pk2(__builtin_amdgcn_cosf(r0), __builtin_amdgcn_cosf(r1));
        *(LAS unsigned*)(FI + a * 136 + b2) = pk2(-__builtin_amdgcn_sinf(r0), -__builtin_amdgcn_sinf(r1)); }
}
template <int KS1, bool REALIN>
__device__ __forceinline__ void mf_s1(const Frame& F, int w, int r, int g) {
    const LAS bf16_t* FR = (const LAS bf16_t*)F.lds; const LAS bf16_t* FI = (const LAS bf16_t*)(F.lds + MF_FI);
    LAS bf16_t* UR = (LAS bf16_t*)(F.lds + MF_U); LAS bf16_t* UI = (LAS bf16_t*)(F.lds + MF_UI);
    bf16x8 xr[KS1], xi[KS1];
#pragma unroll
    for (int ks = 0; ks < KS1; ++ks) { xr[ks] = mf_frag(UR, 16 * w + r, 32 * ks + 8 * g); if (!REALIN) xi[ks] = mf_frag(UI, 16 * w + r, 32 * ks + 8 * g); }
    __syncthreads();
#pragma unroll 1
    for (int ct = 0; ct < 8; ++ct) {
        f32x4 rr = {0.f, 0.f, 0.f, 0.f}, ii = {0.f, 0.f, 0.f, 0.f}, ri = {0.f, 0.f, 0.f, 0.f};
#pragma unroll
        for (int ks = 0; ks < KS1; ++ks) { const bf16x8 fr = mf_frag(FR, 16 * ct + r, 32 * ks + 8 * g), fi = mf_frag(FI, 16 * ct + r, 32 * ks + 8 * g);
            rr = MFMA16(xr[ks], fr, rr); ri = MFMA16(xr[ks], fi, ri);
            if (!REALIN) { ii = MFMA16(xi[ks], fi, ii); ri = MFMA16(xi[ks], fr, ri); } }
        const int k1 = 16 * ct + r; float br[4], bi[4];
#pragma unroll
        for (int e = 0; e < 4; ++e) { const int n2 = 16 * w + 4 * g + e; const float re = rr[e] - ii[e], im = ri[e];
            const float rev = (float)(k1 * n2) * (1.0f / 16384.0f); const float c = __builtin_amdgcn_cosf(rev), sn = __builtin_amdgcn_sinf(rev);
            br[e] = re * c + im * sn; bi[e] = im * c - re * sn; }
        u32x2 wr, wi; wr.x = pk2(br[0], br[1]); wr.y = pk2(br[2], br[3]); wi.x = pk2(bi[0], bi[1]); wi.y = pk2(bi[2], bi[3]);
        *(LAS u32x2*)(UR + k1 * 136 + 16 * w + 4 * g) = wr; *(LAS u32x2*)(UI + k1 * 136 + 16 * w + 4 * g) = wi;
    }
    __syncthreads();
}
static __device__ __noinline__ void f2_unit(const Frame F, int l, int c) {
    const int w = __builtin_amdgcn_readfirstlane(F.tid >> 6), r = F.lane & 15, g = F.lane >> 4;
    const GAS float* HT = WSP(float, WS_HT) + (size_t)l * 1024 * 8192; const GAS float* PS = WSP(float, WS_PS) + (size_t)l * 32 * 1024;
    float S = 0.f;
    for (int pb = 0; pb < 32; ++pb) S += PS[pb * 1024 + c] + PS[pb * 1024 + 512 + c];
    S -= fabsf(HT[(size_t)(512 + c) * 8192]);
    const float inv = 1.0f / S;
    { LAS bf16_t* UR = (LAS bf16_t*)(F.lds + MF_U);
      const GAS float* hf = HT + (size_t)c * 8192; const GAS float* hb = HT + (size_t)(512 + c) * 8192;
      float v0[16], v1[16];
#pragma unroll
      for (int i = 0; i < 16; ++i) { const int idx = F.tid + NT * i; const int n2 = idx & 127, n1 = (idx >> 7) * 2; const int n = 128 * n1 + n2;
          if (i < 8) { v0[i] = hf[n]; v1[i] = hf[n + 128]; } else { v0[i] = hb[n == 8192 ? 1 : 16384 - n]; v1[i] = hb[16384 - n - 128]; if (n == 8192) v0[i] = 0.f; } }
      mf_build_F(F);
#pragma unroll
      for (int i = 0; i < 16; ++i) { const int idx = F.tid + NT * i; const int n2 = idx & 127, n1 = (idx >> 7) * 2;
          *(LAS unsigned*)(UR + n2 * 136 + n1) = pk2(v0[i] * inv, v1[i] * inv); } }
    __syncthreads();
    mf_s1<4, true>(F, w, r, g);
    { const LAS bf16_t* FR = (const LAS bf16_t*)F.lds; const LAS bf16_t* FI = (const LAS bf16_t*)(F.lds + MF_FI);
      const LAS bf16_t* UR = (const LAS bf16_t*)(F.lds + MF_U); const LAS bf16_t* UI = (const LAS bf16_t*)(F.lds + MF_UI);
      bf16x8 br[4], bi[4];
#pragma unroll
      for (int ks = 0; ks < 4; ++ks) { br[ks] = mf_frag(UR, 16 * w + r, 32 * ks + 8 * g); bi[ks] = mf_frag(UI, 16 * w + r, 32 * ks + 8 * g); }
      GAS f2* KF = WSP(f2, WS_KF) + (size_t)c * 16384 + (16 * w + r) * 128 + 4 * g;
#pragma unroll 1
      for (int t2 = 0; t2 < 8; ++t2) {
          f32x4 rr = {0.f, 0.f, 0.f, 0.f}, ii = {0.f, 0.f, 0.f, 0.f}, ri = {0.f, 0.f, 0.f, 0.f};
#pragma unroll
          for (int ks = 0; ks < 4; ++ks) { const bf16x8 fr = mf_frag(FR, 16 * t2 + r, 32 * ks + 8 * g), fi = mf_frag(FI, 16 * t2 + r, 32 * ks + 8 * g);
              rr = MFMA16(fr, br[ks], rr); ii = MFMA16(fi, bi[ks], ii); ri = MFMA16(fr, bi[ks], ri); ri = MFMA16(fi, br[ks], ri); }
          const float sc = 1.0f / 16384.0f;
          f32x4 o0, o1; o0[0] = (rr[0] - ii[0]) * sc; o0[1] = ri[0] * sc; o0[2] = (rr[1] - ii[1]) * sc; o0[3] = ri[1] * sc; o1[0] = (rr[2] - ii[2]) * sc; o1[1] = ri[2] * sc; o1[2] = (rr[3] - ii[3]) * sc; o1[3] = ri[3] * sc;
          *(GAS f32x4*)(KF + 16 * t2) = o0; *(GAS f32x4*)(KF + 16 * t2 + 2) = o1;
      } }
    __syncthreads();
}
static __device__ __noinline__ void y2_unit(const Frame F, int c) {
    const int w = __builtin_amdgcn_readfirstlane(F.tid >> 6), r = F.lane & 15, g = F.lane >> 4;
    const LAS bf16_t* FR = (const LAS bf16_t*)F.lds; const LAS bf16_t* FI = (const LAS bf16_t*)(F.lds + MF_FI);
    LAS bf16_t* UR = (LAS bf16_t*)(F.lds + MF_U); LAS bf16_t* UI = (LAS bf16_t*)(F.lds + MF_UI);
    { const GAS f2* UT = WSP(f2, WS_UT) + (size_t)c * 8192;
      f2 v0[8], v1[8];
#pragma unroll
      for (int i = 0; i < 8; ++i) { const int idx = F.tid + NT * i; const int n2 = idx & 127, n1 = (idx >> 7) * 2; v0[i] = UT[128 * n1 + n2]; v1[i] = UT[128 * n1 + 128 + n2]; }
      mf_build_F(F);
#pragma unroll
      for (int i = 0; i < 8; ++i) { const int idx = F.tid + NT * i; const int n2 = idx & 127, n1 = (idx >> 7) * 2;
          *(LAS unsigned*)(UR + n2 * 136 + n1) = pk2(v0[i].x, v1[i].x); *(LAS unsigned*)(UI + n2 * 136 + n1) = pk2(v0[i].y, v1[i].y); } }
    __syncthreads();
    mf_s1<2, false>(F, w, r, g);
    {
        const GAS f2* KF = WSP(f2, WS_KF) + (size_t)c * 16384 + (16 * w + r) * 128 + 4 * g;
        f32x4 kfa[2][2];
        kfa[0][0] = *(const GAS f32x4*)(KF); kfa[0][1] = *(const GAS f32x4*)(KF + 2); kfa[1][0] = *(const GAS f32x4*)(KF + 16); kfa[1][1] = *(const GAS f32x4*)(KF + 18);
        bf16x8 br[4], bi[4];
#pragma unroll
        for (int ks = 0; ks < 4; ++ks) { br[ks] = mf_frag(UR, 16 * w + r, 32 * ks + 8 * g); bi[ks] = mf_frag(UI, 16 * w + r, 32 * ks + 8 * g); }
        __syncthreads();
        unsigned zr[8][2], zi[8][2];
#pragma unroll
        for (int t2 = 0; t2 < 8; ++t2) {
            f32x4 rr = {0.f, 0.f, 0.f, 0.f}, ii = {0.f, 0.f, 0.f, 0.f}, ri = {0.f, 0.f, 0.f, 0.f};
#pragma unroll
            for (int ks = 0; ks < 4; ++ks) { const bf16x8 fr = mf_frag(FR, 16 * t2 + r, 32 * ks + 8 * g), fi = mf_frag(FI, 16 * t2 + r, 32 * ks + 8 * g);
                rr = MFMA16(fr, br[ks], rr); ii = MFMA16(fi, bi[ks], ii); ri = MFMA16(fr, bi[ks], ri); ri = MFMA16(fi, br[ks], ri); }
            const f32x4 k0 = kfa[t2 & 1][0], k1v = kfa[t2 & 1][1];
            if (t2 + 2 < 8) { kfa[t2 & 1][0] = *(const GAS f32x4*)(KF + 16 * (t2 + 2)); kfa[t2 & 1][1] = *(const GAS f32x4*)(KF + 16 * (t2 + 2) + 2); }
            float cr[4], ci[4];
#pragma unroll
            for (int e = 0; e < 4; ++e) { cr[e] = rr[e] - ii[e]; ci[e] = ri[e]; }
            const float z0r = cr[0] * k0[0] - ci[0] * k0[1], z0i = cr[0] * k0[1] + ci[0] * k0[0], z1r = cr[1] * k0[2] - ci[1] * k0[3], z1i = cr[1] * k0[3] + ci[1] * k0[2];
            const float z2r = cr[2] * k1v[0] - ci[2] * k1v[1], z2i = cr[2] * k1v[1] + ci[2] * k1v[0], z3r = cr[3] * k1v[2] - ci[3] * k1v[3], z3i = cr[3] * k1v[3] + ci[3] * k1v[2];
            zr[t2][0] = pk2(z0r, z1r); zr[t2][1] = pk2(z2r, z3r); zi[t2][0] = pk2(z0i, z1i); zi[t2][1] = pk2(z2i, z3i);
        }
#pragma unroll 1
        for (int tn = 0; tn < 8; ++tn) {
            f32x4 p = {0.f, 0.f, 0.f, 0.f}, q1 = {0.f, 0.f, 0.f, 0.f}, q2 = {0.f, 0.f, 0.f, 0.f};
#pragma unroll
            for (int sx = 0; sx < 4; ++sx) { const bf16x8 za = mf_pack4(zr[2 * sx][0], zr[2 * sx][1], zr[2 * sx + 1][0], zr[2 * sx + 1][1]), zb = mf_pack4(zi[2 * sx][0], zi[2 * sx][1], zi[2 * sx + 1][0], zi[2 * sx + 1][1]);
                const bf16x8 fr = mf_frag_perm(FR, 16 * tn + r, sx, g), fi = mf_frag_perm(FI, 16 * tn + r, sx, g);
                p = MFMA16(za, fr, p); p = MFMA16(zb, fi, p); q1 = MFMA16(zb, fr, q1); q2 = MFMA16(za, fi, q2); }
            const int n2 = 16 * tn + r; float ar[4], ai[4];
#pragma unroll
            for (int e = 0; e < 4; ++e) { const int k1 = 16 * w + 4 * g + e; const float re = p[e], im = q1[e] - q2[e];
                const float rev = (float)(k1 * n2) * (1.0f / 16384.0f); const float cs = __builtin_amdgcn_cosf(rev), sn = __builtin_amdgcn_sinf(rev);
                ar[e] = re * cs - im * sn; ai[e] = im * cs + re * sn; }
            u32x2 wr, wi; wr.x = pk2(ar[0], ar[1]); wr.y = pk2(ar[2], ar[3]); wi.x = pk2(ai[0], ai[1]); wi.y = pk2(ai[2], ai[3]);
            *(LAS u32x2*)(UR + n2 * 136 + 16 * w + 4 * g) = wr; *(LAS u32x2*)(UI + n2 * 136 + 16 * w + 4 * g) = wi;
        }
        __syncthreads();
    }
    {
        bf16x8 yr[4], yi[4];
#pragma unroll
        for (int ks = 0; ks < 4; ++ks) { yr[ks] = mf_frag(UR, 16 * w + r, 32 * ks + 8 * g); yi[ks] = mf_frag(UI, 16 * w + r, 32 * ks + 8 * g); }
        GAS f2* YT = WSP(f2, WS_YT) + (size_t)c * 8192 + 16 * w + r;
#pragma unroll 1
        for (int tn1 = 0; tn1 < 4; ++tn1) {
            f32x4 p = {0.f, 0.f, 0.f, 0.f}, q1 = {0.f, 0.f, 0.f, 0.f}, q2 = {0.f, 0.f, 0.f, 0.f};
#pragma unroll
            for (int ks = 0; ks < 4; ++ks) { const bf16x8 fr = mf_frag(FR, 16 * tn1 + r, 32 * ks + 8 * g), fi = mf_frag(FI, 16 * tn1 + r, 32 * ks + 8 * g);
                p = MFMA16(fr, yr[ks], p); p = MFMA16(fi, yi[ks], p); q1 = MFMA16(fr, yi[ks], q1); q2 = MFMA16(fi, yr[ks], q2); }
#pragma unroll
            for (int e = 0; e < 4; ++e) { const int n1 = 16 * tn1 + 4 * g + e; YT[128 * n1] = mk2(p[e], q1[e] - q2[e]); }
        }
    }
    __syncthreads();
}

__device__ __forceinline__ float hy_conv3(const GAS bf16_t* P, size_t row0, int t, int n, int col, const GAS float* cw, const GAS float* cb) {
    const GAS bf16_t* p = P + (row0 + t) * PC + P_HY + col;
    const float a = (t > 0) ? bf2f(p[-PC]) : 0.f, b = bf2f(p[0]), c = (t + 1 < n) ? bf2f(p[PC]) : 0.f;
    return a * cw[col] + b * cw[1536 + col] + c * cw[3072 + col] + cb[col];
}
__device__ __forceinline__ f32x4 hy_conv3x4(const GAS bf16_t* P, size_t row0, int t, int n, int col, const GAS float* cw, const GAS float* cb) {
    const GAS bf16_t* p = P + (row0 + t) * PC + P_HY + col;
    u32x2 ra = {0u, 0u}, rc = {0u, 0u};
    if (t > 0) ra = *(const GAS u32x2*)(p - PC);
    const u32x2 rb = *(const GAS u32x2*)p;
    if (t + 1 < n) rc = *(const GAS u32x2*)(p + PC);
    const f32x4 w0 = *(const GAS f32x4*)(cw + col), w1 = *(const GAS f32x4*)(cw + 1536 + col), w2 = *(const GAS f32x4*)(cw + 3072 + col), bb = *(const GAS f32x4*)(cb + col);
    f32x4 o;
    o[0] = lo16(ra.x) * w0[0] + lo16(rb.x) * w1[0] + lo16(rc.x) * w2[0] + bb[0];
    o[1] = hi16(ra.x) * w0[1] + hi16(rb.x) * w1[1] + hi16(rc.x) * w2[1] + bb[1];
    o[2] = lo16(ra.y) * w0[2] + lo16(rb.y) * w1[2] + lo16(rc.y) * w2[2] + bb[2];
    o[3] = hi16(ra.y) * w0[3] + hi16(rb.y) * w1[3] + hi16(rc.y) * w2[3] + bb[3];
    return o;
}
static __device__ __noinline__ void y1_unit(const Frame F, int l, int u) {
    const int nb = u >> 4, cbk = u & 15, n0 = nb * 64, c0 = cbk * 32;
    LAS f2* zt = (LAS f2*)F.lds;
    const GAS bf16_t* P = WSP(bf16_t, WS_P); const GAS float* cw = F.in[I_CW] + (size_t)l * 3 * 1536; const GAS float* cb = F.in[I_CB] + (size_t)l * 1536;
    { const int nn = F.tid >> 3, c4 = (F.tid & 7) * 4, n = n0 + nn, c = c0 + c4;
      const f32x4 a0 = hy_conv3x4(P, 0, n, SEQ, 512 + c, cw, cb), v0 = hy_conv3x4(P, 0, n, SEQ, 1024 + c, cw, cb);
      const f32x4 a1 = hy_conv3x4(P, SEQ, n, SEQ, 512 + c, cw, cb), v1 = hy_conv3x4(P, SEQ, n, SEQ, 1024 + c, cw, cb);
#pragma unroll
      for (int e = 0; e < 4; ++e) zt[(c4 + e) * 65 + nn] = mk2(a0[e] * v0[e], a1[e] * v1[e]); }
    __syncthreads();
    { const int nn = F.tid & 63, cg = F.tid >> 6; GAS f2* UT = WSP(f2, WS_UT);
#pragma unroll
      for (int i = 0; i < 4; ++i) { const int cc = cg + 8 * i; UT[(size_t)(c0 + cc) * 8192 + n0 + nn] = zt[cc * 65 + nn]; } }
    __syncthreads();
}
static __device__ __noinline__ void y3_unit(const Frame F, int l, int u) {
    const int nb = u >> 4, cbk = u & 15, n0 = nb * 64, c0 = cbk * 32;
    LAS f2* yt = (LAS f2*)F.lds;
    const GAS bf16_t* P = WSP(bf16_t, WS_P); const GAS float* cw = F.in[I_CW] + (size_t)l * 3 * 1536; const GAS float* cb = F.in[I_CB] + (size_t)l * 1536;
    const GAS float* skip = F.in[I_SKIP] + (size_t)l * 512;
    { const int nn = F.tid & 63, cg = F.tid >> 6; const GAS f2* YT = WSP(f2, WS_YT);
#pragma unroll
      for (int i = 0; i < 4; ++i) { const int cc = cg + 8 * i; yt[cc * 65 + nn] = YT[(size_t)(c0 + cc) * 8192 + n0 + nn]; } }
    __syncthreads();
    { const int nn = F.tid >> 3, c4 = (F.tid & 7) * 4, n = n0 + nn, c = c0 + c4; GAS bf16_t* MIX = WSP(bf16_t, WS_MIX);
      const f32x4 sk = *(const GAS f32x4*)(skip + c);
#pragma unroll
      for (int b = 0; b < 2; ++b) { const size_t r0 = (size_t)b * SEQ;
          const f32x4 x0 = hy_conv3x4(P, r0, n, SEQ, c, cw, cb), x1 = hy_conv3x4(P, r0, n, SEQ, 512 + c, cw, cb), v = hy_conv3x4(P, r0, n, SEQ, 1024 + c, cw, cb);
          float o[4];
#pragma unroll
          for (int e = 0; e < 4; ++e) { const f2 y = yt[(c4 + e) * 65 + nn]; const float yb = b ? y.y : y.x; o[e] = x0[e] * (yb + sk[e] * x1[e] * v[e]); }
          u32x2 w; w.x = pk2(o[0], o[1]); w.y = pk2(o[2], o[3]);
          *(GAS u32x2*)(MIX + (r0 + n) * 1536 + 1024 + c) = w; } }
    __syncthreads();
}
static __device__ __noinline__ void yctx_unit(const Frame F, int u) {
    const int tq = u & 3, cbk = (u >> 2) & 15, b = u >> 6;
    LAS float* zs = (LAS float*)F.lds;
    LAS float* gs = zs + 8192;
    LAS float* x0s = gs + 16384;
    const GAS bf16_t* P = WSP(bf16_t, WS_P); const GAS float* cw = F.in[I_CW]; const GAS float* cb = F.in[I_CB]; const GAS float* skip = F.in[I_SKIP];
    const GAS float* HTC = WSP(float, WS_HTC); const GAS float* PSC = WSP(float, WS_PSC);
    const size_t r0 = (size_t)RL + (size_t)b * CTX; const int c0 = cbk * 32, t0 = tq * 64;
    { const int c4 = (F.tid & 7) * 4;
#pragma unroll
      for (int i = 0; i < 4; ++i) { const int sidx = (F.tid >> 3) + 64 * i;
          const f32x4 x1 = hy_conv3x4(P, r0, sidx, CTX, 512 + c0 + c4, cw, cb), v = hy_conv3x4(P, r0, sidx, CTX, 1024 + c0 + c4, cw, cb);
#pragma unroll
          for (int e = 0; e < 4; ++e) zs[sidx * 32 + c4 + e] = x1[e] * v[e]; }
      { const int tt = F.tid >> 3; const f32x4 x0 = hy_conv3x4(P, r0, t0 + tt, CTX, c0 + c4, cw, cb);
#pragma unroll
        for (int e = 0; e < 4; ++e) x0s[tt * 32 + c4 + e] = x0[e]; } }
    { const int m = F.tid & 255, cg = F.tid >> 8;
#pragma unroll 4
      for (int i = 0; i < 16; ++i) { const int cc = cg * 16 + i, c = c0 + cc;
          const float inv = 1.0f / (PSC[c] + PSC[512 + c] - fabsf(HTC[(size_t)(512 + c) * 256]));
          gs[(255 + m) * 32 + cc] = HTC[(size_t)c * 256 + m] * inv;
          if (m >= 1) gs[(255 - m) * 32 + cc] = HTC[(size_t)(512 + c) * 256 + m] * inv; } }
    __syncthreads();
    { const int cc = F.tid & 31, tg = F.tid >> 5; const int tl = tg * 4;
      float a0 = 0.f, a1 = 0.f, a2 = 0.f, a3 = 0.f;
      const LAS float* gp = gs + (255 + t0 + tl) * 32 + cc; const LAS float* zp = zs + cc;
#pragma unroll 8
      for (int sidx = 0; sidx < 256; ++sidx) { const float zv = zp[sidx * 32];
          a0 += gp[(0 - sidx) * 32] * zv; a1 += gp[(1 - sidx) * 32] * zv; a2 += gp[(2 - sidx) * 32] * zv; a3 += gp[(3 - sidx) * 32] * zv; }
      GAS bf16_t* MIX = WSP(bf16_t, WS_MIX); const float sk = skip[c0 + cc];
      const float acc[4] = {a0, a1, a2, a3};
#pragma unroll
      for (int e = 0; e < 4; ++e) { const int t = t0 + tl + e;
          MIX[(r0 + t) * 1536 + 1024 + c0 + cc] = f2bf(x0s[(tl + e) * 32 + cc] * (acc[e] + sk * zs[t * 32 + cc])); } }
    __syncthreads();
}

__device__ __forceinline__ const GAS float* x_row(const Frame F, int l, int row) {
    if (l == 0) return row < RL ? F.in[I_X] + (size_t)row * 1024 : F.in[I_CTX] + (size_t)(row - RL) * 1024;
    return WSP(float, WS_XM) + (size_t)row * 1024;
}
static __device__ __noinline__ void norm1_rows(const Frame F, int l) {
    const GAS float* nm = F.in[I_NMIX] + (size_t)l * 1024; const GAS float* mod = WSP(float, WS_MOD) + (size_t)l * 3 * 6144; GAS bf16_t* HX = WSP(bf16_t, WS_HX);
    for (int row = F.bid * 8 + F.wave; row < R; row += F.G * 8) {
        const GAS float* src = x_row(F, l, row); const int rb = row < RL ? (row >> 13) : 2; const GAS float* md = mod + rb * 6144;
        f32x4 xa[2], xb[2]; float ss = 0.f;
#pragma unroll
        for (int i = 0; i < 2; ++i) { const int d0 = 8 * F.lane + 512 * i; xa[i] = *(const GAS f32x4*)(src + d0); xb[i] = *(const GAS f32x4*)(src + d0 + 4);
#pragma unroll
            for (int q = 0; q < 4; ++q) ss += xa[i][q] * xa[i][q] + xb[i][q] * xb[i][q]; }
        ss = wave_sum(ss); const float rs = rsqrtf(ss * (1.0f / 1024.0f) + EPS);
#pragma unroll
        for (int i = 0; i < 2; ++i) { const int d0 = 8 * F.lane + 512 * i;
            const f32x4 na = *(const GAS f32x4*)(nm + d0), nb = *(const GAS f32x4*)(nm + d0 + 4);
            const f32x4 sa = *(const GAS f32x4*)(md + 1024 + d0), sb = *(const GAS f32x4*)(md + 1024 + d0 + 4);
            const f32x4 ha = *(const GAS f32x4*)(md + d0), hb = *(const GAS f32x4*)(md + d0 + 4);
            float h[8];
#pragma unroll
            for (int q = 0; q < 4; ++q) { h[q] = xa[i][q] * rs * na[q] * (1.0f + sa[q]) + ha[q]; h[4 + q] = xb[i][q] * rs * nb[q] * (1.0f + sb[q]) + hb[q]; }
            u32x4 hw; hw.x = pk2(h[0], h[1]); hw.y = pk2(h[2], h[3]); hw.z = pk2(h[4], h[5]); hw.w = pk2(h[6], h[7]);
            *(GAS u32x4*)(HX + (size_t)row * 1024 + d0) = hw; }
    }
}
static __device__ __noinline__ void e1_phase(const Frame F, int l) {
    LAS float* wr = (LAS float*)F.lds;
    const GAS float* WR = F.in[I_WR] + (size_t)l * 1024 * 16;
    for (int idx = F.tid; idx < 16384; idx += NT) { const int d = idx >> 4, e = idx & 15; const int i = d >> 9, ln = (d >> 3) & 63, jj = d & 7; wr[((i * 8 + jj) * 64 + ln) * 16 + e] = WR[idx]; }
    __syncthreads();
    const GAS float* nm = F.in[I_NFFN] + (size_t)l * 1024; const GAS float* mod = WSP(float, WS_MOD) + (size_t)l * 3 * 6144; GAS bf16_t* HX = WSP(bf16_t, WS_HX);
    GAS float* AFF = WSP(float, WS_AFF);
    const int nrows = (l == 0) ? R : RL;
    for (int row = F.bid * 8 + F.wave; row < nrows; row += F.G * 8) {
        const GAS float* src = x_row(F, l, row); GAS float* xm = WSP(float, WS_XM) + (size_t)row * 1024; const GAS bf16_t* dl = WSP(bf16_t, WS_T) + (size_t)row * 1024;
        const int rb = row < RL ? (row >> 13) : 2; const GAS float* md = mod + rb * 6144;
        float v[16]; float ss = 0.f;
#pragma unroll
        for (int i = 0; i < 2; ++i) { const int d0 = 8 * F.lane + 512 * i;
            const f32x4 xa = *(const GAS f32x4*)(src + d0), xb = *(const GAS f32x4*)(src + d0 + 4); const u32x4 dw = *(const GAS u32x4*)(dl + d0);
            const f32x4 ga = *(const GAS f32x4*)(md + 2048 + d0), gb = *(const GAS f32x4*)(md + 2048 + d0 + 4);
            f32x4 ya, yb;
            ya[0] = xa[0] + ga[0] * lo16(dw.x); ya[1] = xa[1] + ga[1] * hi16(dw.x); ya[2] = xa[2] + ga[2] * lo16(dw.y); ya[3] = xa[3] + ga[3] * hi16(dw.y);
            yb[0] = xb[0] + gb[0] * lo16(dw.z); yb[1] = xb[1] + gb[1] * hi16(dw.z); yb[2] = xb[2] + gb[2] * lo16(dw.w); yb[3] = xb[3] + gb[3] * hi16(dw.w);
            *(GAS f32x4*)(xm + d0) = ya; *(GAS f32x4*)(xm + d0 + 4) = yb;
#pragma unroll
            for (int q = 0; q < 4; ++q) { v[8 * i + q] = ya[q]; v[8 * i + 4 + q] = yb[q]; ss += ya[q] * ya[q] + yb[q] * yb[q]; } }
        ss = wave_sum(ss); const float rs = rsqrtf(ss * (1.0f / 1024.0f) + EPS);
        float lg[16];
#pragma unroll
        for (int e = 0; e < 16; ++e) lg[e] = 0.f;
#pragma unroll
        for (int i = 0; i < 2; ++i) { const int d0 = 8 * F.lane + 512 * i;
            const f32x4 na = *(const GAS f32x4*)(nm + d0), nb = *(const GAS f32x4*)(nm + d0 + 4);
            const f32x4 sa = *(const GAS f32x4*)(md + 4096 + d0), sb = *(const GAS f32x4*)(md + 4096 + d0 + 4);
            const f32x4 ha = *(const GAS f32x4*)(md + 3072 + d0), hb = *(const GAS f32x4*)(md + 3072 + d0 + 4);
            float h[8];
#pragma unroll
            for (int q = 0; q < 4; ++q) { h[q] = v[8 * i + q] * rs * na[q] * (1.0f + sa[q]) + ha[q]; h[4 + q] = v[8 * i + 4 + q] * rs * nb[q] * (1.0f + sb[q]) + hb[q]; }
            u32x4 hw; hw.x = pk2(h[0], h[1]); hw.y = pk2(h[2], h[3]); hw.z = pk2(h[4], h[5]); hw.w = pk2(h[6], h[7]);
            *(GAS u32x4*)(HX + (size_t)row * 1024 + d0) = hw;
#pragma unroll
            for (int jj = 0; jj < 8; ++jj) {
#pragma unroll
                for (int q = 0; q < 4; ++q) { const f32x4 w = *(const LAS f32x4*)(wr + ((i * 8 + jj) * 64 + F.lane) * 16 + 4 * q);
                    lg[4 * q + 0] += h[jj] * w[0]; lg[4 * q + 1] += h[jj] * w[1]; lg[4 * q + 2] += h[jj] * w[2]; lg[4 * q + 3] += h[jj] * w[3]; }
                if (jj & 1) asm volatile("" ::: "memory"); } }
        float mx = -INFINITY;
#pragma unroll
        for (int e = 0; e < 16; ++e) { lg[e] = wave_sum(lg[e]); mx = fmaxf(mx, lg[e]); }
        float sum = 0.f;
#pragma unroll
        for (int e = 0; e < 16; ++e) { lg[e] = expf(lg[e] - mx); sum += lg[e]; }
        const float is = 1.0f / sum; float mine = 0.f;
#pragma unroll
        for (int e = 0; e < 16; ++e) mine = (F.lane == e) ? lg[e] * is : mine;
        { const bool isc = row >= RL; const int rr = isc ? row - RL : row; const int b = isc ? (rr >> 8) : (rr >> 13), n = isc ? (rr & 255) : (rr & 8191);
          const size_t li = isc ? (size_t)32 * 8192 + (size_t)(b * 16 + (F.lane & 15)) * 256 + n : (size_t)(b * 16 + (F.lane & 15)) * 8192 + n;
          if (F.lane < 16) AFF[li] = mine; }
    }
    __syncthreads();
}
__device__ __forceinline__ int e2_block_excl_scan(int v, LAS int* red, int lane, int wave) {
    int inc = v;
#pragma unroll
    for (int o = 1; o < 64; o <<= 1) { const int y = __shfl_up(inc, o); if (lane >= o) inc += y; }
    if (lane == 63) red[wave] = inc;
    __syncthreads();
    int base = inc - v;
#pragma unroll
    for (int w = 0; w < 8; ++w) { const int rw = red[w]; base += (w < wave) ? rw : 0; }
    __syncthreads();
    return base;
}
__device__ __forceinline__ void e2_unit(const Frame F, int list, bool isctx) {
    const int n = isctx ? CTX : SEQ, k = isctx ? CAPC : CAP;
    const int b = list >> 4, e = list & 15;
    const GAS float* aff = WSP(float, WS_AFF) + (isctx ? (size_t)32 * 8192 + (size_t)list * 256 : (size_t)list * 8192);
    GAS int* IDX = WSP(int, WS_IDX) + (isctx ? 32 * 1024 + list * 32 : list * 1024);
    GAS int* SLOT = WSP(int, WS_SLOT);
    LAS int* hist = (LAS int*)F.lds;
    LAS int* ctl = hist + 264;
    LAS int* red = hist + 272;
    const bool tvalid = F.tid * 16 < n;
    unsigned kh[16];
#pragma unroll
    for (int j = 0; j < 16; ++j) kh[j] = 0u;
    if (tvalid) {
#pragma unroll
        for (int j = 0; j < 16; ++j) kh[j] = __float_as_uint(aff[F.tid * 16 + j]); }
    unsigned prefix = 0u; int krem = k;
    for (int pass = 0; pass < 4; ++pass) {
        const int shift = 24 - 8 * pass;
        const unsigned himask = pass == 0 ? 0u : (0xFFFFFFFFu << (shift + 8));
        if (F.tid < 257) hist[F.tid] = 0;
        __syncthreads();
#pragma unroll
        for (int j = 0; j < 16; ++j) { const bool mt = tvalid && (kh[j] & himask) == (prefix & himask);
            __hip_atomic_fetch_add(hist + (mt ? (int)((kh[j] >> shift) & 255u) : 256), 1, __ATOMIC_RELAXED, __HIP_MEMORY_SCOPE_WORKGROUP); }
        __syncthreads();
        if (F.tid < 64) {
            const int L = F.tid; const int c0 = hist[4 * L], c1 = hist[4 * L + 1], c2 = hist[4 * L + 2], c3 = hist[4 * L + 3]; const int loc = c0 + c1 + c2 + c3;
            int suf = loc;
#pragma unroll
            for (int o = 1; o < 64; o <<= 1) { const int y = __shfl_down(suf, o); if (L + o < 64) suf += y; }
            const int above = suf - loc;
            const int cum3 = above + c3, cum2 = cum3 + c2, cum1 = cum2 + c1;
            const int bsel = cum3 >= krem ? 4 * L + 3 : (cum2 >= krem ? 4 * L + 2 : (cum1 >= krem ? 4 * L + 1 : 4 * L));
            const int cab = cum3 >= krem ? above : (cum2 >= krem ? cum3 : (cum1 >= krem ? cum2 : cum1));
            if (above < krem && above + loc >= krem) { ctl[0] = bsel; ctl[1] = cab; }
        }
        __syncthreads();
        prefix |= (unsigned)ctl[0] << shift; krem -= ctl[1];
        __syncthreads();
    }
    const unsigned th = prefix;
    int ceq = 0;
#pragma unroll
    for (int j = 0; j < 16; ++j) ceq += (tvalid && kh[j] == th) ? 1 : 0;
    int eqrun = e2_block_excl_scan(ceq, red, F.lane, F.wave);
    unsigned selmask = 0u; int csel = 0;
#pragma unroll
    for (int j = 0; j < 16; ++j) { const bool gt = tvalid && kh[j] > th, eq = tvalid && kh[j] == th;
        const bool sel = gt || (eq && eqrun < krem); eqrun += eq ? 1 : 0;
        selmask |= sel ? (1u << j) : 0u; csel += sel ? 1 : 0; }
    int base = e2_block_excl_scan(csel, red, F.lane, F.wave);
    if (tvalid) {
#pragma unroll
        for (int j = 0; j < 16; ++j) { const int i = F.tid * 16 + j; const bool sel = (selmask >> j) & 1u; const int row = isctx ? RL + b * CTX + i : b * SEQ + i;
            SLOT[(isctx ? (size_t)32 * 8192 + (size_t)list * 256 : (size_t)list * 8192) + i] = sel ? base : -1;
            if (sel) IDX[base] = i;
            base += sel ? 1 : 0; } }
}
static __device__ __noinline__ void e3_phase(const Frame F, int l) {
    const GAS bf16_t* HX = WSP(bf16_t, WS_HX); GAS bf16_t* XG = WSP(bf16_t, WS_XG); const GAS int* IDX = WSP(int, WS_IDX);
    const int total = 32768 + (l == 0 ? 1024 : 0);
    for (int j0 = (F.bid * 8 + F.wave) * 4; j0 < total; j0 += F.G * 8 * 4) {
        int src[4], dst[4];
#pragma unroll
        for (int q = 0; q < 4; ++q) { const int j = j0 + q;
            if (j < 32768) { const int e = j >> 11, rem = j & 2047, b = rem >> 10, slot = rem & 1023; src[q] = b * SEQ + IDX[(b * 16 + e) * 1024 + slot]; dst[q] = e * XROWS + rem; }
            else { const int jj = j - 32768; const int e = jj >> 6, rem = jj & 63, b = rem >> 5, slot = rem & 31; src[q] = RL + b * CTX + IDX[32 * 1024 + (b * 16 + e) * 32 + slot]; dst[q] = e * XROWS + 2048 + rem; } }
        u32x4 v[4][2];
#pragma unroll
        for (int q = 0; q < 4; ++q) { const GAS u32x4* sp = (const GAS u32x4*)(HX + (size_t)src[q] * 1024); v[q][0] = sp[F.lane]; v[q][1] = sp[64 + F.lane]; }
#pragma unroll
        for (int q = 0; q < 4; ++q) { GAS u32x4* dp = (GAS u32x4*)(XG + (size_t)dst[q] * 1024); dp[F.lane] = v[q][0]; dp[64 + F.lane] = v[q][1]; }
    }
}
static __device__ __noinline__ void e6_phase(const Frame F, int l) {
    const GAS bf16_t* Y = WSP(bf16_t, WS_Y); const GAS int* SLOT = WSP(int, WS_SLOT); const GAS float* AFF = WSP(float, WS_AFF);
    const GAS float* mod = WSP(float, WS_MOD) + (size_t)l * 3 * 6144; GAS float* XM = WSP(float, WS_XM);
    const GAS float* nm1 = F.in[I_NMIX] + 1024; const GAS float* mod1 = WSP(float, WS_MOD) + (size_t)3 * 6144; GAS bf16_t* HX = WSP(bf16_t, WS_HX);
    const int nrows = (l == 0) ? R : RL;
    for (int row = F.bid * 8 + F.wave; row < nrows; row += F.G * 8) {
        const bool isctx = row >= RL; const int rr = isctx ? row - RL : row; const int b = isctx ? (rr >> 8) : (rr >> 13); const int n = isctx ? (rr & 255) : (rr & 8191);
        int s = -1; float a = 0.f;
        if (F.lane < 16) { const size_t li = isctx ? (size_t)32 * 8192 + (size_t)(b * 16 + F.lane) * 256 + n : (size_t)(b * 16 + F.lane) * 8192 + n; s = SLOT[li]; a = AFF[li]; }
        const GAS float* xs = XM + (size_t)row * 1024;
        f32x4 xv[4];
#pragma unroll
        for (int i = 0; i < 2; ++i)
#pragma unroll
            for (int hq = 0; hq < 2; ++hq) xv[2 * i + hq] = *(const GAS f32x4*)(xs + 8 * F.lane + 512 * i + 4 * hq);
        unsigned long long mask = __ballot(s >= 0);
        const int off = isctx ? 2048 + b * 32 : b * 1024;
        float acc[16];
#pragma unroll
        for (int i = 0; i < 16; ++i) acc[i] = 0.f;
        while (mask) {
            u32x4 w[3][2]; float ae[3];
#pragma unroll
            for (int q = 0; q < 3; ++q) {
                if (mask) { const int e = __ffsll((long long)mask) - 1; mask &= mask - 1; const int se = __shfl(s, e); ae[q] = __shfl(a, e);
                    const GAS bf16_t* yr = Y + ((size_t)e * XROWS + off + se) * 1024 + 8 * F.lane; w[q][0] = *(const GAS u32x4*)(yr); w[q][1] = *(const GAS u32x4*)(yr + 512); }
                else { ae[q] = 0.f; w[q][0] = (u32x4){0u, 0u, 0u, 0u}; w[q][1] = (u32x4){0u, 0u, 0u, 0u}; } }
#pragma unroll
            for (int q = 0; q < 3; ++q)
#pragma unroll
                for (int i = 0; i < 2; ++i) { const u32x4 ww = w[q][i]; const float aq = ae[q];
                    acc[8 * i + 0] += aq * lo16(ww.x); acc[8 * i + 1] += aq * hi16(ww.x); acc[8 * i + 2] += aq * lo16(ww.y); acc[8 * i + 3] += aq * hi16(ww.y);
                    acc[8 * i + 4] += aq * lo16(ww.z); acc[8 * i + 5] += aq * hi16(ww.z); acc[8 * i + 6] += aq * lo16(ww.w); acc[8 * i + 7] += aq * hi16(ww.w); } }
        const int rb = isctx ? 2 : b; const GAS float* g2 = mod + rb * 6144 + 5 * 1024;
        GAS float* dst = (l == 1) ? F.out + (size_t)row * 1024 : XM + (size_t)row * 1024;
        float ss = 0.f;
#pragma unroll
        for (int i = 0; i < 2; ++i)
#pragma unroll
            for (int hq = 0; hq < 2; ++hq) { const int d0 = 8 * F.lane + 512 * i + 4 * hq;
                const f32x4 gv = *(const GAS f32x4*)(g2 + d0);
                f32x4 o;
#pragma unroll
                for (int q = 0; q < 4; ++q) { o[q] = xv[2 * i + hq][q] + gv[q] * acc[8 * i + 4 * hq + q]; ss += o[q] * o[q]; }
                xv[2 * i + hq] = o;
                *(GAS f32x4*)(dst + d0) = o; }
        if (l == 0) {
            ss = wave_sum(ss); const float rs = rsqrtf(ss * (1.0f / 1024.0f) + EPS); const GAS float* md = mod1 + rb * 6144;
#pragma unroll
            for (int i = 0; i < 2; ++i) { const int d0 = 8 * F.lane + 512 * i;
                const f32x4 na = *(const GAS f32x4*)(nm1 + d0), nb = *(const GAS f32x4*)(nm1 + d0 + 4);
                const f32x4 sa = *(const GAS f32x4*)(md + 1024 + d0), sb = *(const GAS f32x4*)(md + 1024 + d0 + 4);
                const f32x4 ha = *(const GAS f32x4*)(md + d0), hb = *(const GAS f32x4*)(md + d0 + 4);
                float h[8];
#pragma unroll
                for (int q = 0; q < 4; ++q) { h[q] = xv[2 * i][q] * rs * na[q] * (1.0f + sa[q]) + ha[q]; h[4 + q] = xv[2 * i + 1][q] * rs * nb[q] * (1.0f + sb[q]) + hb[q]; }
                u32x4 hw; hw.x = pk2(h[0], h[1]); hw.y = pk2(h[2], h[3]); hw.z = pk2(h[4], h[5]); hw.w = pk2(h[6], h[7]);
                *(GAS u32x4*)(HX + (size_t)row * 1024 + d0) = hw; }
        }
    }
}

__device__ __forceinline__ int hg_row(int dir, int b, int p, int rho) {
    if (dir == 0) return p < 4 ? RL + b * CTX + p * 64 + rho : b * SEQ + (p - 4) * 64 + rho;
    return p < 4 ? RL + b * CTX + (3 - p) * 64 + (63 - rho) : b * SEQ + (131 - p) * 64 + (63 - rho);
}
__device__ __forceinline__ u32x4 pack8(const float (&e)[16], int o) { u32x4 w; w.x = pk2(e[o], e[o + 1]); w.y = pk2(e[o + 2], e[o + 3]); w.z = pk2(e[o + 4], e[o + 5]); w.w = pk2(e[o + 6], e[o + 7]); return w; }
static __device__ __noinline__ void h1_unit(const Frame F, int u) {
    const int ch = u / NCH, p = u - ch * NCH; const int dir = ch >> 3, b = (ch >> 2) & 1, h = ch & 3;
    LAS bf16_t* KT = (LAS bf16_t*)F.lds; LAS bf16_t* VT = (LAS bf16_t*)(F.lds + 18432); LAS float* tot = (LAS float*)(F.lds + 36864);
    const GAS float* LF = WSP(float, WS_LF); const GAS bf16_t* P = WSP(bf16_t, WS_P);
    const int k = F.tid & 127, seg = F.tid >> 7;
    float lf[16]; u32x4 vreg[2];
#pragma unroll
    for (int j = 0; j < 16; ++j) { const int row = hg_row(dir, b, p, seg * 16 + j); lf[j] = LF[(size_t)row * 1024 + dir * 512 + h * 128 + k]; }
#pragma unroll
    for (int i = 0; i < 2; ++i) { const int idx8 = F.tid + NT * i; const int rho = idx8 >> 4, c8 = (idx8 & 15) * 8; const int row = hg_row(dir, b, p, rho);
        vreg[i] = *(const GAS u32x4*)(P + (size_t)row * PC + P_I + h * 128 + c8); }
    float cs[16]; float run = 0.f;
#pragma unroll
    for (int j = 0; j < 16; ++j) { run += lf[j]; cs[j] = run; }
    tot[seg * 128 + k] = run;
#pragma unroll
    for (int i = 0; i < 2; ++i) { const int idx8 = F.tid + NT * i; const int rho = idx8 >> 4, c8 = (idx8 & 15) * 8; LAS bf16_t* vt = VT + c8 * 72 + (rho ^ (((c8 >> 3) & 7) << 3));
        vt[0 * 72] = (bf16_t)(vreg[i].x & 0xFFFF); vt[1 * 72] = (bf16_t)(vreg[i].x >> 16); vt[2 * 72] = (bf16_t)(vreg[i].y & 0xFFFF); vt[3 * 72] = (bf16_t)(vreg[i].y >> 16);
        vt[4 * 72] = (bf16_t)(vreg[i].z & 0xFFFF); vt[5 * 72] = (bf16_t)(vreg[i].z >> 16); vt[6 * 72] = (bf16_t)(vreg[i].w & 0xFFFF); vt[7 * 72] = (bf16_t)(vreg[i].w >> 16); }
    __syncthreads();
    { const float t0 = tot[k], t1 = tot[128 + k], t2 = tot[256 + k], t3 = tot[384 + k];
      const float off = seg == 0 ? 0.f : (seg == 1 ? t0 : (seg == 2 ? t0 + t1 : t0 + t1 + t2)); const float rem = (t0 + t1 + t2 + t3) - off;
      if (seg == 0) WSP(float, WS_DEC)[(size_t)u * 128 + k] = __expf(rem);
      float kt[16];
#pragma unroll
      for (int j = 0; j < 16; ++j) kt[j] = (1.0f - __expf(lf[j])) * __expf(rem - cs[j]);
      *(LAS u32x4*)(KT + k * 72 + seg * 16) = pack8(kt, 0); *(LAS u32x4*)(KT + k * 72 + seg * 16 + 8) = pack8(kt, 8); }
    __syncthreads();
    { const int r = F.lane & 31, hh = F.lane >> 5; const int mt = F.wave >> 1, nt0 = (F.wave & 1) * 2;
      LAS bf16_t* stg = (LAS bf16_t*)(F.lds + 40960);
#pragma unroll
      for (int q = 0; q < 2; ++q) { const int nt = nt0 + q; f32x16 acc;
#pragma unroll
          for (int e = 0; e < 16; ++e) acc[e] = 0.f;
#pragma unroll
          for (int ks = 0; ks < 4; ++ks) { const bf16x8 A = *(const LAS bf16x8*)(VT + (32 * mt + r) * 72 + ((16 * ks + 8 * hh) ^ ((((32 * mt + r) >> 3) & 7) << 3))); const bf16x8 B = *(const LAS bf16x8*)(KT + (32 * nt + r) * 72 + 16 * ks + 8 * hh);
              acc = MFMA32(A, B, acc); }
#pragma unroll
          for (int e = 0; e < 16; e += 2) { const int vrow = 32 * mt + (e & 3) + 8 * (e >> 2) + 4 * hh; const unsigned w = pk2(acc[e], acc[e + 1]);
              stg[vrow * 136 + 32 * nt + r] = (bf16_t)(w & 0xFFFFu); stg[(vrow + 1) * 136 + 32 * nt + r] = (bf16_t)(w >> 16); } } }
    __syncthreads();
    { GAS bf16_t* dst = WSP(bf16_t, WS_DS) + (size_t)u * 16384; const LAS bf16_t* stg = (const LAS bf16_t*)(F.lds + 40960);
#pragma unroll
      for (int i = 0; i < 4; ++i) { const int idx = F.tid + NT * i; const int v = idx >> 4, k8 = (idx & 15) * 8; *(GAS u32x4*)(dst + v * 128 + k8) = *(const LAS u32x4*)(stg + v * 136 + k8); } }
    __syncthreads();
}
static __device__ __noinline__ void h2_phase(const Frame F) {
    LAS float* dcs = (LAS float*)F.lds;
    const int bidu = __builtin_amdgcn_readfirstlane(F.bid), Gu = __builtin_amdgcn_readfirstlane(F.G);
    for (int e0 = bidu * NT; e0 < 131072; e0 += Gu * NT) {
        const int ch = e0 >> 13; const unsigned el = (unsigned)(((e0 + F.tid) & 8191) * 2); const int k = el & 127;
        { const GAS float* DEC = WSP(float, WS_DEC) + (size_t)ch * NCH * 128;
          for (int idx = F.tid; idx < NCH * 32; idx += NT) *(LAS f32x4*)(dcs + idx * 4) = *(const GAS f32x4*)(DEC + idx * 4); }
        float s0 = 0.f, s1 = 0.f;
        const GAS bf16_t* DSu = WSP(bf16_t, WS_DS) + (size_t)ch * NCH * 16384; GAS bf16_t* STu = WSP(bf16_t, WS_ST) + (size_t)ch * NCH * 16384;
        unsigned ds[44];
#pragma unroll
        for (int j = 0; j < 44; ++j) ds[j] = *(const GAS unsigned*)(DSu + (size_t)j * 16384 + el);
        __syncthreads();
#pragma unroll 1
        for (int p0 = 0; p0 < NCH; p0 += 44) {
            const bool more = p0 + 44 < NCH;
#pragma unroll
            for (int j = 0; j < 44; ++j) { const f2 dc = *(const LAS f2*)(dcs + (p0 + j) * 128 + k); *(GAS unsigned*)(STu + (size_t)(p0 + j) * 16384 + el) = pk2(s0, s1); s0 = dc.x * s0 + lo16(ds[j]); s1 = dc.y * s1 + hi16(ds[j]);
                if (more) ds[j] = *(const GAS unsigned*)(DSu + (size_t)(p0 + 44 + j) * 16384 + el); }
        }
        __syncthreads();
    }
}
static __device__ __noinline__ void h3_unit(const Frame F, int u) {
    const int ch = u / NCH, p = u - ch * NCH; const int dir = ch >> 3, b = (ch >> 2) & 1, h = ch & 3;
    LAS float* bs = (LAS float*)F.lds;
    LAS bf16_t* ATT = (LAS bf16_t*)F.lds;
    LAS bf16_t* QF = (LAS bf16_t*)(F.lds + 32768);
    LAS bf16_t* QS = (LAS bf16_t*)(F.lds + 32768 + 17408);
    LAS bf16_t* KS = (LAS bf16_t*)(F.lds + 32768 + 2 * 17408);
    LAS bf16_t* VT = (LAS bf16_t*)(F.lds + 32768 + 2 * 17408 + 43520);
    const GAS float* LF = WSP(float, WS_LF); const GAS bf16_t* P = WSP(bf16_t, WS_P);
    f2 lfr[8]; unsigned qr[8]; bf16x8 sB[8];
    const int k2 = (F.tid & 63) * 2;
#pragma unroll
    for (int i = 0; i < 8; ++i) { const int rho = (F.tid >> 6) + 8 * i; const int row = hg_row(dir, b, p, rho);
        lfr[i] = *(const GAS f2*)(LF + (size_t)row * 1024 + dir * 512 + h * 128 + k2); qr[i] = *(const GAS unsigned*)(P + (size_t)row * PC + P_HQ + h * 128 + k2); }
    { const int r = F.lane & 31, hh = F.lane >> 5; const int nt = F.wave >> 1; const GAS bf16_t* ST = WSP(bf16_t, WS_ST) + (size_t)u * 16384;
#pragma unroll
      for (int ks = 0; ks < 8; ++ks) sB[ks] = *(const GAS bf16x8*)(ST + (32 * nt + r) * 128 + 16 * ks + 8 * hh); }
#pragma unroll
    for (int i = 0; i < 4; ++i) { const int idx = F.tid + NT * i; const int rho = idx >> 5, k4 = (idx & 31) * 4; const int row = hg_row(dir, b, p, rho);
        *(LAS f32x4*)(bs + rho * 128 + k4) = *(const GAS f32x4*)(LF + (size_t)row * 1024 + dir * 512 + h * 128 + k4); }
#pragma unroll
    for (int i = 0; i < 2; ++i) { const int idx8 = F.tid + NT * i; const int rho = idx8 >> 4, c8 = (idx8 & 15) * 8; const int row = hg_row(dir, b, p, rho);
        const u32x4 vv = *(const GAS u32x4*)(P + (size_t)row * PC + P_I + h * 128 + c8);
        LAS bf16_t* vt = VT + c8 * 72 + (rho ^ (((c8 >> 3) & 7) << 3));
        vt[0 * 72] = (bf16_t)(vv.x & 0xFFFF); vt[1 * 72] = (bf16_t)(vv.x >> 16); vt[2 * 72] = (bf16_t)(vv.y & 0xFFFF); vt[3 * 72] = (bf16_t)(vv.y >> 16);
        vt[4 * 72] = (bf16_t)(vv.z & 0xFFFF); vt[5 * 72] = (bf16_t)(vv.z >> 16); vt[6 * 72] = (bf16_t)(vv.w & 0xFFFF); vt[7 * 72] = (bf16_t)(vv.w >> 16); }
    __syncthreads();
    if (F.tid < 128) { float run = 0.f;
#pragma unroll 16
        for (int rho = 0; rho < 64; ++rho) { run += bs[rho * 128 + F.tid]; bs[rho * 128 + F.tid] = run; } }
    __syncthreads();
    { const f2 r1 = *(const LAS f2*)(bs + 15 * 128 + k2), r2 = *(const LAS f2*)(bs + 31 * 128 + k2), r3 = *(const LAS f2*)(bs + 47 * 128 + k2);
#pragma unroll
      for (int i = 0; i < 8; ++i) { const int rho = (F.tid >> 6) + 8 * i; const int i4 = rho >> 4;
        const f2 lf = lfr[i]; const float kc0 = 1.0f - __expf(lf.x), kc1 = 1.0f - __expf(lf.y);
        const float q0 = lo16(qr[i]), q1 = hi16(qr[i]);
        const f2 bb = *(const LAS f2*)(bs + rho * 128 + k2);
        const f2 ri = i4 == 0 ? mk2(0.f, 0.f) : (i4 == 1 ? r1 : (i4 == 2 ? r2 : r3));
        *(LAS unsigned*)(QF + rho * 136 + k2) = pk2(q0 * __expf(bb.x), q1 * __expf(bb.y)); *(LAS unsigned*)(QS + rho * 136 + k2) = pk2(q0 * __expf(bb.x - ri.x), q1 * __expf(bb.y - ri.y));
        if (i4 <= 0) *(LAS unsigned*)(KS + (0 + rho) * 136 + k2) = pk2(kc0 * __expf(0.f - bb.x), kc1 * __expf(0.f - bb.y));
        if (i4 <= 1) *(LAS unsigned*)(KS + (16 + rho) * 136 + k2) = pk2(kc0 * __expf(r1.x - bb.x), kc1 * __expf(r1.y - bb.y));
        if (i4 <= 2) *(LAS unsigned*)(KS + (48 + rho) * 136 + k2) = pk2(kc0 * __expf(r2.x - bb.x), kc1 * __expf(r2.y - bb.y));
        *(LAS unsigned*)(KS + (96 + rho) * 136 + k2) = pk2(kc0 * __expf(r3.x - bb.x), kc1 * __expf(r3.y - bb.y)); } }
    __syncthreads();
    for (int idx = F.tid; idx < 4096; idx += NT) { const int t = idx >> 6, s = idx & 63; if ((s >> 4) > (t >> 4)) ATT[t * 72 + s] = 0; }
    { const int c16 = F.lane & 15, g = F.lane >> 4;
      for (int bl = F.wave; bl < 10; bl += 8) {
          const int bi = bl < 1 ? 0 : (bl < 3 ? 1 : (bl < 6 ? 2 : 3)); const int bj = bl - (bi * (bi + 1)) / 2; const int kbase = bi == 0 ? 0 : (bi == 1 ? 16 : (bi == 2 ? 48 : 96));
          f32x4 acc = {0.f, 0.f, 0.f, 0.f};
#pragma unroll
          for (int ks = 0; ks < 4; ++ks) { const bf16x8 A = *(const LAS bf16x8*)(QS + (16 * bi + c16) * 136 + 32 * ks + 8 * g); const bf16x8 B = *(const LAS bf16x8*)(KS + (kbase + 16 * bj + c16) * 136 + 32 * ks + 8 * g);
              acc = MFMA16(A, B, acc); }
#pragma unroll
          for (int e = 0; e < 4; ++e) { const int t = 4 * g + e, s = c16; const float val = (bi == bj && s > t) ? 0.f : acc[e]; ATT[(16 * bi + t) * 72 + 16 * bj + s] = f2bf(val); } } }
    __syncthreads();
    { const int r = F.lane & 31, hh = F.lane >> 5; const int mt = F.wave & 1, nt = F.wave >> 1;
      const GAS bf16_t* ST = WSP(bf16_t, WS_ST) + (size_t)u * 16384;
      f32x16 acc;
#pragma unroll
      for (int e = 0; e < 16; ++e) acc[e] = 0.f;
#pragma unroll
      for (int ks = 0; ks < 8; ++ks) { const bf16x8 A = *(const LAS bf16x8*)(QF + (32 * mt + r) * 136 + 16 * ks + 8 * hh); acc = MFMA32(A, sB[ks], acc); }
#pragma unroll
      for (int ks = 0; ks < 4; ++ks) { const bf16x8 A = *(const LAS bf16x8*)(ATT + (32 * mt + r) * 72 + 16 * ks + 8 * hh); const bf16x8 B = *(const LAS bf16x8*)(VT + (32 * nt + r) * 72 + ((16 * ks + 8 * hh) ^ ((((32 * nt + r) >> 3) & 7) << 3)));
          acc = MFMA32(A, B, acc); }
      GAS float* OH = WSP(float, WS_OH) + (size_t)dir * R * 512;
#pragma unroll
      for (int e = 0; e < 16; ++e) { const int t = 32 * mt + (e & 3) + 8 * (e >> 2) + 4 * hh; const int row = hg_row(dir, b, p, t); OH[(size_t)row * 512 + h * 128 + 32 * nt + r] = acc[e]; } }
    __syncthreads();
}
static __device__ __noinline__ void h4_phase(const Frame F, int l) {
    const GAS float* OH = WSP(float, WS_OH); const GAS bf16_t* P = WSP(bf16_t, WS_P); GAS bf16_t* MIX = WSP(bf16_t, WS_MIX);
    const int nrows = (l == 0) ? R : RL;
    for (int row = F.bid * 8 + F.wave; row < nrows; row += F.G * 8) {
        const int c = 8 * F.lane;
        const f32x4 a0 = *(const GAS f32x4*)(OH + (size_t)row * 512 + c), a1 = *(const GAS f32x4*)(OH + (size_t)row * 512 + c + 4);
        const f32x4 b0 = *(const GAS f32x4*)(OH + ((size_t)R + row) * 512 + c), b1 = *(const GAS f32x4*)(OH + ((size_t)R + row) * 512 + c + 4);
        const f32x4 o0 = a0 + b0, o1 = a1 + b1;
        float ss = o0[0] * o0[0] + o0[1] * o0[1] + o0[2] * o0[2] + o0[3] * o0[3] + o1[0] * o1[0] + o1[1] * o1[1] + o1[2] * o1[2] + o1[3] * o1[3];
        ss += __shfl_xor(ss, 1); ss += __shfl_xor(ss, 2); ss += __shfl_xor(ss, 4); ss += __shfl_xor(ss, 8);
        const float rn = rsqrtf(ss * (1.0f / 128.0f) + EPS);
        const u32x4 gt = *(const GAS u32x4*)(P + (size_t)row * PC + P_HG + c);
        u32x4 w; w.x = pk2(o0[0] * rn * lo16(gt.x), o0[1] * rn * hi16(gt.x)); w.y = pk2(o0[2] * rn * lo16(gt.y), o0[3] * rn * hi16(gt.y));
        w.z = pk2(o1[0] * rn * lo16(gt.z), o1[1] * rn * hi16(gt.z)); w.w = pk2(o1[2] * rn * lo16(gt.w), o1[3] * rn * hi16(gt.w));
        *(GAS u32x4*)(MIX + (size_t)row * 1536 + c) = w;
    }
}

__device__ __forceinline__ void na_norm(const u32x4 ra, const u32x4 rb, int hf, int sub, const GAS float* gain, float (&a)[8], float (&bq)[8]) {
    a[0] = lo16(ra.x); a[1] = hi16(ra.x); a[2] = lo16(ra.y); a[3] = hi16(ra.y); a[4] = lo16(ra.z); a[5] = hi16(ra.z); a[6] = lo16(ra.w); a[7] = hi16(ra.w);
    bq[0] = lo16(rb.x); bq[1] = hi16(rb.x); bq[2] = lo16(rb.y); bq[3] = hi16(rb.y); bq[4] = lo16(rb.z); bq[5] = hi16(rb.z); bq[6] = lo16(rb.w); bq[7] = hi16(rb.w);
    float ss = 0.f;
#pragma unroll
    for (int j = 0; j < 8; ++j) ss += a[j] * a[j] + bq[j] * bq[j];
    ss += __shfl_xor(ss, 1); ss += __shfl_xor(ss, 2);
    const float rn = rsqrtf(ss * (1.0f / 64.0f) + EPS);
#pragma unroll
    for (int j = 0; j < 8; ++j) { a[j] *= rn * gain[32 * hf + 8 * sub + j]; bq[j] *= rn * gain[32 * hf + 16 + 8 * sub + j]; }
}
__device__ __forceinline__ void na_store16(LAS bf16_t* dst, const float (&a)[8], const float (&bq)[8], float sc) {
    u32x4 w; w.x = pk2(a[0] * sc, a[1] * sc); w.y = pk2(a[2] * sc, a[3] * sc); w.z = pk2(a[4] * sc, a[5] * sc); w.w = pk2(a[6] * sc, a[7] * sc);
    *(LAS u32x4*)dst = w;
    w.x = pk2(bq[0] * sc, bq[1] * sc); w.y = pk2(bq[2] * sc, bq[3] * sc); w.z = pk2(bq[4] * sc, bq[5] * sc); w.w = pk2(bq[6] * sc, bq[7] * sc);
    *(LAS u32x4*)(dst + 16) = w;
}
__device__ __forceinline__ void na_rope(float (&a)[8], float (&bq)[8], const LAS f2* rt, int sub) {
#pragma unroll
    for (int j = 0; j < 8; ++j) { const f2 cs = rt[8 * sub + j]; const float x = a[j], y = bq[j]; a[j] = x * cs.x - y * cs.y; bq[j] = x * cs.y + y * cs.x; }
}
static __device__ __noinline__ void nk_unit(const Frame F, int l, int u) {
    GAS bf16_t* P = WSP(bf16_t, WS_P); const GAS f2* ROPE = WSP(f2, WS_ROPE); const GAS float* kg = F.in[I_KG] + (size_t)l * 64;
    const int row = u * 16 + (F.tid >> 5), head = (F.tid >> 2) & 7, part = F.tid & 3, hf = part >> 1, sub = part & 1;
    GAS bf16_t* kp = P + (size_t)row * PC + P_NK + head * 64 + 32 * hf + 8 * sub;
    const u32x4 ra = *(const GAS u32x4*)kp, rb = *(const GAS u32x4*)(kp + 16);
    float a[8], bq[8];
    na_norm(ra, rb, hf, sub, kg, a, bq);
    if (row < RL) { const int rr = (row >> 6) & 127, cc = row & 63;
        const GAS f2* rt = ROPE + (hf == 0 ? rr * 16 : 128 * 16 + cc * 16) + 8 * sub;
#pragma unroll
        for (int j = 0; j < 8; ++j) { const f2 cs = rt[j]; const float x = a[j], y = bq[j]; a[j] = x * cs.x - y * cs.y; bq[j] = x * cs.y + y * cs.x; } }
    u32x4 w; w.x = pk2(a[0], a[1]); w.y = pk2(a[2], a[3]); w.z = pk2(a[4], a[5]); w.w = pk2(a[6], a[7]);
    *(GAS u32x4*)kp = w;
    w.x = pk2(bq[0], bq[1]); w.y = pk2(bq[2], bq[3]); w.z = pk2(bq[4], bq[5]); w.w = pk2(bq[6], bq[7]);
    *(GAS u32x4*)(kp + 16) = w;
}
static __device__ __noinline__ void na_unit(const Frame F, int l, int u, bool ctxq) {
    const int hp = u & 3, br = u >> 2; const int b = ctxq ? (br >> 2) : (br >> 7); const int r = ctxq ? (br & 3) : (br & 127);
    const int hs = F.wave >> 2, head = hp * 2 + hs, wq = F.wave & 3, tl = F.tid & 255;
    LAS unsigned char* hb = F.lds + hs * 54272;
    LAS bf16_t* QR = (LAS bf16_t*)hb; LAS bf16_t* QP = (LAS bf16_t*)(hb + 9216); LAS bf16_t* KT = (LAS bf16_t*)(hb + 18432); LAS bf16_t* VT = (LAS bf16_t*)(hb + 36864);
    LAS float* rpb = (LAS float*)(F.lds + 108544) + hs * 465;
    LAS f2* crope = (LAS f2*)(F.lds + 112640);
    LAS f2* rrope = (LAS f2*)(F.lds + 120832);
    const GAS bf16_t* P = WSP(bf16_t, WS_P); const GAS f2* ROPE = WSP(f2, WS_ROPE);
    const GAS float* qg = F.in[I_QG] + (size_t)l * 64; const GAS float* kg = F.in[I_KG] + (size_t)l * 64;
    const int rs = min(max(r - 4, 0), 120);
    const size_t qrow0 = ctxq ? (size_t)RL + (size_t)b * CTX + (size_t)r * 64 : (size_t)b * SEQ + (size_t)r * 64;
    for (int idx = tl; idx < 465; idx += 256) rpb[idx] = F.in[I_RPB][((size_t)l * 8 + head) * 465 + idx];
    for (int idx = F.tid; idx < 1024; idx += NT) crope[idx] = ROPE[128 * 16 + idx];
    if (F.tid < 144) { const int rr = F.tid >> 4; rrope[F.tid] = ROPE[(rr < 8 ? rs + rr : r) * 16 + (F.tid & 15)]; }
    __syncthreads();
    { const int qi = tl >> 2, part = tl & 3, hf = part >> 1, sub = part & 1;
      float a[8], bq[8];
      { const GAS bf16_t* qp = P + (qrow0 + qi) * PC + P_NQ + head * 64;
        na_norm(*(const GAS u32x4*)(qp + 32 * hf + 8 * sub), *(const GAS u32x4*)(qp + 32 * hf + 16 + 8 * sub), hf, sub, qg, a, bq); }
      na_store16(QP + qi * 72 + 32 * hf + 8 * sub, a, bq, 0.125f);
      if (!ctxq) { na_rope(a, bq, hf == 0 ? rrope + 8 * 16 : crope + qi * 16, sub); na_store16(QR + qi * 72 + 32 * hf + 8 * sub, a, bq, 0.125f); } }
    __syncthreads();
    const int c16 = F.lane & 15, g = F.lane >> 4;
    f32x4 O[4];
#pragma unroll
    for (int dt = 0; dt < 4; ++dt) O[dt] = (f32x4){0.f, 0.f, 0.f, 0.f};
    float m_run = -1e30f, l_run = 0.f;
    const int qc = 16 * wq + c16;
    const int cs = min(max(qc - 8, 0), 48);
    u32x4 kr[2][2];
#define NA_LOAD(KT) do { _Pragma("unroll") for (int it = 0; it < 2; ++it) { const int item = tl + 256 * it; const int kap = item >> 2, part = item & 3, hf = part >> 1, sub = part & 1; \
        const bool w_ = (KT) < 4; const int kr_ = rs + 2 * (KT) + (kap >> 6), kc_ = kap & 63; \
        const size_t row = w_ ? (size_t)b * SEQ + (size_t)kr_ * 64 + kc_ : (size_t)RL + (size_t)b * CTX + (size_t)((KT) - 4) * 128 + kap; \
        const GAS bf16_t* kp = P + row * PC + P_NK + head * 64; const GAS bf16_t* vp = P + row * PC + P_NV + head * 64; \
        if (it == 0) { kr[it][0] = *(const GAS u32x4*)(kp + 32 * hf + 8 * sub); kr[it][1] = *(const GAS u32x4*)(kp + 32 * hf + 16 + 8 * sub); } (void)vp; } } while (0)
    for (int kt = ctxq ? 4 : 0; kt < 6; ++kt) {
        const bool win = kt < 4;
        u32x4 vr[2][2];
#pragma unroll
        for (int it = 0; it < 2; ++it) { const int item = tl + 256 * it; const int kap = item >> 2, part = item & 3, hf = part >> 1, sub = part & 1; const int kr_ = rs + 2 * kt + (kap >> 6), kc_ = kap & 63;
            const size_t row = win ? (size_t)b * SEQ + (size_t)kr_ * 64 + kc_ : (size_t)RL + (size_t)b * CTX + (size_t)(kt - 4) * 128 + kap;
            const GAS bf16_t* vp = P + row * PC + P_NV + head * 64;
            vr[it][0] = *(const GAS u32x4*)(vp + 32 * hf + 8 * sub); vr[it][1] = *(const GAS u32x4*)(vp + 32 * hf + 16 + 8 * sub);
            kr[it][0] = *(const GAS u32x4*)(P + row * PC + P_NK + head * 64 + 32 * hf + 8 * sub); kr[it][1] = *(const GAS u32x4*)(P + row * PC + P_NK + head * 64 + 32 * hf + 16 + 8 * sub); }
#pragma unroll
        for (int it = 0; it < 2; ++it) { const int item = tl + 256 * it; const int kap = item >> 2, part = item & 3, hf = part >> 1, sub = part & 1;
            const int kr_ = rs + 2 * kt + (kap >> 6), kc_ = kap & 63;
            *(LAS u32x4*)(KT + kap * 72 + 32 * hf + 8 * sub) = kr[it][0]; *(LAS u32x4*)(KT + kap * 72 + 32 * hf + 8 * sub + 16) = kr[it][1];
            const u32x4 va = vr[it][0], vb = vr[it][1];
            LAS bf16_t* vt = VT + (32 * hf + 8 * sub) * 132 + (kap ^ (hf << 4));
            vt[0 * 132] = (bf16_t)(va.x & 0xFFFF); vt[1 * 132] = (bf16_t)(va.x >> 16); vt[2 * 132] = (bf16_t)(va.y & 0xFFFF); vt[3 * 132] = (bf16_t)(va.y >> 16);
            vt[4 * 132] = (bf16_t)(va.z & 0xFFFF); vt[5 * 132] = (bf16_t)(va.z >> 16); vt[6 * 132] = (bf16_t)(va.w & 0xFFFF); vt[7 * 132] = (bf16_t)(va.w >> 16);
            vt += 16 * 132;
            vt[0 * 132] = (bf16_t)(vb.x & 0xFFFF); vt[1 * 132] = (bf16_t)(vb.x >> 16); vt[2 * 132] = (bf16_t)(vb.y & 0xFFFF); vt[3 * 132] = (bf16_t)(vb.y >> 16);
            vt[4 * 132] = (bf16_t)(vb.z & 0xFFFF); vt[5 * 132] = (bf16_t)(vb.z >> 16); vt[6 * 132] = (bf16_t)(vb.w & 0xFFFF); vt[7 * 132] = (bf16_t)(vb.w >> 16); }
        __syncthreads();
        f32x4 s[8];
        float mt_max = -1e30f;
        const unsigned skS = (unsigned)__builtin_amdgcn_readfirstlane(win ? (wq == 0 ? 0xCC : (wq == 3 ? 0x33 : (wq == 1 ? 0x88 : 0x11))) : 0);
        const unsigned skP = (unsigned)__builtin_amdgcn_readfirstlane(win ? (wq == 0 ? 0xA : (wq == 3 ? 0x5 : 0)) : 0);
        const LAS bf16_t* QX = win ? QR : QP;
        const bf16x8 q0 = *(const LAS bf16x8*)(QX + (16 * wq + c16) * 72 + 8 * g), q1 = *(const LAS bf16x8*)(QX + (16 * wq + c16) * 72 + 32 + 8 * g);
#pragma unroll
        for (int mt = 0; mt < 8; ++mt) {
            f32x4 acc = {0.f, 0.f, 0.f, 0.f};
            if ((skS >> mt) & 1u) { s[mt] = (f32x4){-1e30f, -1e30f, -1e30f, -1e30f}; continue; }
            const bf16x8 A0 = *(const LAS bf16x8*)(KT + (16 * mt + c16) * 72 + 8 * g), A1 = *(const LAS bf16x8*)(KT + (16 * mt + c16) * 72 + 32 + 8 * g);
            acc = MFMA16(A0, q0, acc); acc = MFMA16(A1, q1, acc);
            if (win) { const int kr = rs + 2 * kt + (mt >> 2);
#pragma unroll
                for (int e = 0; e < 4; ++e) { const int kc = 16 * (mt & 3) + 4 * g + e; const bool valid = (kc >= cs) && (kc < cs + 16);
                    const int bi = (kr - r + 7) * 31 + (kc - qc + 15);
                    acc[e] = valid ? acc[e] + rpb[valid ? bi : 0] : -1e30f; } }
            s[mt] = acc;
            mt_max = fmaxf(mt_max, fmaxf(fmaxf(acc[0], acc[1]), fmaxf(acc[2], acc[3])));
        }
        mt_max = fmaxf(mt_max, __shfl_xor(mt_max, 16)); mt_max = fmaxf(mt_max, __shfl_xor(mt_max, 32));
        const float m_new = fmaxf(m_run, mt_max); const float alpha = __expf(m_run - m_new); m_run = m_new;
        float psum = 0.f;
#pragma unroll
        for (int mt = 0; mt < 8; ++mt)
#pragma unroll
            for (int e = 0; e < 4; ++e) { const float pv = __expf(s[mt][e] - m_new); s[mt][e] = pv; psum += pv; }
        l_run = l_run * alpha + psum;
#pragma unroll
        for (int dt = 0; dt < 4; ++dt) O[dt] *= alpha;
#pragma unroll
        for (int k2 = 0; k2 < 4; ++k2) {
            if ((skP >> k2) & 1u) continue;
            u32x4 pw; pw.x = pk2(s[2 * k2][0], s[2 * k2][1]); pw.y = pk2(s[2 * k2][2], s[2 * k2][3]); pw.z = pk2(s[2 * k2 + 1][0], s[2 * k2 + 1][1]); pw.w = pk2(s[2 * k2 + 1][2], s[2 * k2 + 1][3]);
            bf16x8 pf; __builtin_memcpy(&pf, &pw, 16);
#pragma unroll
            for (int dt = 0; dt < 4; ++dt) {
                const u32x2 lo = *(const LAS u32x2*)(VT + (16 * dt + c16) * 132 + 32 * k2 + 4 * g + (dt >= 2 ? 16 : 0)), hi = *(const LAS u32x2*)(VT + (16 * dt + c16) * 132 + 32 * k2 + 4 * g + (dt >= 2 ? 0 : 16));
                u32x4 aw; aw.x = lo.x; aw.y = lo.y; aw.z = hi.x; aw.w = hi.y; bf16x8 af; __builtin_memcpy(&af, &aw, 16);
                O[dt] = MFMA16(af, pf, O[dt]); } }
        __syncthreads();
    }
    l_run += __shfl_xor(l_run, 16); l_run += __shfl_xor(l_run, 32);
    const float inv = 1.0f / l_run;
    GAS bf16_t* MIX = WSP(bf16_t, WS_MIX) + (qrow0 + qc) * 1536 + 512 + head * 64;
#pragma unroll
    for (int dt = 0; dt < 4; ++dt) { u32x2 w; w.x = pk2(O[dt][0] * inv, O[dt][1] * inv); w.y = pk2(O[dt][2] * inv, O[dt][3] * inv); *(GAS u32x2*)(MIX + 16 * dt + 4 * g) = w; }
}


static __device__ __noinline__ void gs_phase(const Frame F, int l) {
    const GAS bf16_t* T = WSP(bf16_t, WS_T); const GAS bf16_t* P = WSP(bf16_t, WS_P); GAS bf16_t* M = WSP(bf16_t, WS_HX);
    const int nrows = (l == 0) ? R : RL;
    for (int row = F.bid * 8 + F.wave; row < nrows; row += F.G * 8) {
        const GAS bf16_t* tp = T + (size_t)row * 3072 + 8 * F.lane; const GAS bf16_t* gp = P + (size_t)row * PC + P_GATE + 8 * F.lane;
        u32x4 t[3][2], g[3][2];
#pragma unroll
        for (int br = 0; br < 3; ++br)
#pragma unroll
            for (int i = 0; i < 2; ++i) { t[br][i] = *(const GAS u32x4*)(tp + 1024 * br + 512 * i); g[br][i] = *(const GAS u32x4*)(gp + 1024 * br + 512 * i); }
#pragma unroll
        for (int i = 0; i < 2; ++i) { u32x4 w;
#define GS_MIX(F_) (lo16(t[0][i].F_) * lo16(g[0][i].F_) + lo16(t[1][i].F_) * lo16(g[1][i].F_) + lo16(t[2][i].F_) * lo16(g[2][i].F_))
#define GS_MIXH(F_) (hi16(t[0][i].F_) * hi16(g[0][i].F_) + hi16(t[1][i].F_) * hi16(g[1][i].F_) + hi16(t[2][i].F_) * hi16(g[2][i].F_))
            w.x = pk2(GS_MIX(x), GS_MIXH(x)); w.y = pk2(GS_MIX(y), GS_MIXH(y)); w.z = pk2(GS_MIX(z), GS_MIXH(z)); w.w = pk2(GS_MIX(w), GS_MIXH(w));
#undef GS_MIX
#undef GS_MIXH
            *(GAS u32x4*)(M + (size_t)row * 1024 + 8 * F.lane + 512 * i) = w; }
    }
}

struct EpiNull {
    static constexpr bool PERM = true;
    __device__ __forceinline__ void operator()(const f32x4 (&acc)[2][2][4][2], const pg8::Unit& u, int wr, int wc, int fr, int fq) const {
#pragma unroll
        for (int ai = 0; ai < 2; ++ai)
#pragma unroll
            for (int bj = 0; bj < 2; ++bj)
#pragma unroll
                for (int m = 0; m < 4; ++m)
#pragma unroll
                    for (int n = 0; n < 2; ++n) asm volatile("" :: "v"(acc[ai][bj][m][n]));
    }
};
template <int MODE>
static __device__ __forceinline__ void gemm_run_t(Frame F, int l) {
    asm volatile("" : "+s"(F.ws), "+s"(l));
    const bool ctx_on = (l == 0);
    if constexpr (MODE == 0) {
        pg8::Gemm g{1024, 1024, 1024};
        SchedIn S{(const char*)WSP(bf16_t, WS_HX), (const char*)(WSP(bf16_t, WS_WIN) + (size_t)l * INC * 1024), F.G, F.bid, ctx_on ? 34 : 10};
        EpiIn E{WSP(float, WS_LF), WSP(bf16_t, WS_P), WSP(f2, WS_LBC) + (size_t)l * 1024};
        pg8::gemm_phase(F.lds, g, S, E, true);
    } else if constexpr (MODE == 1) {
        pg8::Gemm g{1536, 512, 512};
        SchedBr S{(const char*)WSP(bf16_t, WS_MIX), (const char*)(WSP(bf16_t, WS_WBR) + (size_t)l * 3 * 1024 * 512), F.G, F.bid, ctx_on ? 66 : 64};
        EpiBr E{WSP(bf16_t, WS_T), WSP(bf16_t, WS_P)};
        pg8::gemm_phase(F.lds, g, S, E, true);
    } else if constexpr (MODE == 2) {
        pg8::Gemm g{1024, 3072, 1024};
        SchedOut S{(const char*)WSP(bf16_t, WS_HX), (const char*)(WSP(bf16_t, WS_WO3) + (size_t)l * 1024 * 3072), F.G, F.bid, ctx_on ? 66 : 64};
        EpiOut E{WSP(bf16_t, WS_T)};
        pg8::gemm_phase(F.lds, g, S, E, true);
    } else if constexpr (MODE == 6) {
        pg8::Gemm g{1024, 1024, 1024};
        SchedGU S{(const char*)WSP(bf16_t, WS_XG), (const char*)WSP(bf16_t, WS_WGU), F.G, F.bid, ctx_on ? 9 : 8};
        EpiNull E{};
        pg8::gemm_phase(F.lds, g, S, E, true);
    } else if constexpr (MODE == 7) {
        pg8::Gemm g{FF, FF, FF};
        SchedDn S{(const char*)WSP(bf16_t, WS_H), (const char*)WSP(bf16_t, WS_WDN), F.G, F.bid, ctx_on ? 9 : 8};
        EpiNull E{};
        pg8::gemm_phase(F.lds, g, S, E, true);
    } else if constexpr (MODE == 3) {
        pg8::Gemm g{1024, 1024, 1024};
        SchedGU S{(const char*)WSP(bf16_t, WS_XG), (const char*)WSP(bf16_t, WS_WGU), F.G, F.bid, ctx_on ? 9 : 8};
        EpiGU E{WSP(bf16_t, WS_H)};
        pg8::gemm_phase(F.lds, g, S, E, true);
    } else {
        pg8::Gemm g{FF, FF, FF};
        SchedDn S{(const char*)WSP(bf16_t, WS_H), (const char*)WSP(bf16_t, WS_WDN), F.G, F.bid, ctx_on ? 9 : 8};
        EpiDn E{WSP(bf16_t, WS_Y)};
        pg8::gemm_phase(F.lds, g, S, E, true);
    }
}

constexpr int NPH_LAYER = 15, NPHASES = 1 + 2 * NPH_LAYER;
__global__ void __launch_bounds__(NT, 2) fwd_kernel(KArgs args) {
    extern __shared__ __attribute__((aligned(16))) unsigned char smem[];
    Frame F; F.in = (const GAS float* LAS*)((LAS unsigned char*)smem + LDS_MISC + 64); F.out = (GAS float*)args.out; F.ws = (GAS unsigned char*)args.ws; F.lds = (LAS unsigned char*)smem; F.tid = threadIdx.x; F.lane = F.tid & 63; F.wave = __builtin_amdgcn_readfirstlane(F.tid >> 6);
    F.G = gridDim.x; F.bid = blockIdx.x;
    volatile LAS unsigned* misc = (volatile LAS unsigned*)(F.lds + LDS_MISC);
    if (F.tid < 4) misc[F.tid] = 0u;
    if (F.tid == 0) {
#pragma unroll
        for (int i = 0; i < 31; ++i) F.in[i] = (const GAS float*)args.in[i];
    }
    __syncthreads();
    const int lo = args.ph_lo, hi = args.ph_hi;
    XcdBarrier bar; bar.bar = (unsigned*)(args.ws + WS_CTL); bar.x = 0; bar.st = misc;
    if (hi - lo > 1) bar = xcd_barrier_post((unsigned*)(args.ws + WS_CTL), misc);
#ifndef PHASE_MASK
#define PHASE_MASK 0xFFFF
#endif
#define PH_ON(j) (((PHASE_MASK) >> (j)) & 1)
#ifndef DUP_MASK
#define DUP_MASK 0
#endif
#define REPS(j) ((((DUP_MASK) >> (j)) & 1) ? 2 : 1)

#define IN(k) (lo <= (k) && (k) < hi)
#define SEAM(k) do { if ((k) + 1 < hi) xcd_barrier(bar); } while (0)
    const int G = F.G, bid = F.bid;

    if (PH_ON(15) && IN(0)) { for (int rep = 0; rep < REPS(15); ++rep) prologue_phase(F); SEAM(0); }

    for (int l = 0; l < 2; ++l) {
        const int pb = 1 + NPH_LAYER * l;
        const bool ctx_on = (l == 0);
        const int pre1 = (G & 7) == 0 ? 2112 : 0;
        const int e2u = ctx_on ? 64 : 32, e2idle = G > e2u ? G - e2u : 0, bgc2 = 8448 - e2idle * 5;
        const bool g256 = G == 256;
        const int tA2_first = ctx_on ? 196 : 148, tA2_n = g256 ? (256 - tA2_first) * 4 : 0, tG1_n = (g256 && ctx_on) ? 232 * 2 : 0, tG2_n = (g256 && ctx_on) ? 248 * 4 : 0;
        const int tA2_lo = l == 0 ? 0 : pre1, tG1_lo = tA2_lo + tA2_n, tG2_lo = tG1_lo + tG1_n;
        const int bgc0 = tG2_lo + tG2_n, bgc1 = l == 0 ? (g256 ? 4200 : 2816) : 4500;
#define TAILC(first_idle, lo_, cnt_) do { if ((cnt_) > 0 && bid >= (first_idle)) { int b2 = bid; asm volatile("" : "+s"(b2)); conv_stream(F, 1, l, (lo_) + b2 - (first_idle), (lo_) + (cnt_), 256 - (first_idle)); } } while (0)
        if (PH_ON(0) && IN(pb + 0) && !(l == 1 && g256)) { for (int rep = 0; rep < REPS(0); ++rep) {
            for (int u = bid; u < 512; u += G) f2_unit(F, l, u);
            SREP(2) if (l == 0) norm1_rows(F, l);
            } SEAM(pb + 0);
        }
        if (PH_ON(1) && IN(pb + 1)) { for (int rep = 0; rep < REPS(1); ++rep) {
            gemm_run_t<0>(F, l);
            TAILC(tA2_first, tA2_lo, tA2_n);
            } SEAM(pb + 1);
        }
        if (PH_ON(2) && IN(pb + 2)) { for (int rep = 0; rep < REPS(2); ++rep) {
#ifndef M1_MASK
#define M1_MASK 31
#endif
#define BGC(slot, pos) do { if ((bid & 3) == (pos)) conv_stream(F, 1, l, ((slot) == 0 ? bgc0 : bgc1) + bid, (slot) == 0 ? bgc1 : bgc2, G); } while (0)
            BGC(0, 0);
            SREP(3) if (M1_MASK & 1) { for (int u = bid; u < R / 16; u += G) nk_unit(F, l, u); }
            BGC(0, 1);
            SREP(4) if (M1_MASK & 4) for (int u = (bid + 160) % G; u < NCHAIN * NCH; u += G) h1_unit(F, u);
            BGC(0, 2);
            SREP(5) if (M1_MASK & 8) for (int u = bid; u < 2048; u += G) y1_unit(F, l, u);
            BGC(0, 3);
            SREP(6) if ((M1_MASK & 16) && ctx_on) for (int u = (bid + 64) % G; u < 128; u += G) yctx_unit(F, u);
            } SEAM(pb + 2);
        }
        if (PH_ON(3) && IN(pb + 3)) { for (int rep = 0; rep < REPS(3); ++rep) {
            BGC(1, 0);
            { const int nna = 1024 + (ctx_on ? 32 : 0); for (int u = bid; u < nna; u += G) na_unit(F, l, u < 1024 ? u : u - 1024, u >= 1024); }
            SREP(7) for (int u = bid; u < 512; u += G) { y2_unit(F, u); if (u < G) BGC(1, 1); }
            BGC(1, 2);
            SREP(8) h2_phase(F);
            BGC(1, 3);
            } SEAM(pb + 3);
        }
        if (PH_ON(4) && IN(pb + 4)) { for (int rep = 0; rep < REPS(4); ++rep) {
            SREP(9) { if (ctx_on) { for (int u = bid; u < NCHAIN * NCH; u += G) h3_unit(F, u); }
            else { for (int v = bid; v < NCHAIN * 128; v += G) h3_unit(F, (v >> 7) * NCH + 4 + (v & 127)); } }
            SREP(10) for (int u = (bid + 64) % G; u < 2048; u += G) y3_unit(F, l, u);
            } SEAM(pb + 4);
        }
        if (PH_ON(5) && IN(pb + 5)) { for (int rep = 0; rep < REPS(5); ++rep) { h4_phase(F, l); } SEAM(pb + 5); }
        if (PH_ON(6) && IN(pb + 6)) { for (int rep = 0; rep < REPS(6); ++rep) {
            gemm_run_t<1>(F, l);
            TAILC(24, tG1_lo, tG1_n);
            } SEAM(pb + 6);
        }
        if (PH_ON(7) && IN(pb + 7)) { for (int rep = 0; rep < REPS(7); ++rep) { gs_phase(F, l); } SEAM(pb + 7); }
        if (PH_ON(8) && IN(pb + 8)) { for (int rep = 0; rep < REPS(8); ++rep) {
            gemm_run_t<2>(F, l);
            TAILC(8, tG2_lo, tG2_n);
            if (g256 && ctx_on && bid >= 8 && bid < 40) { int b2 = bid; asm volatile("" : "+s"(b2)); f2_unit(F, 1, 480 + b2 - 8); }
            } SEAM(pb + 8);
        }
        if (PH_ON(9) && IN(pb + 9)) { for (int rep = 0; rep < REPS(9); ++rep) { e1_phase(F, l); } SEAM(pb + 9); }
        if (PH_ON(10) && IN(pb + 10)) { for (int rep = 0; rep < REPS(10); ++rep) { for (int u = bid; u < e2u; u += G) e2_unit(F, u & 31, u >= 32);
            if (bid >= e2u) { int b2 = bid; asm volatile("" : "+s"(b2)); conv_stream(F, 1, l, bgc2 + b2 - e2u, 8448, e2idle); } } SEAM(pb + 10); }
        if (PH_ON(11) && IN(pb + 11)) { for (int rep = 0; rep < REPS(11); ++rep) { e3_phase(F, l); } SEAM(pb + 11); }
        if (PH_ON(12) && IN(pb + 12)) { for (int rep = 0; rep < REPS(12); ++rep) {
            gemm_run_t<3>(F, l);
            if (l == 0 && g256 && (bid & 7) >= 3) { int b2 = bid; asm volatile("" : "+s"(b2)); __syncthreads(); for (int u = (b2 >> 3) * 5 + (b2 & 7) - 3; u < 480; u += 160) f2_unit(F, 1, u); }
#ifdef PROBE_GEMM_E
            gemm_run_t<6>(F, l);
#endif
            } SEAM(pb + 12);
        }
        if (PH_ON(13) && IN(pb + 13)) { for (int rep = 0; rep < REPS(13); ++rep) {
            gemm_run_t<4>(F, l);
#ifdef PROBE_GEMM_E
            gemm_run_t<7>(F, l);
#endif
            if (l == 0 && pre1 && (bid & 7) >= 2) { int b2 = bid; asm volatile("" : "+s"(b2)); conv_stream(F, 1, 1, (b2 >> 3) * 6 + (b2 & 7) - 2, pre1, (G >> 3) * 6); }
            } SEAM(pb + 13);
        }
        if (PH_ON(14) && IN(pb + 14)) { for (int rep = 0; rep < REPS(14); ++rep) { e6_phase(F, l); } SEAM(pb + 14); }
    }
#undef IN
#undef SEAM
}

extern "C" void kernel_launch(void* const* d_in, const int* in_sizes, int n_in, void* d_out, int out_size, void* d_ws, size_t ws_size, hipStream_t stream) {
    static int grid = 0;
    if (grid == 0) {
        if (n_in != 31 || out_size != RL * D || ws_size < WS_END) { fprintf(stderr, "kernel_launch: unexpected shapes (n_in %d out %d ws %zu need %zu)\n", n_in, out_size, ws_size, (size_t)WS_END); grid = -1; return; }
        int dev = 0, cus = 0, per_cu = 0;
        if (hipGetDevice(&dev) != hipSuccess || hipDeviceGetAttribute(&cus, hipDeviceAttributeMultiprocessorCount, dev) != hipSuccess) { grid = -1; return; }
        if (hipFuncSetAttribute((const void*)fwd_kernel, hipFuncAttributeMaxDynamicSharedMemorySize, LDS_BYTES) != hipSuccess) { fprintf(stderr, "kernel_launch: hipFuncSetAttribute failed\n"); grid = -1; return; }
        if (hipOccupancyMaxActiveBlocksPerMultiprocessor(&per_cu, (const void*)fwd_kernel, NT, LDS_BYTES) != hipSuccess || per_cu < 1) fprintf(stderr, "kernel_launch: occupancy query says %d\n", per_cu);
        (void)hipGetLastError();
        grid = cus;
    }
    if (grid < 0) return;
    (void)hipMemsetAsync((char*)d_ws + WS_CTL, 0, 16384, stream);
    KArgs a{};
    for (int i = 0; i < 31; ++i) a.in[i] = (const float*)d_in[i];
    a.out = (float*)d_out; a.ws = (unsigned char*)d_ws;
#if N_LAUNCH_MODE == 1
    a.ph_lo = 0; a.ph_hi = NPHASES;
    hipLaunchKernelGGL(fwd_kernel, dim3(grid), dim3(NT), LDS_BYTES, stream, a);
#else
    for (int ph = 0; ph < NPHASES; ++ph) { a.ph_lo = ph; a.ph_hi = ph + 1; hipLaunchKernelGGL(fwd_kernel, dim3(grid), dim3(NT), LDS_BYTES, stream, a); }
#endif
}
```

```cpp
#include <hip/hip_runtime.h>
#include <stdint.h>
#include <stdio.h>

#ifndef N_LAUNCH_MODE
#define N_LAUNCH_MODE 1
#endif

#ifndef SUB_DUP
#define SUB_DUP 0
#endif
#define SREP(k) for (int srep = 0; srep < ((((SUB_DUP) >> (k)) & 1) ? 2 : 1); ++srep)
#define LAS __attribute__((address_space(3)))
#define GAS __attribute__((address_space(1)))
#define CAS __attribute__((address_space(4)))
typedef unsigned short bf16_t;
typedef short bf16x8 __attribute__((ext_vector_type(8)));
typedef short bf16x4 __attribute__((ext_vector_type(4)));
typedef float f32x4 __attribute__((ext_vector_type(4)));
typedef float f32x16 __attribute__((ext_vector_type(16)));
typedef unsigned u32x4 __attribute__((ext_vector_type(4)));
typedef unsigned u32x2 __attribute__((ext_vector_type(2)));
typedef float f2 __attribute__((ext_vector_type(2)));
__device__ __forceinline__ f2 mk2(float x, float y) { f2 r; r.x = x; r.y = y; return r; }

constexpr int D = 1024, NB = 2, SEQ = 8192, CTX = 256, GW = 64, GROWS = 128;
constexpr int RL = NB * SEQ;
constexpr int RC = NB * CTX;
constexpr int R = RL + RC;
constexpr int INC = 8704;
constexpr int PC = 7680;
constexpr int P_I = 0, P_NK = 512, P_NV = 1024, P_HQ = 1536, P_NQ = 2048, P_HG = 2560, P_HY = 3072, P_GATE = 4608;
constexpr int NE = 16, FF = 2816, CAP = 1024, CAPC = 32;
constexpr int XROWS = 2304;
constexpr int NCH = 132;
constexpr int NCHAIN = 16;
constexpr int NT = 512;
constexpr float EPS = 1e-6f;

constexpr size_t WS_CTL  = 0;
constexpr size_t WS_MOD  = 16384;
constexpr size_t WS_LBC  = WS_MOD + 147456;
constexpr size_t WS_TW   = WS_LBC + 16384;
constexpr size_t WS_ROPE = WS_TW + 131072;
constexpr size_t WS_PS   = WS_ROPE + 24576;
constexpr size_t WS_PSC  = WS_PS + 262144;
constexpr size_t WS_HTC  = WS_PSC + 4096;
constexpr size_t WS_HT   = WS_HTC + 1048576;
constexpr size_t WS_KF   = WS_HT + 67108864;
constexpr size_t WS_WIN  = WS_KF + 67108864;
constexpr size_t WS_WBR  = WS_WIN + 35651584;
constexpr size_t WS_WO3  = WS_WBR + 6291456;
constexpr size_t WS_WGU  = WS_WO3 + 12582912;
constexpr size_t WS_WDN  = WS_WGU + 184549376;
constexpr size_t WS_HX   = WS_WDN + 92274688;
constexpr size_t WS_XM   = WS_HX + 34603008;
constexpr size_t WS_AFF  = WS_XM + 69206016;
constexpr size_t WS_SLOT = WS_AFF + 1048576 + 32768;
constexpr size_t WS_IDX  = WS_SLOT + 1081344;
constexpr size_t WS_T    = WS_IDX + 131072 + 4096;
constexpr size_t WS_MIX  = WS_T + 103809024;
constexpr size_t WS_REG  = WS_MIX + 51904512;
constexpr size_t WS_LF   = WS_REG;
constexpr size_t WS_P    = WS_LF + 69206016;
constexpr size_t WS_DS   = WS_P + 259522560;
constexpr size_t WS_DEC  = WS_DS + 138412032;
constexpr size_t WS_ST   = WS_DEC + 1081344;
constexpr size_t WS_OH   = WS_ST + 69206016;
constexpr size_t WS_UT   = WS_OH + 69206016;
constexpr size_t WS_YT   = WS_UT + 33554432;
constexpr size_t WS_END1 = WS_YT + 33554432;
constexpr size_t WS_XG   = WS_REG;
constexpr size_t WS_H    = WS_XG + 75497472;
constexpr size_t WS_Y    = WS_H + 207618048;
constexpr size_t WS_END2 = WS_Y + 75497472;
constexpr size_t WS_END  = WS_END1 > WS_END2 ? WS_END1 : WS_END2;
static_assert(WS_END <= 1476395008ull, "workspace map exceeds the guaranteed d_ws size");
static_assert((WS_REG & 255) == 0 && (WS_P & 255) == 0 && (WS_DS & 255) == 0 && (WS_ST & 255) == 0, "alignment");

constexpr int LDS_STAGE = 131072;
constexpr int LDS_MISC = 139264;
constexpr int LDS_BYTES = LDS_MISC + 1024;

__device__ __forceinline__ float bf2f(bf16_t b) { return __uint_as_float(((unsigned)b) << 16); }
__device__ __forceinline__ bf16_t f2bf(float f) { unsigned u = __float_as_uint(f); u += 0x7FFFu + ((u >> 16) & 1u); return (bf16_t)(u >> 16); }
typedef float f32x2n __attribute__((ext_vector_type(2)));
typedef __bf16 bf16x2n __attribute__((ext_vector_type(2)));
__device__ __forceinline__ unsigned pk2(float lo, float hi) { f32x2n v; v.x = lo; v.y = hi; const bf16x2n b = __builtin_convertvector(v, bf16x2n); unsigned r; __builtin_memcpy(&r, &b, 4); return r; }
__device__ __forceinline__ float lo16(unsigned w) { return __uint_as_float(w << 16); }
__device__ __forceinline__ float hi16(unsigned w) { return __uint_as_float(w & 0xFFFF0000u); }
__device__ __forceinline__ float sigmoidf_(float x) { return __builtin_amdgcn_rcpf(1.f + __expf(-x)); }
__device__ __forceinline__ float siluf_(float x) { return x * __builtin_amdgcn_rcpf(1.f + __expf(-x)); }
__device__ __forceinline__ float logsigf_(float z) { return fminf(z, 0.f) - log1pf(__expf(-fabsf(z))); }
__device__ __forceinline__ float wave_sum(float v) {
#pragma unroll
    for (int o = 32; o >= 1; o >>= 1) v += __shfl_xor(v, o);
    return v;
}

#define XB_TMO      128
#define XB_XCNT(j)  (256  + 64 * (j))
#define XB_XSUB(j)  (1280 + 64 * (j))
#define XB_XGEN(j)  (2304 + 64 * (j))
#define XB_TOP      3328
#define XB_TOPGEN   3392
#define XCD_BAR_WORDS 3456
#define XB_SPIN_CAP (1u << 22)

__device__ __forceinline__ unsigned xb_ld(unsigned* p)              { return __hip_atomic_load(p, __ATOMIC_RELAXED, __HIP_MEMORY_SCOPE_AGENT); }
__device__ __forceinline__ unsigned xb_add(unsigned* p, unsigned v) { return __hip_atomic_fetch_add(p, v, __ATOMIC_RELAXED, __HIP_MEMORY_SCOPE_AGENT); }
__device__ __forceinline__ unsigned xb_xcc_id() { return (unsigned)__builtin_amdgcn_s_getreg((3 << 11) | 20) & 0xFu; }
#define XB_SPIN(cond, bar) do { unsigned _sp = 0; while (cond) { __builtin_amdgcn_s_sleep(1); \
    if ((++_sp & 255u) == 0u) { if (xb_ld(&(bar)[XB_TMO])) break; if (_sp > XB_SPIN_CAP) { atomicAdd(&(bar)[XB_TMO], 1u); break; } } } } while (0)

struct XcdBarrier { unsigned* bar; unsigned x; volatile LAS unsigned* st; };

__device__ __forceinline__ XcdBarrier xcd_barrier_post(unsigned* bar, volatile LAS unsigned* st) {
    XcdBarrier b; b.bar = bar; b.x = xb_xcc_id(); b.st = st;
    if (threadIdx.x == 0) (void)xb_add(&bar[XB_XCNT(b.x)], 1u);
    return b;
}
__device__ __forceinline__ void xcd_barrier_complete(unsigned* bar, unsigned x, unsigned& nloc, unsigned& nx) {
    const unsigned G = gridDim.x * gridDim.y * gridDim.z;
    unsigned sum, cnt, mine, sp = 0u;
    for (;;) {
        sum = 0u; cnt = 0u; mine = 0u;
#pragma unroll
        for (unsigned j = 0; j < 16; ++j) { const unsigned c = xb_ld(&bar[XB_XCNT(j)]); sum += c; cnt += (c > 0u) ? 1u : 0u; mine = (j == x) ? c : mine; }
        if (sum == G) break;
        __builtin_amdgcn_s_sleep(1);
        if ((++sp & 255u) == 0u) { if (xb_ld(&bar[XB_TMO])) break; if (sp > XB_SPIN_CAP) { atomicAdd(&bar[XB_TMO], 1u); break; } }
    }
    nloc = mine > 0u ? mine : 1u; nx = cnt > 0u ? cnt : 1u;
}
__device__ __forceinline__ void xcd_barrier(const XcdBarrier& b) {
    asm volatile("s_waitcnt vmcnt(0)" ::: "memory");
    __syncthreads();
    if (threadIdx.x == 0) {
        unsigned* bar = b.bar;
        __builtin_amdgcn_s_waitcnt(0);
        unsigned nloc = b.st[0], nx = b.st[1];
        if (nloc == 0u) { xcd_barrier_complete(bar, b.x, nloc, nx); b.st[0] = nloc; b.st[1] = nx; }
        const unsigned old = xb_add(&bar[XB_XSUB(b.x)], 1u);
        const unsigned gen = old / nloc;
        if (old + 1u == (gen + 1u) * nloc) {
            __builtin_amdgcn_fence(__ATOMIC_RELEASE, "agent");
            asm volatile("s_waitcnt vmcnt(0)" ::: "memory");
            const unsigned og = xb_add(&bar[XB_TOP], 1u);
            const unsigned tg = og / nx;
            if (og + 1u == (tg + 1u) * nx) xb_add(&bar[XB_TOPGEN], 1u);
            else XB_SPIN(xb_ld(&bar[XB_TOPGEN]) == tg, bar);
            __builtin_amdgcn_fence(__ATOMIC_ACQUIRE, "agent");
            xb_add(&bar[XB_XGEN(b.x)], 1u);
            asm volatile("s_waitcnt vmcnt(0)" ::: "memory");
        } else {
            XB_SPIN(xb_ld(&bar[XB_XGEN(b.x)]) == gen, bar);
            __builtin_amdgcn_fence(__ATOMIC_ACQUIRE, "agent");
            asm volatile("s_waitcnt vmcnt(0)" ::: "memory");
        }
    }
    __syncthreads();
}

namespace pg8 {
constexpr int BM = 256, BK = 64, HALF = 128, HTB = HALF * BK * 2, STAGE_BYTES = 8 * HTB, NXCD = 8, WGM = 8;
__device__ __forceinline__ int lds_byte(int r, int c) { const int st = (r >> 4) * 2 + (c >> 5), rr = r & 15, cc = c & 31, ob = rr * 64 + cc * 2; return st * 1024 + (ob ^ (((ob >> 9) & 1) << 5)); }
__device__ __forceinline__ void stage_rc(int b, int& Rr, int& C) { const int st = b / 1024, sb = b % 1024, swz = sb ^ (((sb >> 9) & 1) << 5); Rr = (st >> 1) * 16 + swz / 64; C = (st & 1) * 32 + (swz % 64) / 2; }
__device__ __forceinline__ int perm32(int rho) { const int n = rho >> 4, i = rho & 15; return 8 * (i >> 2) + 4 * n + (i & 3); }

struct Unit { int pm, pn, g; };
struct Gemm { int lda, ldb, K; };

__device__ __forceinline__ void tile_order(int L, int nM, int nN, int& pm, int& pn) {
    const int nwg = nM * nN; int wgid = L;
    { const int q = nwg / NXCD, r = nwg % NXCD, xcd = wgid % NXCD, off = wgid / NXCD; wgid = (xcd < r ? xcd * (q + 1) : r * (q + 1) + (xcd - r) * q) + off; }
    const int nig = WGM * nN, gid = wgid / nig, fm = gid * WGM, gsz = (nM - fm) < WGM ? (nM - fm) : WGM;
    pm = fm + ((wgid % nig) % gsz); pn = (wgid % nig) / gsz;
}

template <class Epi, class Sched>
__device__ __forceinline__ void gemm_phase(LAS unsigned char* lds, const Gemm g, const Sched& S, const Epi& E, const bool perm) {
    int tid = threadIdx.x; asm volatile("" : "+v"(tid));
    const int wid = __builtin_amdgcn_readfirstlane(tid >> 6), lane = tid & 63, wr = wid >> 2, wc = wid & 3, fr = lane & 15, fq = lane >> 4;
    const int K = g.K, nt = K / BK;
    unsigned voffA[2], voffB[2];
#pragma unroll
    for (int i = 0; i < 2; ++i) { int Rr, C; stage_rc(tid * 16 + i * 8192, Rr, C); const int Rb = perm ? ((Rr & ~31) + perm32(Rr & 31)) : Rr;
        voffA[i] = (unsigned)(Rr * g.lda + C) * 2u; voffB[i] = (unsigned)(Rb * g.ldb + C) * 2u; }
    const size_t kstep = (size_t)(BK * 2);
    const size_t hstepA = (size_t)HALF * g.lda * 2, hstepB = (size_t)HALF * g.ldb * 2;
    const unsigned ldsw = (unsigned)wid * 1024u;
    const int aoff = lds_byte(wr * 64 + fr, fq * 8), boff = lds_byte(wc * 32 + fr, fq * 8);
#define PG8_SA(b, h) (((b) * 2 + (h)) * HTB)
#define PG8_SB(b, h) ((4 + (b) * 2 + (h)) * HTB)
#define PG8_STAGE(bufoff, gbase, voff) do { _Pragma("unroll") for (int _i = 0; _i < 2; ++_i) \
        __builtin_amdgcn_global_load_lds((const unsigned*)((const char*)(gbase) + (voff)[_i]), (LAS unsigned*)(lds + (bufoff) + ldsw + _i * 8192), 16, 0, 0); } while (0)
#define PG8_LDA(dst, b, h) do { _Pragma("unroll") for (int m = 0; m < 4; ++m) _Pragma("unroll") for (int k = 0; k < 2; ++k) dst[m][k] = *(const LAS bf16x8*)(lds + PG8_SA(b, h) + aoff + m * 2048 + k * 1024); } while (0)
#define PG8_LDB(dst, b, h) do { _Pragma("unroll") for (int n = 0; n < 2; ++n) _Pragma("unroll") for (int k = 0; k < 2; ++k) dst[n][k] = *(const LAS bf16x8*)(lds + PG8_SB(b, h) + boff + n * 2048 + k * 1024); } while (0)
#define PG8_MMA(ai, bj, At, Bt) do { __builtin_amdgcn_s_setprio(1); _Pragma("unroll") for (int m = 0; m < 4; ++m) _Pragma("unroll") for (int n = 0; n < 2; ++n) _Pragma("unroll") for (int k = 0; k < 2; ++k) \
        acc[ai][bj][m][n] = __builtin_amdgcn_mfma_f32_16x16x32_bf16(Bt[n][k], At[m][k], acc[ai][bj][m][n], 0, 0, 0); __builtin_amdgcn_s_setprio(0); } while (0)
#define PG8_WAIT_V(n) asm volatile("s_waitcnt vmcnt(" #n ")" ::: "memory")
#define PG8_WAIT_L(n) asm volatile("s_waitcnt lgkmcnt(" #n ")" ::: "memory")
#define PG8_BAR __builtin_amdgcn_s_barrier()
#define PG8_SCHED __builtin_amdgcn_sched_barrier(0)
    Unit cur, nxt; int ui = 0;
    if (!S.next(0, cur)) return;
    f32x4 acc[2][2][4][2];
#pragma unroll
    for (int a = 0; a < 2; ++a)
#pragma unroll
        for (int b = 0; b < 2; ++b)
#pragma unroll
            for (int m = 0; m < 4; ++m)
#pragma unroll
                for (int n = 0; n < 2; ++n) acc[a][b][m][n] = (f32x4){0.f, 0.f, 0.f, 0.f};
    bf16x8 At[4][2], B0[2][2], B1[2][2];
    const char* cA = S.a_ptr(cur); const char* cB = S.b_ptr(cur);
    PG8_STAGE(PG8_SB(0, 0), cB, voffB); PG8_STAGE(PG8_SA(0, 0), cA, voffA); PG8_STAGE(PG8_SB(0, 1), cB + hstepB, voffB); PG8_STAGE(PG8_SA(0, 1), cA + hstepA, voffA);
    if (wr == 1) PG8_BAR;
    PG8_WAIT_V(4); PG8_BAR;
    PG8_STAGE(PG8_SB(1, 0), cB + kstep, voffB); PG8_STAGE(PG8_SA(1, 0), cA + kstep, voffA); PG8_STAGE(PG8_SB(1, 1), cB + hstepB + kstep, voffB);
    PG8_WAIT_V(6); PG8_BAR;
    for (;;) {
        const bool has_next = S.next(ui + 1, nxt);
        const char* nA = has_next ? S.a_ptr(nxt) : cA; const char* nB = has_next ? S.b_ptr(nxt) : cB;
        for (int t = 0; t < nt; t += 2) {
            const bool last = (t == nt - 2);
            const char* a1 = cA + (size_t)(t + 1) * kstep;
            const char* a2 = last ? nA : cA + (size_t)(t + 2) * kstep; const char* b2 = last ? nB : cB + (size_t)(t + 2) * kstep;
            const char* a3 = a2 + kstep; const char* b3 = b2 + kstep;
            PG8_LDB(B0, 0, 0); PG8_SCHED; PG8_LDA(At, 0, 0); PG8_STAGE(PG8_SA(1, 1), a1 + hstepA, voffA);
            PG8_WAIT_L(8); PG8_BAR; PG8_WAIT_L(0); PG8_MMA(0, 0, At, B0); PG8_BAR; PG8_SCHED;
            PG8_LDB(B1, 0, 1); PG8_STAGE(PG8_SB(0, 0), b2, voffB);
            PG8_BAR; PG8_WAIT_L(0); PG8_MMA(0, 1, At, B1); PG8_BAR;
            PG8_LDA(At, 0, 1); PG8_STAGE(PG8_SA(0, 0), a2, voffA);
            PG8_BAR; PG8_WAIT_L(0); PG8_MMA(1, 0, At, B0); PG8_BAR; PG8_SCHED;
            PG8_STAGE(PG8_SB(0, 1), b2 + hstepB, voffB);
            PG8_WAIT_V(6); PG8_BAR; PG8_MMA(1, 1, At, B1); PG8_BAR;
            PG8_LDB(B0, 1, 0); PG8_SCHED; PG8_LDA(At, 1, 0); PG8_STAGE(PG8_SA(0, 1), a2 + hstepA, voffA);
            PG8_WAIT_L(8); PG8_BAR; PG8_WAIT_L(0); PG8_MMA(0, 0, At, B0); PG8_BAR; PG8_SCHED;
            PG8_LDB(B1, 1, 1); PG8_STAGE(PG8_SB(1, 0), b3, voffB);
            PG8_BAR; PG8_WAIT_L(0); PG8_MMA(0, 1, At, B1); PG8_BAR;
            PG8_LDA(At, 1, 1); PG8_STAGE(PG8_SA(1, 0), a3, voffA);
            PG8_BAR; PG8_WAIT_L(0); PG8_MMA(1, 0, At, B0); PG8_BAR; PG8_SCHED;
            PG8_STAGE(PG8_SB(1, 1), b3 + hstepB, voffB);
            PG8_WAIT_V(6); PG8_BAR; PG8_MMA(1, 1, At, B1); PG8_BAR;
        }
        E(acc, cur, wr, wc, fr, fq);
        if (!has_next) break;
#pragma unroll
        for (int a = 0; a < 2; ++a)
#pragma unroll
            for (int b = 0; b < 2; ++b)
#pragma unroll
                for (int m = 0; m < 4; ++m)
#pragma unroll
                    for (int n = 0; n < 2; ++n) acc[a][b][m][n] = (f32x4){0.f, 0.f, 0.f, 0.f};
        cur = nxt; cA = nA; cB = nB; ++ui;
    }
    PG8_WAIT_V(0);
    if (wr == 0) PG8_BAR;
    PG8_BAR;
#undef PG8_SA
#undef PG8_SB
#undef PG8_STAGE
#undef PG8_LDA
#undef PG8_LDB
#undef PG8_MMA
#undef PG8_WAIT_V
#undef PG8_WAIT_L
#undef PG8_BAR
#undef PG8_SCHED
}
}

struct KArgs { const float* in[31]; float* out; unsigned char* ws; int ph_lo, ph_hi; };
enum { I_X = 0, I_C, I_CTX, I_CCTX, I_WMOD, I_BMOD, I_NMIX, I_NFFN, I_WIN, I_HGLB, I_QG, I_KG, I_RPB, I_CW, I_CB, I_PW1, I_PB1, I_PF1, I_PW2, I_PB2, I_PF2, I_PW3, I_SKIP,
       I_WA, I_WB, I_WC, I_WOUT, I_WR, I_WEG, I_WEU, I_WED };

struct Frame {
    const GAS float* LAS* in; GAS float* out; GAS unsigned char* ws; LAS unsigned char* lds; int tid, lane, wave, G, bid;
};
#define WSP(T, off) ((GAS T*)(F.ws + (off)))

struct SchedIn {
    const char* A; const char* B; int G, c, nctx;
    __device__ __forceinline__ bool next(int i, pg8::Unit& u) const {
        const int L = i * G + c;
        if (L < 64 * 34) { pg8::tile_order(L, 64, 34, u.pm, u.pn); u.g = 0; return true; }
        const int e = L - 64 * 34; if (e >= 2 * nctx) return false;
        const int hi_ = e >= nctx ? 1 : 0; u.pm = 64 + hi_; u.pn = e - hi_ * nctx; u.g = 0; return true;
    }
    __device__ __forceinline__ const char* a_ptr(const pg8::Unit& u) const { return A + (size_t)u.pm * 256 * 1024 * 2; }
    __device__ __forceinline__ const char* b_ptr(const pg8::Unit& u) const { return B + (size_t)u.pn * 256 * 1024 * 2; }
};
struct SchedBr {
    const char* A; const char* B; int G, c, nM;
    __device__ __forceinline__ bool next(int i, pg8::Unit& u) const {
        const int L = i * G + c; if (L >= nM * 12) return false;
        pg8::tile_order(L, nM, 12, u.pm, u.pn); u.g = u.pn >> 2; return true;
    }
    __device__ __forceinline__ const char* a_ptr(const pg8::Unit& u) const { return A + ((size_t)u.pm * 256 * 1536 + (size_t)u.g * 512) * 2; }
    __device__ __forceinline__ const char* b_ptr(const pg8::Unit& u) const { return B + (size_t)u.pn * 256 * 512 * 2; }
};
struct SchedOut {
    const char* A; const char* B; int G, c, nM;
    __device__ __forceinline__ bool next(int i, pg8::Unit& u) const {
        const int L = i * G + c; if (L >= nM * 4) return false;
        pg8::tile_order(L, nM, 4, u.pm, u.pn); u.g = 0; return true;
    }
    __device__ __forceinline__ const char* a_ptr(const pg8::Unit& u) const { return A + (size_t)u.pm * 256 * 1024 * 2; }
    __device__ __forceinline__ const char* b_ptr(const pg8::Unit& u) const { return B + (size_t)u.pn * 256 * 3072 * 2; }
};
struct SchedGU {
    const char* A; const char* B; int G, c, nMt;
    __device__ __forceinline__ bool next(int i, pg8::Unit& u) const {
        const int L = (G % 8 == 0) ? ((i * 8 + (c & 7)) * (G >> 3) + (c >> 3)) : (i * G + c);
         const int per = nMt * 22; if (L >= NE * per) return false;
        u.g = nMt == 8 ? L / 176 : L / 198; const int rem = L - u.g * per; u.pn = nMt == 8 ? (rem >> 3) : rem / 9; u.pm = rem - u.pn * nMt; return true;
    }
    __device__ __forceinline__ const char* a_ptr(const pg8::Unit& u) const { return A + ((size_t)u.g * XROWS + (size_t)u.pm * 256) * 1024 * 2; }
    __device__ __forceinline__ const char* b_ptr(const pg8::Unit& u) const { return B + ((size_t)u.g * 5632 + (size_t)u.pn * 256) * 1024 * 2; }
};
struct SchedDn {
    const char* A; const char* B; int G, c, nMt;
    __device__ __forceinline__ bool next(int i, pg8::Unit& u) const {
        const int L = (G % 8 == 0) ? ((i * 8 + (c & 7)) * (G >> 3) + (c >> 3)) : (i * G + c);
         const int per = nMt * 4; if (L >= NE * per) return false;
        u.g = nMt == 8 ? (L >> 5) : L / 36; const int rem = L - u.g * per; u.pn = nMt == 8 ? (rem >> 3) : rem / 9; u.pm = rem - u.pn * nMt; return true;
    }
    __device__ __forceinline__ const char* a_ptr(const pg8::Unit& u) const { return A + ((size_t)u.g * XROWS + (size_t)u.pm * 256) * FF * 2; }
    __device__ __forceinline__ const char* b_ptr(const pg8::Unit& u) const { return B + ((size_t)u.g * 1024 + (size_t)u.pn * 256) * FF * 2; }
};

__device__ __forceinline__ float log_forget(float z, f2 c) {
    return __logf(c.x + c.y * sigmoidf_(fmaxf(z, -60.f)));
}
struct EpiIn {
    static constexpr bool PERM = true;
    GAS float* LF; GAS bf16_t* P; const GAS f2* lbc;
    template <int BJ> __device__ __forceinline__ void part(const f32x4 (&acc)[2][2][4][2], int pn, int row0, int wc, int fq) const {
        const int act = (pn == 10 || pn == 11 || pn == 14 || pn == 15) ? 1 : (pn >= 22 ? 2 : 0);
        const int c0 = pn * 256 + BJ * 128 + wc * 32 + 8 * fq;
        if (pn < 4) {
            f2 cc[8];
#pragma unroll
            for (int e = 0; e < 8; ++e) cc[e] = lbc[c0 + e];
#pragma unroll
            for (int ai = 0; ai < 2; ++ai)
#pragma unroll
                for (int m = 0; m < 4; ++m) {
                    const int row = row0 + ai * 128 + m * 16;
                    f32x4 v0 = acc[ai][BJ][m][0], v1 = acc[ai][BJ][m][1];
#pragma unroll
                    for (int e = 0; e < 4; ++e) { v0[e] = log_forget(v0[e], cc[e]); v1[e] = log_forget(v1[e], cc[4 + e]); }
                    GAS float* p = LF + (size_t)row * 1024 + c0;
                    *(GAS f32x4*)p = v0; *(GAS f32x4*)(p + 4) = v1;
                }
        } else {
#pragma unroll
            for (int ai = 0; ai < 2; ++ai)
#pragma unroll
                for (int m = 0; m < 4; ++m) {
                    const int row = row0 + ai * 128 + m * 16;
                    f32x4 v0 = acc[ai][BJ][m][0], v1 = acc[ai][BJ][m][1];
                    if (act == 1) {
#pragma unroll
                        for (int e = 0; e < 4; ++e) { v0[e] = siluf_(v0[e]); v1[e] = siluf_(v1[e]); }
                    } else if (act == 2) {
#pragma unroll
                        for (int e = 0; e < 4; ++e) { v0[e] = sigmoidf_(v0[e]); v1[e] = sigmoidf_(v1[e]); }
                    }
                    u32x4 w; w.x = pk2(v0[0], v0[1]); w.y = pk2(v0[2], v0[3]); w.z = pk2(v1[0], v1[1]); w.w = pk2(v1[2], v1[3]);
                    *(GAS u32x4*)(P + (size_t)row * PC + (c0 - 1024)) = w;
                }
        }
    }
    __device__ __forceinline__ void operator()(const f32x4 (&acc)[2][2][4][2], const pg8::Unit& u, int wr, int wc, int fr, int fq) const {
        const int row0 = u.pm * 256 + wr * 64 + fr;
        part<0>(acc, u.pn, row0, wc, fq);
        part<1>(acc, u.pn, row0, wc, fq);
    }
};
struct EpiBr {
    static constexpr bool PERM = true;
    GAS bf16_t* T; const GAS bf16_t* P;
    __device__ __forceinline__ void operator()(const f32x4 (&acc)[2][2][4][2], const pg8::Unit& u, int wr, int wc, int fr, int fq) const {
        const int row0 = u.pm * 256 + wr * 64 + fr;
#pragma unroll
        for (int ai = 0; ai < 2; ++ai)
#pragma unroll
            for (int m = 0; m < 4; ++m) {
                const int row = row0 + ai * 128 + m * 16;
#pragma unroll
                for (int bj = 0; bj < 2; ++bj) {
                    const int c0 = u.pn * 256 + bj * 128 + wc * 32 + 8 * fq;
                    const f32x4 v0 = acc[ai][bj][m][0], v1 = acc[ai][bj][m][1];
                    u32x4 w; w.x = pk2(v0[0], v0[1]); w.y = pk2(v0[2], v0[3]); w.z = pk2(v1[0], v1[1]); w.w = pk2(v1[2], v1[3]);
                    *(GAS u32x4*)(T + (size_t)row * 3072 + c0) = w;
                }
            }
    }
};
struct EpiOut {
    static constexpr bool PERM = true;
    GAS bf16_t* DL;
    __device__ __forceinline__ void operator()(const f32x4 (&acc)[2][2][4][2], const pg8::Unit& u, int wr, int wc, int fr, int fq) const {
        const int row0 = u.pm * 256 + wr * 64 + fr;
#pragma unroll
        for (int ai = 0; ai < 2; ++ai)
#pragma unroll
            for (int m = 0; m < 4; ++m) {
                const int row = row0 + ai * 128 + m * 16;
#pragma unroll
                for (int bj = 0; bj < 2; ++bj) {
                    const int c0 = u.pn * 256 + bj * 128 + wc * 32 + 8 * fq;
                    const f32x4 v0 = acc[ai][bj][m][0], v1 = acc[ai][bj][m][1];
                    u32x4 w; w.x = pk2(v0[0], v0[1]); w.y = pk2(v0[2], v0[3]); w.z = pk2(v1[0], v1[1]); w.w = pk2(v1[2], v1[3]);
                    *(GAS u32x4*)(DL + (size_t)row * 1024 + c0) = w;
                }
            }
    }
};
struct EpiGU {
    static constexpr bool PERM = true;
    GAS bf16_t* H;
    __device__ __forceinline__ void operator()(const f32x4 (&acc)[2][2][4][2], const pg8::Unit& u, int wr, int wc, int fr, int fq) const {
        const int row0 = u.g * XROWS + u.pm * 256 + wr * 64 + fr;
        const int hc = u.pn * 128 + wc * 32 + 8 * fq;
#pragma unroll
        for (int ai = 0; ai < 2; ++ai)
#pragma unroll
            for (int m = 0; m < 4; ++m) {
                const int row = row0 + ai * 128 + m * 16;
                const f32x4 g0 = acc[ai][0][m][0], g1 = acc[ai][0][m][1], u0 = acc[ai][1][m][0], u1 = acc[ai][1][m][1];
                u32x4 w; w.x = pk2(siluf_(g0[0]) * u0[0], siluf_(g0[1]) * u0[1]); w.y = pk2(siluf_(g0[2]) * u0[2], siluf_(g0[3]) * u0[3]);
                w.z = pk2(siluf_(g1[0]) * u1[0], siluf_(g1[1]) * u1[1]); w.w = pk2(siluf_(g1[2]) * u1[2], siluf_(g1[3]) * u1[3]);
                *(GAS u32x4*)(H + (size_t)row * FF + hc) = w;
            }
    }
};
struct EpiDn {
    static constexpr bool PERM = true;
    GAS bf16_t* Y;
    __device__ __forceinline__ void operator()(const f32x4 (&acc)[2][2][4][2], const pg8::Unit& u, int wr, int wc, int fr, int fq) const {
        const int row0 = u.g * XROWS + u.pm * 256 + wr * 64 + fr;
#pragma unroll
        for (int ai = 0; ai < 2; ++ai)
#pragma unroll
            for (int m = 0; m < 4; ++m) {
                const int row = row0 + ai * 128 + m * 16;
#pragma unroll
                for (int bj = 0; bj < 2; ++bj) {
                    const int c0 = u.pn * 256 + bj * 128 + wc * 32 + 8 * fq;
                    const f32x4 v0 = acc[ai][bj][m][0], v1 = acc[ai][bj][m][1];
                    u32x4 w; w.x = pk2(v0[0], v0[1]); w.y = pk2(v0[2], v0[3]); w.z = pk2(v1[0], v1[1]); w.w = pk2(v1[2], v1[3]);
                    *(GAS u32x4*)(Y + (size_t)row * 1024 + c0) = w;
                }
            }
    }
};

#define MFMA32(a, b, c) __builtin_amdgcn_mfma_f32_32x32x16_bf16((a), (b), (c), 0, 0, 0)
#define MFMA16(a, b, c) __builtin_amdgcn_mfma_f32_16x16x32_bf16((a), (b), (c), 0, 0, 0)
struct CJob { const GAS float* src; GAS bf16_t* dst; int N, k0, n0, ldd, rmap, coff; };
__device__ __forceinline__ CJob conv_job_ne(const Frame& F, int jj) {
    const int l = jj / 704, j = jj - l * 704; CJob d;
    if (j < 544) { const int kt = j / 68, nt = j % 68;
        d.src = F.in[I_WIN] + (size_t)l * 1024 * INC; d.N = INC; d.k0 = kt * 128; d.n0 = nt * 128; d.dst = WSP(bf16_t, WS_WIN) + (size_t)l * INC * 1024; d.ldd = 1024; d.rmap = 0; d.coff = 0;
    } else if (j < 640) { const int q = j - 544; const int g = q >> 5, r = q & 31; const int kt = r >> 3, nt = r & 7;
        d.src = (g == 0 ? F.in[I_WA] : (g == 1 ? F.in[I_WB] : F.in[I_WC])) + (size_t)l * 512 * 1024; d.N = 1024; d.k0 = kt * 128; d.n0 = nt * 128;
        d.dst = WSP(bf16_t, WS_WBR) + (size_t)(l * 3 + g) * 1024 * 512; d.ldd = 512; d.rmap = 0; d.coff = 0;
    } else { const int q = j - 640; const int rep = q >> 6, r = q & 63; const int kt = r >> 3, nt = r & 7;
        d.src = F.in[I_WOUT] + (size_t)l * 1024 * 1024; d.N = 1024; d.k0 = kt * 128; d.n0 = nt * 128; d.dst = WSP(bf16_t, WS_WO3) + (size_t)l * 1024 * 3072; d.ldd = 3072; d.rmap = 0; d.coff = rep * 1024; }
    return d;
}
__device__ __forceinline__ CJob conv_job_ex(const Frame& F, int l, int j) {
    CJob d;
    if (j < 5632) { const int up = j >= 2816; const int q = j - up * 2816; const int e = q / 176, r = q % 176; const int kt = r / 22, nt = r % 22;
        d.src = (up ? F.in[I_WEU] : F.in[I_WEG]) + ((size_t)(l * NE + e) * 1024) * FF; d.N = FF; d.k0 = kt * 128; d.n0 = nt * 128;
        d.dst = WSP(bf16_t, WS_WGU) + (size_t)e * 5632 * 1024; d.ldd = 1024; d.rmap = 1 + up; d.coff = 0;
    } else { const int q = j - 5632; const int e = q / 176, r = q % 176; const int kt = r >> 3, nt = r & 7;
        d.src = F.in[I_WED] + ((size_t)(l * NE + e) * FF) * 1024; d.N = 1024; d.k0 = kt * 128; d.n0 = nt * 128; d.dst = WSP(bf16_t, WS_WDN) + (size_t)e * 1024 * FF; d.ldd = FF; d.rmap = 0; d.coff = 0; }
    return d;
}
static __device__ __noinline__ void conv_stream(const Frame F, int kind, int l, int first, int total, int stride) {
    LAS unsigned char* lds = F.lds;
    const int t = F.tid, lane = t & 63; const int w = __builtin_amdgcn_readfirstlane(t >> 6);
    kind = __builtin_amdgcn_readfirstlane(kind); l = __builtin_amdgcn_readfirstlane(l); first = __builtin_amdgcn_readfirstlane(first); total = __builtin_amdgcn_readfirstlane(total); stride = __builtin_amdgcn_readfirstlane(stride);
    if (first >= total) return;
    const int nmy = (total - first + stride - 1) / stride;
    __syncthreads();
    const int krow = lane >> 5, c0 = ((lane & 31) ^ (2 * w)) * 4, c1 = ((lane & 31) ^ (2 * w + 1)) * 4;
    const int kg = lane & 15, qn = lane >> 4;
#define CONV_JOB(J) (kind ? conv_job_ex(F, l, (J)) : conv_job_ne(F, (J)))
#define CONV_LOAD(D, BUF) do { const unsigned vo0 = (unsigned)(krow * (D).N + c0) * 4u, vo1 = (unsigned)(krow * (D).N + c1) * 4u; \
        const char* gb = (const char*)((D).src + (size_t)((D).k0 + 16 * w) * (D).N + (D).n0); const size_t rs2 = (size_t)(D).N * 8; \
        _Pragma("unroll") for (int pi = 0; pi < 8; ++pi) \
            __builtin_amdgcn_global_load_lds((const unsigned*)(gb + pi * rs2 + (pi < 4 ? vo0 : vo1)), (LAS unsigned*)(lds + (BUF) * 65536 + (w * 8 + pi) * 1024), 16, 0, 0); } while (0)
#define CONV_OUT(D, BUF) do { _Pragma("unroll") for (int jj = 0; jj < 4; ++jj) { const int j4 = 4 * w + jj; \
        const LAS float* rp = (const LAS float*)(lds + (BUF) * 65536) + kg * 1024 + ((j4 ^ kg) * 4) + qn; \
        float v[8]; _Pragma("unroll") for (int e = 0; e < 8; ++e) v[e] = rp[e * 128]; \
        u32x4 wv; wv.x = pk2(v[0], v[1]); wv.y = pk2(v[2], v[3]); wv.z = pk2(v[4], v[5]); wv.w = pk2(v[6], v[7]); \
        const int n = (D).n0 + 4 * j4 + qn; const int row = (D).rmap == 0 ? n : (((n >> 7) << 8) + (n & 127) + ((D).rmap == 2 ? 128 : 0)); \
        *(GAS u32x4*)((D).dst + (size_t)row * (D).ldd + (D).coff + (D).k0 + kg * 8) = wv; } } while (0)
#define CONV_WAITV(n) asm volatile("s_waitcnt vmcnt(" #n ")" ::: "memory")
#define CONV_BAR do { asm volatile("s_waitcnt lgkmcnt(0)" ::: "memory"); __builtin_amdgcn_s_barrier(); asm volatile("" ::: "memory"); } while (0)
    { const CJob d = CONV_JOB(first); CONV_LOAD(d, 0); }
    if (nmy > 1) { const CJob d = CONV_JOB(first + stride); CONV_LOAD(d, 1); }
    for (int q = 0; q < nmy; q += 2) {
        const int j = first + q * stride;
        if (q + 1 < nmy) { if (q) CONV_WAITV(12); else CONV_WAITV(8); } else CONV_WAITV(0);
        CONV_BAR;
        { const CJob d = CONV_JOB(j); CONV_OUT(d, 0); }
        if (q + 2 < nmy) { CONV_BAR; const CJob d = CONV_JOB(j + 2 * stride); CONV_LOAD(d, 0); }
        if (q + 1 < nmy) {
            if (q + 2 < nmy) CONV_WAITV(12); else CONV_WAITV(0);
            CONV_BAR;
            { const CJob d = CONV_JOB(j + stride); CONV_OUT(d, 1); }
            if (q + 3 < nmy) { CONV_BAR; const CJob d = CONV_JOB(j + 3 * stride); CONV_LOAD(d, 1); }
        }
    }
#undef CONV_LOAD
#undef CONV_OUT
#undef CONV_JOB
#undef CONV_WAITV
#undef CONV_BAR
    __syncthreads();
}
static __device__ __noinline__ void mod_unit(const Frame F, int u) {
    const int l = u / 96, jb = (u % 96) * 64; const int t = F.tid, cg = t & 15, ds = t >> 4;
    const GAS float* W = F.in[I_WMOD] + (size_t)l * 1024 * 6144;
    f32x4 acc0 = {0, 0, 0, 0}, acc1 = {0, 0, 0, 0}, acc2 = {0, 0, 0, 0};
    for (int dd = 0; dd < 32; ++dd) {
        const int d = ds * 32 + dd;
        const f32x4 w = *(const GAS f32x4*)(W + (size_t)d * 6144 + jb + cg * 4);
        const float s0 = siluf_(F.in[I_C][d]), s1 = siluf_(F.in[I_C][1024 + d]), s2 = siluf_(F.in[I_CCTX][d]);
        acc0 += w * s0; acc1 += w * s1; acc2 += w * s2;
    }
    LAS float* red = (LAS float*)F.lds;
#pragma unroll
    for (int e = 0; e < 4; ++e) { red[(ds * 3 + 0) * 64 + cg * 4 + e] = acc0[e]; red[(ds * 3 + 1) * 64 + cg * 4 + e] = acc1[e]; red[(ds * 3 + 2) * 64 + cg * 4 + e] = acc2[e]; }
    __syncthreads();
    if (t < 192) { const int r = t >> 6, c = t & 63; float s = 0.f;
        for (int q = 0; q < 32; ++q) s += red[(q * 3 + r) * 64 + c];
        WSP(float, WS_MOD)[(size_t)(l * 3 + r) * 6144 + jb + c] = s + F.in[I_BMOD][(size_t)l * 6144 + jb + c]; }
    __syncthreads();
}
__device__ __forceinline__ const CAS float* ucp(const GAS float* p) {
    const unsigned long long a = (unsigned long long)p; const unsigned lo = __builtin_amdgcn_readfirstlane((unsigned)a), hi = __builtin_amdgcn_readfirstlane((unsigned)(a >> 32));
    return (const CAS float*)(((unsigned long long)hi << 32) | lo);
}
__device__ __forceinline__ void f1_unit(const Frame F, int l, int pb, int cb, int n, GAS float* HT, GAS float* PS) {
    LAS float* h1s = (LAS float*)F.lds; LAS float* h2s = h1s + 64 * 256;
    const int t = F.tid, pos = t & 255, p = pb * 256 + pos; const int half = __builtin_amdgcn_readfirstlane(t >> 8);
    l = __builtin_amdgcn_readfirstlane(l); cb = __builtin_amdgcn_readfirstlane(cb);
    const CAS float* w1 = ucp(F.in[I_PW1] + (size_t)l * 33 * 64); const CAS float* b1 = ucp(F.in[I_PB1] + l * 64); const CAS float* fr1 = ucp(F.in[I_PF1] + l * 64);
    const CAS float* w2 = ucp(F.in[I_PW2] + (size_t)l * 64 * 64); const CAS float* b2 = ucp(F.in[I_PB2] + l * 64); const CAS float* fr2 = ucp(F.in[I_PF2] + l * 64);
    const CAS float* w3 = ucp(F.in[I_PW3] + (size_t)l * 64 * 1024);
    const float tn = (float)p * (1.0f / (float)(n - 1));
    const float rev = (float)p / (float)n;
    const float inv2pi = 0.15915494309189535f;
    float z[33];
    z[0] = tn;
#pragma unroll
    for (int j = 0; j < 16; ++j) { const float fj = 1e-4f + (float)j * ((15.0f - 1e-4f) / 15.0f); const float a = fj * rev; z[1 + j] = __builtin_amdgcn_cosf(a); z[17 + j] = -__builtin_amdgcn_sinf(a); }
    for (int mm = 0; mm < 32; ++mm) { const int m = half * 32 + mm; float acc = b1[m];
#pragma unroll
        for (int i = 0; i < 33; ++i) acc += z[i] * w1[i * 64 + m];
        h1s[m * 256 + pos] = __builtin_amdgcn_sinf(fr1[m] * acc * inv2pi); }
    __syncthreads();
    for (int q = 0; q < 2; ++q) { const int m0 = half * 32 + q * 16; float acc[16];
#pragma unroll
      for (int mm = 0; mm < 16; ++mm) acc[mm] = b2[m0 + mm];
      for (int i = 0; i < 64; ++i) { const float hv = h1s[i * 256 + pos];
#pragma unroll
          for (int mm = 0; mm < 16; ++mm) acc[mm] += hv * w2[i * 64 + m0 + mm]; }
#pragma unroll
      for (int mm = 0; mm < 16; ++mm) h2s[(m0 + mm) * 256 + pos] = __builtin_amdgcn_sinf(fr2[m0 + mm] * acc[mm] * inv2pi); }
    __syncthreads();
    LAS bf16_t* w3t = (LAS bf16_t*)F.lds;
    { const GAS float* w3g = F.in[I_PW3] + (size_t)l * 64 * 1024 + cb * 256;
#pragma unroll 8
      for (int i = 0; i < 32; ++i) { const int idx = t + 512 * i; const int m = idx >> 8, c = idx & 255; w3t[c * 72 + m] = (bf16_t)(pk2(w3g[(size_t)m * 1024 + c], 0.f) & 0xFFFFu); } }
    __syncthreads();
    { const int r = F.lane & 31, hh = F.lane >> 5, ct = F.wave;
      const float da = -3.0701134573253945f, db = -15.350567286626973f;
      bf16x8 Af[4];
#pragma unroll
      for (int ks = 0; ks < 4; ++ks) Af[ks] = *(const LAS bf16x8*)(w3t + (32 * ct + r) * 72 + 16 * ks + 8 * hh);
      float delta[16], asum[16];
#pragma unroll
      for (int e = 0; e < 16; ++e) { const int col = cb * 256 + 32 * ct + (e & 3) + 8 * (e >> 2) + 4 * hh; delta[e] = fabsf(da + (float)col * ((db - da) / 1023.0f)); asum[e] = 0.f; }
      for (int pt = 0; pt < 8; ++pt) {
          f32x16 acc;
#pragma unroll
          for (int e = 0; e < 16; ++e) acc[e] = 0.f;
#pragma unroll
          for (int ks = 0; ks < 4; ++ks) { const LAS float* hp = h2s + (16 * ks + 8 * hh) * 256 + 32 * pt + r;
              u32x4 bw; bw.x = pk2(hp[0], hp[256]); bw.y = pk2(hp[512], hp[768]); bw.z = pk2(hp[1024], hp[1280]); bw.w = pk2(hp[1536], hp[1792]);
              bf16x8 Bf; __builtin_memcpy(&Bf, &bw, 16); acc = MFMA32(Af[ks], Bf, acc); }
          const int pp = pb * 256 + 32 * pt + r; const float tnp = (float)pp * (1.0f / (float)(n - 1));
#pragma unroll
          for (int e = 0; e < 16; ++e) { const int col = cb * 256 + 32 * ct + (e & 3) + 8 * (e >> 2) + 4 * hh;
              const float val = acc[e] * __expf(-tnp * delta[e]); HT[(size_t)col * n + pp] = val; asum[e] += fabsf(val); } }
#pragma unroll
      for (int e = 0; e < 16; ++e) { float sa = asum[e]; sa += __shfl_xor(sa, 1); sa += __shfl_xor(sa, 2); sa += __shfl_xor(sa, 4); sa += __shfl_xor(sa, 8); sa += __shfl_xor(sa, 16);
          if (r == 0) PS[(size_t)pb * 1024 + cb * 256 + 32 * ct + (e & 3) + 8 * (e >> 2) + 4 * hh] = sa; } }
    __syncthreads();
}
__device__ __forceinline__ void prologue_phase(const Frame F) {
    constexpr int U_TW = 32, U_ROPE = 6, U_LBC = 4, U_MOD = 192, U_F1 = 256, U_F1C = 4;
    constexpr int O_ROPE = U_TW, O_LBC = O_ROPE + U_ROPE, O_MOD = O_LBC + U_LBC, O_F1 = O_MOD + U_MOD, O_F1C = O_F1 + U_F1, TOTAL = O_F1C + U_F1C;
    for (int st = 0; st < 2; ++st) {
      const bool do_conv = ((F.bid & 1) != 0) == (st == 0);
      if (do_conv) { conv_stream(F, 0, 0, F.bid, 1408, F.G); }
      else {
    for (int u = (F.bid + 22) % F.G; u < TOTAL; u += F.G) {
        if (u < O_ROPE) { const int m = u * 512 + F.tid; float sn, c; sincospif((float)m * (1.0f / 8192.0f), &sn, &c); WSP(f2, WS_TW)[m] = mk2(c, -sn); }
        else if (u < O_LBC) { const int idx = (u - O_ROPE) * 512 + F.tid; const int pp = idx >> 4, i = idx & 15; const int pos = pp < 128 ? pp : pp - 128;
            const float inv = powf(10000.0f, -(float)i / 16.0f); const float ang = (float)pos * inv; WSP(f2, WS_ROPE)[idx] = mk2(cosf(ang), sinf(ang)); }
        else if (u < O_MOD) { const int idx = (u - O_LBC) * 512 + F.tid; const int l = idx >> 10, rem = idx & 1023;
            const float a0 = F.in[I_HGLB][rem], a1 = F.in[I_HGLB][1024 + rem];
            f2 o; if (l == 0) o = mk2(0.f, 1.f); else o = mk2(sigmoidf_(a1 - a0), sigmoidf_(a0 - a1));
            WSP(f2, WS_LBC)[idx] = o; }
        else if (u < O_F1) mod_unit(F, u - O_MOD);
        else { const int j = u - O_F1; const bool isc = j >= U_F1; const int l = isc ? 0 : (j >> 7), pb = isc ? 0 : ((j >> 2) & 31), cb = j & 3;
            f1_unit(F, l, pb, cb, isc ? 256 : 8192, isc ? WSP(float, WS_HTC) : WSP(float, WS_HT) + (size_t)l * 1024 * 8192, isc ? WSP(float, WS_PSC) : WSP(float, WS_PS) + (size_t)l * 32 * 1024); }
    }
      }
    }

}

constexpr int MF_FI = 34816, MF_U = 69632, MF_UI = MF_U + 34816;
__device__ __forceinline__ bf16x8 mf_frag(const LAS bf16_t* M, int row, int k0) { return *(const LAS bf16x8*)(M + row * 136 + k0); }
__device__ __forceinline__ bf16x8 mf_frag_perm(const LAS bf16_t* M, int row, int s, int g) {
    const u32x2 lo = *(const LAS u32x2*)(M + row * 136 + 32 * s + 4 * g), hi = *(const LAS u32x2*)(M + row * 136 + 32 * s + 16 + 4 * g);
    u32x4 w; w.x = lo.x; w.y = lo.y; w.z = hi.x; w.w = hi.y; bf16x8 r; __builtin_memcpy(&r, &w, 16); return r; }
__device__ __forceinline__ bf16x8 mf_pack4(unsigned a, unsigned b, unsigned c, unsigned d) { u32x4 w; w.x = a; w.y = b; w.z = c; w.w = d; bf16x8 r; __builtin_memcpy(&r, &w, 16); return r; }
__device__ __forceinline__ void mf_build_F(const Frame& F) {
    LAS bf16_t* FR = (LAS bf16_t*)F.lds; LAS bf16_t* FI = (LAS bf16_t*)(F.lds + MF_FI);
    for (int idx = F.tid; idx < 8192; idx += NT) { const int a = idx >> 6, b2 = (idx & 63) * 2;
        const float r0 = (float)((a * b2) & 127) * (1.0f / 128.0f), r1 = (float)((a * (b2 + 1)) & 127) * (1.0f / 128.0f);
        *(LAS unsigned*)(FR + a * 136 + b2) = pk2(__builtin_amdgcn_cosf(r0), __builtin_amdgcn_cosf(r1));
        *(LAS unsigned*)(FI + a * 136 + b2) = pk2(-__builtin_amdgcn_sinf(r0), -__builtin_amdgcn_sinf(r1)); }
}
template <int KS1, bool REALIN>
__device__ __forceinline__ void mf_s1(const Frame& F, int w, int r, int g) {
    const LAS bf16_t* FR = (const LAS bf16_t*)F.lds; const LAS bf16_t* FI = (const LAS bf16_t*)(F.lds + MF_FI);
    LAS bf16_t* UR = (LAS bf16_t*)(F.lds + MF_U); LAS bf16_t* UI = (LAS bf16_t*)(F.lds + MF_UI);
    bf16x8 xr[KS1], xi[KS1];
#pragma unroll
    for (int ks = 0; ks < KS1; ++ks) { xr[ks] = mf_frag(UR, 16 * w + r, 32 * ks + 8 * g); if (!REALIN) xi[ks] = mf_frag(UI, 16 * w + r, 32 * ks + 8 * g); }
    __syncthreads();
#pragma unroll 1
    for (int ct = 0; ct < 8; ++ct) {
        f32x4 rr = {0.f, 0.f, 0.f, 0.f}, ii = {0.f, 0.f, 0.f, 0.f}, ri = {0.f, 0.f, 0.f, 0.f};
#pragma unroll
        for (int ks = 0; ks < KS1; ++ks) { const bf16x8 fr = mf_frag(FR, 16 * ct + r, 32 * ks + 8 * g), fi = mf_frag(FI, 16 * ct + r, 32 * ks + 8 * g);
            rr = MFMA16(xr[ks], fr, rr); ri = MFMA16(xr[ks], fi, ri);
            if (!REALIN) { ii = MFMA16(xi[ks], fi, ii); ri = MFMA16(xi[ks], fr, ri); } }
        const int k1 = 16 * ct + r; float br[4], bi[4];
#pragma unroll
        for (int e = 0; e < 4; ++e) { const int n2 = 16 * w + 4 * g + e; const float re = rr[e] - ii[e], im = ri[e];
            const float rev = (float)(k1 * n2) * (1.0f / 16384.0f); const float c = __builtin_amdgcn_cosf(rev), sn = __builtin_amdgcn_sinf(rev);
            br[e] = re * c + im * sn; bi[e] = im * c - re * sn; }
        u32x2 wr, wi; wr.x = pk2(br[0], br[1]); wr.y = pk2(br[2], br[3]); wi.x = pk2(bi[0], bi[1]); wi.y = pk2(bi[2], bi[3]);
        *(LAS u32x2*)(UR + k1 * 136 + 16 * w + 4 * g) = wr; *(LAS u32x2*)(UI + k1 * 136 + 16 * w + 4 * g) = wi;
    }
    __syncthreads();
}
static __device__ __noinline__ void f2_unit(const Frame F, int l, int c) {
    const int w = __builtin_amdgcn_readfirstlane(F.tid >> 6), r = F.lane & 15, g = F.lane >> 4;
    const GAS float* HT = WSP(float, WS_HT) + (size_t)l * 1024 * 8192; const GAS float* PS = WSP(float, WS_PS) + (size_t)l * 32 * 1024;
    float S = 0.f;
    for (int pb = 0; pb < 32; ++pb) S += PS[pb * 1024 + c] + PS[pb * 1024 + 512 + c];
    S -= fabsf(HT[(size_t)(512 + c) * 8192]);
    const float inv = 1.0f / S;
    { LAS bf16_t* UR = (LAS bf16_t*)(F.lds + MF_U);
      const GAS float* hf = HT + (size_t)c * 8192; const GAS float* hb = HT + (size_t)(512 + c) * 8192;
      float v0[16], v1[16];
#pragma unroll
      for (int i = 0; i < 16; ++i) { const int idx = F.tid + NT * i; const int n2 = idx & 127, n1 = (idx >> 7) * 2; const int n = 128 * n1 + n2;
          if (i < 8) { v0[i] = hf[n]; v1[i] = hf[n + 128]; } else { v0[i] = hb[n == 8192 ? 1 : 16384 - n]; v1[i] = hb[16384 - n - 128]; if (n == 8192) v0[i] = 0.f; } }
      mf_build_F(F);
#pragma unroll
      for (int i = 0; i < 16; ++i) { const int idx = F.tid + NT * i; const int n2 = idx & 127, n1 = (idx >> 7) * 2;
          *(LAS unsigned*)(UR + n2 * 136 + n1) = pk2(v0[i] * inv, v1[i] * inv); } }
    __syncthreads();
    mf_s1<4, true>(F, w, r, g);
    { const LAS bf16_t* FR = (const LAS bf16_t*)F.lds; const LAS bf16_t* FI = (const LAS bf16_t*)(F.lds + MF_FI);
      const LAS bf16_t* UR = (const LAS bf16_t*)(F.lds + MF_U); const LAS bf16_t* UI = (const LAS bf16_t*)(F.lds + MF_UI);
      bf16x8 br[4], bi[4];
#pragma unroll
      for (int ks = 0; ks < 4; ++ks) { br[ks] = mf_frag(UR, 16 * w + r, 32 * ks + 8 * g); bi[ks] = mf_frag(UI, 16 * w + r, 32 * ks + 8 * g); }
      GAS f2* KF = WSP(f2, WS_KF) + (size_t)c * 16384 + (16 * w + r) * 128 + 4 * g;
#pragma unroll 1
      for (int t2 = 0; t2 < 8; ++t2) {
          f32x4 rr = {0.f, 0.f, 0.f, 0.f}, ii = {0.f, 0.f, 0.f, 0.f}, ri = {0.f, 0.f, 0.f, 0.f};
#pragma unroll
          for (int ks = 0; ks < 4; ++ks) { const bf16x8 fr = mf_frag(FR, 16 * t2 + r, 32 * ks + 8 * g), fi = mf_frag(FI, 16 * t2 + r, 32 * ks + 8 * g);
              rr = MFMA16(fr, br[ks], rr); ii = MFMA16(fi, bi[ks], ii); ri = MFMA16(fr, bi[ks], ri); ri = MFMA16(fi, br[ks], ri); }
          const float sc = 1.0f / 16384.0f;
          f32x4 o0, o1; o0[0] = (rr[0] - ii[0]) * sc; o0[1] = ri[0] * sc; o0[2] = (rr[1] - ii[1]) * sc; o0[3] = ri[1] * sc; o1[0] = (rr[2] - ii[2]) * sc; o1[1] = ri[2] * sc; o1[2] = (rr[3] - ii[3]) * sc; o1[3] = ri[3] * sc;
          *(GAS f32x4*)(KF + 16 * t2) = o0; *(GAS f32x4*)(KF + 16 * t2 + 2) = o1;
      } }
    __syncthreads();
}
static __device__ __noinline__ void y2_unit(const Frame F, int c) {
    const int w = __builtin_amdgcn_readfirstlane(F.tid >> 6), r = F.lane & 15, g = F.lane >> 4;
    const LAS bf16_t* FR = (const LAS bf16_t*)F.lds; const LAS bf16_t* FI = (const LAS bf16_t*)(F.lds + MF_FI);
    LAS bf16_t* UR = (LAS bf16_t*)(F.lds + MF_U); LAS bf16_t* UI = (LAS bf16_t*)(F.lds + MF_UI);
    { const GAS f2* UT = WSP(f2, WS_UT) + (size_t)c * 8192;
      f2 v0[8], v1[8];
#pragma unroll
      for (int i = 0; i < 8; ++i) { const int idx = F.tid + NT * i; const int n2 = idx & 127, n1 = (idx >> 7) * 2; v0[i] = UT[128 * n1 + n2]; v1[i] = UT[128 * n1 + 128 + n2]; }
      mf_build_F(F);
#pragma unroll
      for (int i = 0; i < 8; ++i) { const int idx = F.tid + NT * i; const int n2 = idx & 127, n1 = (idx >> 7) * 2;
          *(LAS unsigned*)(UR + n2 * 136 + n1) = pk2(v0[i].x, v1[i].x); *(LAS unsigned*)(UI + n2 * 136 + n1) = pk2(v0[i].y, v1[i].y); } }
    __syncthreads();
    mf_s1<2, false>(F, w, r, g);
    {
        const GAS f2* KF = WSP(f2, WS_KF) + (size_t)c * 16384 + (16 * w + r) * 128 + 4 * g;
        f32x4 kfa[2][2];
        kfa[0][0] = *(const GAS f32x4*)(KF); kfa[0][1] = *(const GAS f32x4*)(KF + 2); kfa[1][0] = *(const GAS f32x4*)(KF + 16); kfa[1][1] = *(const GAS f32x4*)(KF + 18);
        bf16x8 br[4], bi[4];
#pragma unroll
        for (int ks = 0; ks < 4; ++ks) { br[ks] = mf_frag(UR, 16 * w + r, 32 * ks + 8 * g); bi[ks] = mf_frag(UI, 16 * w + r, 32 * ks + 8 * g); }
        __syncthreads();
        unsigned zr[8][2], zi[8][2];
#pragma unroll
        for (int t2 = 0; t2 < 8; ++t2) {
            f32x4 rr = {0.f, 0.f, 0.f, 0.f}, ii = {0.f, 0.f, 0.f, 0.f}, ri = {0.f, 0.f, 0.f, 0.f};
#pragma unroll
            for (int ks = 0; ks < 4; ++ks) { const bf16x8 fr = mf_frag(FR, 16 * t2 + r, 32 * ks + 8 * g), fi = mf_frag(FI, 16 * t2 + r, 32 * ks + 8 * g);
                rr = MFMA16(fr, br[ks], rr); ii = MFMA16(fi, bi[ks], ii); ri = MFMA16(fr, bi[ks], ri); ri = MFMA16(fi, br[ks], ri); }
            const f32x4 k0 = kfa[t2 & 1][0], k1v = kfa[t2 & 1][1];
            if (t2 + 2 < 8) { kfa[t2 & 1][0] = *(const GAS f32x4*)(KF + 16 * (t2 + 2)); kfa[t2 & 1][1] = *(const GAS f32x4*)(KF + 16 * (t2 + 2) + 2); }
            float cr[4], ci[4];
#pragma unroll
            for (int e = 0; e < 4; ++e) { cr[e] = rr[e] - ii[e]; ci[e] = ri[e]; }
            const float z0r = cr[0] * k0[0] - ci[0] * k0[1], z0i = cr[0] * k0[1] + ci[0] * k0[0], z1r = cr[1] * k0[2] - ci[1] * k0[3], z1i = cr[1] * k0[3] + ci[1] * k0[2];
            const float z2r = cr[2] * k1v[0] - ci[2] * k1v[1], z2i = cr[2] * k1v[1] + ci[2] * k1v[0], z3r = cr[3] * k1v[2] - ci[3] * k1v[3], z3i = cr[3] * k1v[3] + ci[3] * k1v[2];
            zr[t2][0] = pk2(z0r, z1r); zr[t2][1] = pk2(z2r, z3r); zi[t2][0] = pk2(z0i, z1i); zi[t2][1] = pk2(z2i, z3i);
        }
#pragma unroll 1
        for (int tn = 0; tn < 8; ++tn) {
            f32x4 p = {0.f, 0.f, 0.f, 0.f}, q1 = {0.f, 0.f, 0.f, 0.f}, q2 = {0.f, 0.f, 0.f, 0.f};
#pragma unroll
            for (int sx = 0; sx < 4; ++sx) { const bf16x8 za = mf_pack4(zr[2 * sx][0], zr[2 * sx][1], zr[2 * sx + 1][0], zr[2 * sx + 1][1]), zb = mf_pack4(zi[2 * sx][0], zi[2 * sx][1], zi[2 * sx + 1][0], zi[2 * sx + 1][1]);
                const bf16x8 fr = mf_frag_perm(FR, 16 * tn + r, sx, g), fi = mf_frag_perm(FI, 16 * tn + r, sx, g);
                p = MFMA16(za, fr, p); p = MFMA16(zb, fi, p); q1 = MFMA16(zb, fr, q1); q2 = MFMA16(za, fi, q2); }
            const int n2 = 16 * tn + r; float ar[4], ai[4];
#pragma unroll
            for (int e = 0; e < 4; ++e) { const int k1 = 16 * w + 4 * g + e; const float re = p[e], im = q1[e] - q2[e];
                const float rev = (float)(k1 * n2) * (1.0f / 16384.0f); const float cs = __builtin_amdgcn_cosf(rev), sn = __builtin_amdgcn_sinf(rev);
                ar[e] = re * cs - im * sn; ai[e] = im * cs + re * sn; }
            u32x2 wr, wi; wr.x = pk2(ar[0], ar[1]); wr.y = pk2(ar[2], ar[3]); wi.x = pk2(ai[0], ai[1]); wi.y = pk2(ai[2], ai[3]);
            *(LAS u32x2*)(UR + n2 * 136 + 16 * w + 4 * g) = wr; *(LAS u32x2*)(UI + n2 * 136 + 16 * w + 4 * g) = wi;
        }
        __syncthreads();
    }
    {
        bf16x8 yr[4], yi[4];
#pragma unroll
        for (int ks = 0; ks < 4; ++ks) { yr[ks] = mf_frag(UR, 16 * w + r, 32 * ks + 8 * g); yi[ks] = mf_frag(UI, 16 * w + r, 32 * ks + 8 * g); }
        GAS f2* YT = WSP(f2, WS_YT) + (size_t)c * 8192 + 16 * w + r;
#pragma unroll 1
        for (int tn1 = 0; tn1 < 4; ++tn1) {
            f32x4 p = {0.f, 0.f, 0.f, 0.f}, q1 = {0.f, 0.f, 0.f, 0.f}, q2 = {0.f, 0.f, 0.f, 0.f};
#pragma unroll
            for (int ks = 0; ks < 4; ++ks) { const bf16x8 fr = mf_frag(FR, 16 * tn1 + r, 32 * ks + 8 * g), fi = mf_frag(FI, 16 * tn1 + r, 32 * ks + 8 * g);
                p = MFMA16(fr, yr[ks], p); p = MFMA16(fi, yi[ks], p); q1 = MFMA16(fr, yi[ks], q1); q2 = MFMA16(fi, yr[ks], q2); }
#pragma unroll
            for (int e = 0; e < 4; ++e) { const int n1 = 16 * tn1 + 4 * g + e; YT[128 * n1] = mk2(p[e], q1[e] - q2[e]); }
        }
    }
    __syncthreads();
}

__device__ __forceinline__ float hy_conv3(const GAS bf16_t* P, size_t row0, int t, int n, int col, const GAS float* cw, const GAS float* cb) {
    const GAS bf16_t* p = P + (row0 + t) * PC + P_HY + col;
    const float a = (t > 0) ? bf2f(p[-PC]) : 0.f, b = bf2f(p[0]), c = (t + 1 < n) ? bf2f(p[PC]) : 0.f;
    return a * cw[col] + b * cw[1536 + col] + c * cw[3072 + col] + cb[col];
}
__device__ __forceinline__ f32x4 hy_conv3x4(const GAS bf16_t* P, size_t row0, int t, int n, int col, const GAS float* cw, const GAS float* cb) {
    const GAS bf16_t* p = P + (row0 + t) * PC + P_HY + col;
    u32x2 ra = {0u, 0u}, rc = {0u, 0u};
    if (t > 0) ra = *(const GAS u32x2*)(p - PC);
    const u32x2 rb = *(const GAS u32x2*)p;
    if (t + 1 < n) rc = *(const GAS u32x2*)(p + PC);
    const f32x4 w0 = *(const GAS f32x4*)(cw + col), w1 = *(const GAS f32x4*)(cw + 1536 + col), w2 = *(const GAS f32x4*)(cw + 3072 + col), bb = *(const GAS f32x4*)(cb + col);
    f32x4 o;
    o[0] = lo16(ra.x) * w0[0] + lo16(rb.x) * w1[0] + lo16(rc.x) * w2[0] + bb[0];
    o[1] = hi16(ra.x) * w0[1] + hi16(rb.x) * w1[1] + hi16(rc.x) * w2[1] + bb[1];
    o[2] = lo16(ra.y) * w0[2] + lo16(rb.y) * w1[2] + lo16(rc.y) * w2[2] + bb[2];
    o[3] = hi16(ra.y) * w0[3] + hi16(rb.y) * w1[3] + hi16(rc.y) * w2[3] + bb[3];
    return o;
}
static __device__ __noinline__ void y1_unit(const Frame F, int l, int u) {
    const int nb = u >> 4, cbk = u & 15, n0 = nb * 64, c0 = cbk * 32;
    LAS f2* zt = (LAS f2*)F.lds;
    const GAS bf16_t* P = WSP(bf16_t, WS_P); const GAS float* cw = F.in[I_CW] + (size_t)l * 3 * 1536; const GAS float* cb = F.in[I_CB] + (size_t)l * 1536;
    { const int nn = F.tid >> 3, c4 = (F.tid & 7) * 4, n = n0 + nn, c = c0 + c4;
      const f32x4 a0 = hy_conv3x4(P, 0, n, SEQ, 512 + c, cw, cb), v0 = hy_conv3x4(P, 0, n, SEQ, 1024 + c, cw, cb);
      const f32x4 a1 = hy_conv3x4(P, SEQ, n, SEQ, 512 + c, cw, cb), v1 = hy_conv3x4(P, SEQ, n, SEQ, 1024 + c, cw, cb);
#pragma unroll
      for (int e = 0; e < 4; ++e) zt[(c4 + e) * 65 + nn] = mk2(a0[e] * v0[e], a1[e] * v1[e]); }
    __syncthreads();
    { const int nn = F.tid & 63, cg = F.tid >> 6; GAS f2* UT = WSP(f2, WS_UT);
#pragma unroll
      for (int i = 0; i < 4; ++i) { const int cc = cg + 8 * i; UT[(size_t)(c0 + cc) * 8192 + n0 + nn] = zt[cc * 65 + nn]; } }
    __syncthreads();
}
static __device__ __noinline__ void y3_unit(const Frame F, int l, int u) {
    const int nb = u >> 4, cbk = u & 15, n0 = nb * 64, c0 = cbk * 32;
    LAS f2* yt = (LAS f2*)F.lds;
    const GAS bf16_t* P = WSP(bf16_t, WS_P); const GAS float* cw = F.in[I_CW] + (size_t)l * 3 * 1536; const GAS float* cb = F.in[I_CB] + (size_t)l * 1536;
    const GAS float* skip = F.in[I_SKIP] + (size_t)l * 512;
    { const int nn = F.tid & 63, cg = F.tid >> 6; const GAS f2* YT = WSP(f2, WS_YT);
#pragma unroll
      for (int i = 0; i < 4; ++i) { const int cc = cg + 8 * i; yt[cc * 65 + nn] = YT[(size_t)(c0 + cc) * 8192 + n0 + nn]; } }
    __syncthreads();
    { const int nn = F.tid >> 3, c4 = (F.tid & 7) * 4, n = n0 + nn, c = c0 + c4; GAS bf16_t* MIX = WSP(bf16_t, WS_MIX);
      const f32x4 sk = *(const GAS f32x4*)(skip + c);
#pragma unroll
      for (int b = 0; b < 2; ++b) { const size_t r0 = (size_t)b * SEQ;
          const f32x4 x0 = hy_conv3x4(P, r0, n, SEQ, c, cw, cb), x1 = hy_conv3x4(P, r0, n, SEQ, 512 + c, cw, cb), v = hy_conv3x4(P, r0, n, SEQ, 1024 + c, cw, cb);
          float o[4];
#pragma unroll
          for (int e = 0; e < 4; ++e) { const f2 y = yt[(c4 + e) * 65 + nn]; const float yb = b ? y.y : y.x; o[e] = x0[e] * (yb + sk[e] * x1[e] * v[e]); }
          u32x2 w; w.x = pk2(o[0], o[1]); w.y = pk2(o[2], o[3]);
          *(GAS u32x2*)(MIX + (r0 + n) * 1536 + 1024 + c) = w; } }
    __syncthreads();
}
static __device__ __noinline__ void yctx_unit(const Frame F, int u) {
    const int tq = u & 3, cbk = (u >> 2) & 15, b = u >> 6;
    LAS float* zs = (LAS float*)F.lds;
    LAS float* gs = zs + 8192;
    LAS float* x0s = gs + 16384;
    const GAS bf16_t* P = WSP(bf16_t, WS_P); const GAS float* cw = F.in[I_CW]; const GAS float* cb = F.in[I_CB]; const GAS float* skip = F.in[I_SKIP];
    const GAS float* HTC = WSP(float, WS_HTC); const GAS float* PSC = WSP(float, WS_PSC);
    const size_t r0 = (size_t)RL + (size_t)b * CTX; const int c0 = cbk * 32, t0 = tq * 64;
    { const int c4 = (F.tid & 7) * 4;
#pragma unroll
      for (int i = 0; i < 4; ++i) { const int sidx = (F.tid >> 3) + 64 * i;
          const f32x4 x1 = hy_conv3x4(P, r0, sidx, CTX, 512 + c0 + c4, cw, cb), v = hy_conv3x4(P, r0, sidx, CTX, 1024 + c0 + c4, cw, cb);
#pragma unroll
          for (int e = 0; e < 4; ++e) zs[sidx * 32 + c4 + e] = x1[e] * v[e]; }
      { const int tt = F.tid >> 3; const f32x4 x0 = hy_conv3x4(P, r0, t0 + tt, CTX, c0 + c4, cw, cb);
#pragma unroll
        for (int e = 0; e < 4; ++e) x0s[tt * 32 + c4 + e] = x0[e]; } }
    { const int m = F.tid & 255, cg = F.tid >> 8;
#pragma unroll 4
      for (int i = 0; i < 16; ++i) { const int cc = cg * 16 + i, c = c0 + cc;
          const float inv = 1.0f / (PSC[c] + PSC[512 + c] - fabsf(HTC[(size_t)(512 + c) * 256]));
          gs[(255 + m) * 32 + cc] = HTC[(size_t)c * 256 + m] * inv;
          if (m >= 1) gs[(255 - m) * 32 + cc] = HTC[(size_t)(512 + c) * 256 + m] * inv; } }
    __syncthreads();
    { const int cc = F.tid & 31, tg = F.tid >> 5; const int tl = tg * 4;
      float a0 = 0.f, a1 = 0.f, a2 = 0.f, a3 = 0.f;
      const LAS float* gp = gs + (255 + t0 + tl) * 32 + cc; const LAS float* zp = zs + cc;
#pragma unroll 8
      for (int sidx = 0; sidx < 256; ++sidx) { const float zv = zp[sidx * 32];
          a0 += gp[(0 - sidx) * 32] * zv; a1 += gp[(1 - sidx) * 32] * zv; a2 += gp[(2 - sidx) * 32] * zv; a3 += gp[(3 - sidx) * 32] * zv; }
      GAS bf16_t* MIX = WSP(bf16_t, WS_MIX); const float sk = skip[c0 + cc];
      const float acc[4] = {a0, a1, a2, a3};
#pragma unroll
      for (int e = 0; e < 4; ++e) { const int t = t0 + tl + e;
          MIX[(r0 + t) * 1536 + 1024 + c0 + cc] = f2bf(x0s[(tl + e) * 32 + cc] * (acc[e] + sk * zs[t * 32 + cc])); } }
    __syncthreads();
}

__device__ __forceinline__ const GAS float* x_row(const Frame F, int l, int row) {
    if (l == 0) return row < RL ? F.in[I_X] + (size_t)row * 1024 : F.in[I_CTX] + (size_t)(row - RL) * 1024;
    return WSP(float, WS_XM) + (size_t)row * 1024;
}
static __device__ __noinline__ void norm1_rows(const Frame F, int l) {
    const GAS float* nm = F.in[I_NMIX] + (size_t)l * 1024; const GAS float* mod = WSP(float, WS_MOD) + (size_t)l * 3 * 6144; GAS bf16_t* HX = WSP(bf16_t, WS_HX);
    for (int row = F.bid * 8 + F.wave; row < R; row += F.G * 8) {
        const GAS float* src = x_row(F, l, row); const int rb = row < RL ? (row >> 13) : 2; const GAS float* md = mod + rb * 6144;
        f32x4 xa[2], xb[2]; float ss = 0.f;
#pragma unroll
        for (int i = 0; i < 2; ++i) { const int d0 = 8 * F.lane + 512 * i; xa[i] = *(const GAS f32x4*)(src + d0); xb[i] = *(const GAS f32x4*)(src + d0 + 4);
#pragma unroll
            for (int q = 0; q < 4; ++q) ss += xa[i][q] * xa[i][q] + xb[i][q] * xb[i][q]; }
        ss = wave_sum(ss); const float rs = rsqrtf(ss * (1.0f / 1024.0f) + EPS);
#pragma unroll
        for (int i = 0; i < 2; ++i) { const int d0 = 8 * F.lane + 512 * i;
            const f32x4 na = *(const GAS f32x4*)(nm + d0), nb = *(const GAS f32x4*)(nm + d0 + 4);
            const f32x4 sa = *(const GAS f32x4*)(md + 1024 + d0), sb = *(const GAS f32x4*)(md + 1024 + d0 + 4);
            const f32x4 ha = *(const GAS f32x4*)(md + d0), hb = *(const GAS f32x4*)(md + d0 + 4);
            float h[8];
#pragma unroll
            for (int q = 0; q < 4; ++q) { h[q] = xa[i][q] * rs * na[q] * (1.0f + sa[q]) + ha[q]; h[4 + q] = xb[i][q] * rs * nb[q] * (1.0f + sb[q]) + hb[q]; }
            u32x4 hw; hw.x = pk2(h[0], h[1]); hw.y = pk2(h[2], h[3]); hw.z = pk2(h[4], h[5]); hw.w = pk2(h[6], h[7]);
            *(GAS u32x4*)(HX + (size_t)row * 1024 + d0) = hw; }
    }
}
static __device__ __noinline__ void e1_phase(const Frame F, int l) {
    LAS float* wr = (LAS float*)F.lds;
    const GAS float* WR = F.in[I_WR] + (size_t)l * 1024 * 16;
    for (int idx = F.tid; idx < 16384; idx += NT) { const int d = idx >> 4, e = idx & 15; const int i = d >> 9, ln = (d >> 3) & 63, jj = d & 7; wr[((i * 8 + jj) * 64 + ln) * 16 + e] = WR[idx]; }
    __syncthreads();
    const GAS float* nm = F.in[I_NFFN] + (size_t)l * 1024; const GAS float* mod = WSP(float, WS_MOD) + (size_t)l * 3 * 6144; GAS bf16_t* HX = WSP(bf16_t, WS_HX);
    GAS float* AFF = WSP(float, WS_AFF);
    const int nrows = (l == 0) ? R : RL;
    for (int row = F.bid * 8 + F.wave; row < nrows; row += F.G * 8) {
        const GAS float* src = x_row(F, l, row); GAS float* xm = WSP(float, WS_XM) + (size_t)row * 1024; const GAS bf16_t* dl = WSP(bf16_t, WS_T) + (size_t)row * 1024;
        const int rb = row < RL ? (row >> 13) : 2; const GAS float* md = mod + rb * 6144;
        float v[16]; float ss = 0.f;
#pragma unroll
        for (int i = 0; i < 2; ++i) { const int d0 = 8 * F.lane + 512 * i;
            const f32x4 xa = *(const GAS f32x4*)(src + d0), xb = *(const GAS f32x4*)(src + d0 + 4); const u32x4 dw = *(const GAS u32x4*)(dl + d0);
            const f32x4 ga = *(const GAS f32x4*)(md + 2048 + d0), gb = *(const GAS f32x4*)(md + 2048 + d0 + 4);
            f32x4 ya, yb;
            ya[0] = xa[0] + ga[0] * lo16(dw.x); ya[1] = xa[1] + ga[1] * hi16(dw.x); ya[2] = xa[2] + ga[2] * lo16(dw.y); ya[3] = xa[3] + ga[3] * hi16(dw.y);
            yb[0] = xb[0] + gb[0] * lo16(dw.z); yb[1] = xb[1] + gb[1] * hi16(dw.z); yb[2] = xb[2] + gb[2] * lo16(dw.w); yb[3] = xb[3] + gb[3] * hi16(dw.w);
            *(GAS f32x4*)(xm + d0) = ya; *(GAS f32x4*)(xm + d0 + 4) = yb;
#pragma unroll
            for (int q = 0; q < 4; ++q) { v[8 * i + q] = ya[q]; v[8 * i + 4 + q] = yb[q]; ss += ya[q] * ya[q] + yb[q] * yb[q]; } }
        ss = wave_sum(ss); const float rs = rsqrtf(ss * (1.0f / 1024.0f) + EPS);
        float lg[16];
#pragma unroll
        for (int e = 0; e < 16; ++e) lg[e] = 0.f;
#pragma unroll
        for (int i = 0; i < 2; ++i) { const int d0 = 8 * F.lane + 512 * i;
            const f32x4 na = *(const GAS f32x4*)(nm + d0), nb = *(const GAS f32x4*)(nm + d0 + 4);
            const f32x4 sa = *(const GAS f32x4*)(md + 4096 + d0), sb = *(const GAS f32x4*)(md + 4096 + d0 + 4);
            const f32x4 ha = *(const GAS f32x4*)(md + 3072 + d0), hb = *(const GAS f32x4*)(md + 3072 + d0 + 4);
            float h[8];
#pragma unroll
            for (int q = 0; q < 4; ++q) { h[q] = v[8 * i + q] * rs * na[q] * (1.0f + sa[q]) + ha[q]; h[4 + q] = v[8 * i + 4 + q] * rs * nb[q] * (1.0f + sb[q]) + hb[q]; }
            u32x4 hw; hw.x = pk2(h[0], h[1]); hw.y = pk2(h[2], h[3]); hw.z = pk2(h[4], h[5]); hw.w = pk2(h[6], h[7]);
            *(GAS u32x4*)(HX + (size_t)row * 1024 + d0) = hw;
#pragma unroll
            for (int jj = 0; jj < 8; ++jj) {
#pragma unroll
                for (int q = 0; q < 4; ++q) { const f32x4 w = *(const LAS f32x4*)(wr + ((i * 8 + jj) * 64 + F.lane) * 16 + 4 * q);
                    lg[4 * q + 0] += h[jj] * w[0]; lg[4 * q + 1] += h[jj] * w[1]; lg[4 * q + 2] += h[jj] * w[2]; lg[4 * q + 3] += h[jj] * w[3]; }
                if (jj & 1) asm volatile("" ::: "memory"); } }
        float mx = -INFINITY;
#pragma unroll
        for (int e = 0; e < 16; ++e) { lg[e] = wave_sum(lg[e]); mx = fmaxf(mx, lg[e]); }
        float sum = 0.f;
#pragma unroll
        for (int e = 0; e < 16; ++e) { lg[e] = expf(lg[e] - mx); sum += lg[e]; }
        const float is = 1.0f / sum; float mine = 0.f;
#pragma unroll
        for (int e = 0; e < 16; ++e) mine = (F.lane == e) ? lg[e] * is : mine;
        { const bool isc = row >= RL; const int rr = isc ? row - RL : row; const int b = isc ? (rr >> 8) : (rr >> 13), n = isc ? (rr & 255) : (rr & 8191);
          const size_t li = isc ? (size_t)32 * 8192 + (size_t)(b * 16 + (F.lane & 15)) * 256 + n : (size_t)(b * 16 + (F.lane & 15)) * 8192 + n;
          if (F.lane < 16) AFF[li] = mine; }
    }
    __syncthreads();
}
__device__ __forceinline__ int e2_block_excl_scan(int v, LAS int* red, int lane, int wave) {
    int inc = v;
#pragma unroll
    for (int o = 1; o < 64; o <<= 1) { const int y = __shfl_up(inc, o); if (lane >= o) inc += y; }
    if (lane == 63) red[wave] = inc;
    __syncthreads();
    int base = inc - v;
#pragma unroll
    for (int w = 0; w < 8; ++w) { const int rw = red[w]; base += (w < wave) ? rw : 0; }
    __syncthreads();
    return base;
}
__device__ __forceinline__ void e2_unit(const Frame F, int list, bool isctx) {
    const int n = isctx ? CTX : SEQ, k = isctx ? CAPC : CAP;
    const int b = list >> 4, e = list & 15;
    const GAS float* aff = WSP(float, WS_AFF) + (isctx ? (size_t)32 * 8192 + (size_t)list * 256 : (size_t)list * 8192);
    GAS int* IDX = WSP(int, WS_IDX) + (isctx ? 32 * 1024 + list * 32 : list * 1024);
    GAS int* SLOT = WSP(int, WS_SLOT);
    LAS int* hist = (LAS int*)F.lds;
    LAS int* ctl = hist + 264;
    LAS int* red = hist + 272;
    const bool tvalid = F.tid * 16 < n;
    unsigned kh[16];
#pragma unroll
    for (int j = 0; j < 16; ++j) kh[j] = 0u;
    if (tvalid) {
#pragma unroll
        for (int j = 0; j < 16; ++j) kh[j] = __float_as_uint(aff[F.tid * 16 + j]); }
    unsigned prefix = 0u; int krem = k;
    for (int pass = 0; pass < 4; ++pass) {
        const int shift = 24 - 8 * pass;
        const unsigned himask = pass == 0 ? 0u : (0xFFFFFFFFu << (shift + 8));
        if (F.tid < 257) hist[F.tid] = 0;
        __syncthreads();
#pragma unroll
        for (int j = 0; j < 16; ++j) { const bool mt = tvalid && (kh[j] & himask) == (prefix & himask);
            __hip_atomic_fetch_add(hist + (mt ? (int)((kh[j] >> shift) & 255u) : 256), 1, __ATOMIC_RELAXED, __HIP_MEMORY_SCOPE_WORKGROUP); }
        __syncthreads();
        if (F.tid < 64) {
            const int L = F.tid; const int c0 = hist[4 * L], c1 = hist[4 * L + 1], c2 = hist[4 * L + 2], c3 = hist[4 * L + 3]; const int loc = c0 + c1 + c2 + c3;
            int suf = loc;
#pragma unroll
            for (int o = 1; o < 64; o <<= 1) { const int y = __shfl_down(suf, o); if (L + o < 64) suf += y; }
            const int above = suf - loc;
            const int cum3 = above + c3, cum2 = cum3 + c2, cum1 = cum2 + c1;
            const int bsel = cum3 >= krem ? 4 * L + 3 : (cum2 >= krem ? 4 * L + 2 : (cum1 >= krem ? 4 * L + 1 : 4 * L));
            const int cab = cum3 >= krem ? above : (cum2 >= krem ? cum3 : (cum1 >= krem ? cum2 : cum1));
            if (above < krem && above + loc >= krem) { ctl[0] = bsel; ctl[1] = cab; }
        }
        __syncthreads();
        prefix |= (unsigned)ctl[0] << shift; krem -= ctl[1];
        __syncthreads();
    }
    const unsigned th = prefix;
    int ceq = 0;
#pragma unroll
    for (int j = 0; j < 16; ++j) ceq += (tvalid && kh[j] == th) ? 1 : 0;
    int eqrun = e2_block_excl_scan(ceq, red, F.lane, F.wave);
    unsigned selmask = 0u; int csel = 0;
#pragma unroll
    for (int j = 0; j < 16; ++j) { const bool gt = tvalid && kh[j] > th, eq = tvalid && kh[j] == th;
        const bool sel = gt || (eq && eqrun < krem); eqrun += eq ? 1 : 0;
        selmask |= sel ? (1u << j) : 0u; csel += sel ? 1 : 0; }
    int base = e2_block_excl_scan(csel, red, F.lane, F.wave);
    if (tvalid) {
#pragma unroll
        for (int j = 0; j < 16; ++j) { const int i = F.tid * 16 + j; const bool sel = (selmask >> j) & 1u; const int row = isctx ? RL + b * CTX + i : b * SEQ + i;
            SLOT[(isctx ? (size_t)32 * 8192 + (size_t)list * 256 : (size_t)list * 8192) + i] = sel ? base : -1;
            if (sel) IDX[base] = i;
            base += sel ? 1 : 0; } }
}
static __device__ __noinline__ void e3_phase(const Frame F, int l) {
    const GAS bf16_t* HX = WSP(bf16_t, WS_HX); GAS bf16_t* XG = WSP(bf16_t, WS_XG); const GAS int* IDX = WSP(int, WS_IDX);
    const int total = 32768 + (l == 0 ? 1024 : 0);
    for (int j0 = (F.bid * 8 + F.wave) * 4; j0 < total; j0 += F.G * 8 * 4) {
        int src[4], dst[4];
#pragma unroll
        for (int q = 0; q < 4; ++q) { const int j = j0 + q;
            if (j < 32768) { const int e = j >> 11, rem = j & 2047, b = rem >> 10, slot = rem & 1023; src[q] = b * SEQ + IDX[(b * 16 + e) * 1024 + slot]; dst[q] = e * XROWS + rem; }
            else { const int jj = j - 32768; const int e = jj >> 6, rem = jj & 63, b = rem >> 5, slot = rem & 31; src[q] = RL + b * CTX + IDX[32 * 1024 + (b * 16 + e) * 32 + slot]; dst[q] = e * XROWS + 2048 + rem; } }
        u32x4 v[4][2];
#pragma unroll
        for (int q = 0; q < 4; ++q) { const GAS u32x4* sp = (const GAS u32x4*)(HX + (size_t)src[q] * 1024); v[q][0] = sp[F.lane]; v[q][1] = sp[64 + F.lane]; }
#pragma unroll
        for (int q = 0; q < 4; ++q) { GAS u32x4* dp = (GAS u32x4*)(XG + (size_t)dst[q] * 1024); dp[F.lane] = v[q][0]; dp[64 + F.lane] = v[q][1]; }
    }
}
static __device__ __noinline__ void e6_phase(const Frame F, int l) {
    const GAS bf16_t* Y = WSP(bf16_t, WS_Y); const GAS int* SLOT = WSP(int, WS_SLOT); const GAS float* AFF = WSP(float, WS_AFF);
    const GAS float* mod = WSP(float, WS_MOD) + (size_t)l * 3 * 6144; GAS float* XM = WSP(float, WS_XM);
    const GAS float* nm1 = F.in[I_NMIX] + 1024; const GAS float* mod1 = WSP(float, WS_MOD) + (size_t)3 * 6144; GAS bf16_t* HX = WSP(bf16_t, WS_HX);
    const int nrows = (l == 0) ? R : RL;
    for (int row = F.bid * 8 + F.wave; row < nrows; row += F.G * 8) {
        const bool isctx = row >= RL; const int rr = isctx ? row - RL : row; const int b = isctx ? (rr >> 8) : (rr >> 13); const int n = isctx ? (rr & 255) : (rr & 8191);
        int s = -1; float a = 0.f;
        if (F.lane < 16) { const size_t li = isctx ? (size_t)32 * 8192 + (size_t)(b * 16 + F.lane) * 256 + n : (size_t)(b * 16 + F.lane) * 8192 + n; s = SLOT[li]; a = AFF[li]; }
        const GAS float* xs = XM + (size_t)row * 1024;
        f32x4 xv[4];
#pragma unroll
        for (int i = 0; i < 2; ++i)
#pragma unroll
            for (int hq = 0; hq < 2; ++hq) xv[2 * i + hq] = *(const GAS f32x4*)(xs + 8 * F.lane + 512 * i + 4 * hq);
        unsigned long long mask = __ballot(s >= 0);
        const int off = isctx ? 2048 + b * 32 : b * 1024;
        float acc[16];
#pragma unroll
        for (int i = 0; i < 16; ++i) acc[i] = 0.f;
        while (mask) {
            u32x4 w[3][2]; float ae[3];
#pragma unroll
            for (int q = 0; q < 3; ++q) {
                if (mask) { const int e = __ffsll((long long)mask) - 1; mask &= mask - 1; const int se = __shfl(s, e); ae[q] = __shfl(a, e);
                    const GAS bf16_t* yr = Y + ((size_t)e * XROWS + off + se) * 1024 + 8 * F.lane; w[q][0] = *(const GAS u32x4*)(yr); w[q][1] = *(const GAS u32x4*)(yr + 512); }
                else { ae[q] = 0.f; w[q][0] = (u32x4){0u, 0u, 0u, 0u}; w[q][1] = (u32x4){0u, 0u, 0u, 0u}; } }
#pragma unroll
            for (int q = 0; q < 3; ++q)
#pragma unroll
                for (int i = 0; i < 2; ++i) { const u32x4 ww = w[q][i]; const float aq = ae[q];
                    acc[8 * i + 0] += aq * lo16(ww.x); acc[8 * i + 1] += aq * hi16(ww.x); acc[8 * i + 2] += aq * lo16(ww.y); acc[8 * i + 3] += aq * hi16(ww.y);
                    acc[8 * i + 4] += aq * lo16(ww.z); acc[8 * i + 5] += aq * hi16(ww.z); acc[8 * i + 6] += aq * lo16(ww.w); acc[8 * i + 7] += aq * hi16(ww.w); } }
        const int rb = isctx ? 2 : b; const GAS float* g2 = mod + rb * 6144 + 5 * 1024;
        GAS float* dst = (l == 1) ? F.out + (size_t)row * 1024 : XM + (size_t)row * 1024;
        float ss = 0.f;
#pragma unroll
        for (int i = 0; i < 2; ++i)
#pragma unroll
            for (int hq = 0; hq < 2; ++hq) { const int d0 = 8 * F.lane + 512 * i + 4 * hq;
                const f32x4 gv = *(const GAS f32x4*)(g2 + d0);
                f32x4 o;
#pragma unroll
                for (int q = 0; q < 4; ++q) { o[q] = xv[2 * i + hq][q] + gv[q] * acc[8 * i + 4 * hq + q]; ss += o[q] * o[q]; }
                xv[2 * i + hq] = o;
                *(GAS f32x4*)(dst + d0) = o; }
        if (l == 0) {
            ss = wave_sum(ss); const float rs = rsqrtf(ss * (1.0f / 1024.0f) + EPS); const GAS float* md = mod1 + rb * 6144;
#pragma unroll
            for (int i = 0; i < 2; ++i) { const int d0 = 8 * F.lane + 512 * i;
                const f32x4 na = *(const GAS f32x4*)(nm1 + d0), nb = *(const GAS f32x4*)(nm1 + d0 + 4);
                const f32x4 sa = *(const GAS f32x4*)(md + 1024 + d0), sb = *(const GAS f32x4*)(md + 1024 + d0 + 4);
                const f32x4 ha = *(const GAS f32x4*)(md + d0), hb = *(const GAS f32x4*)(md + d0 + 4);
                float h[8];
#pragma unroll
                for (int q = 0; q < 4; ++q) { h[q] = xv[2 * i][q] * rs * na[q] * (1.0f + sa[q]) + ha[q]; h[4 + q] = xv[2 * i + 1][q] * rs * nb[q] * (1.0f + sb[q]) + hb[q]; }
                u32x4 hw; hw.x = pk2(h[0], h[1]); hw.y = pk2(h[2], h[3]); hw.z = pk2(h[4], h[5]); hw.w = pk2(h[6], h[7]);
                *(GAS u32x4*)(HX + (size_t)row * 1024 + d0) = hw; }
        }
    }
}

__device__ __forceinline__ int hg_row(int dir, int b, int p, int rho) {
    if (dir == 0) return p < 4 ? RL + b * CTX + p * 64 + rho : b * SEQ + (p - 4) * 64 + rho;
    return p < 4 ? RL + b * CTX + (3 - p) * 64 + (63 - rho) : b * SEQ + (131 - p) * 64 + (63 - rho);
}
__device__ __forceinline__ u32x4 pack8(const float (&e)[16], int o) { u32x4 w; w.x = pk2(e[o], e[o + 1]); w.y = pk2(e[o + 2], e[o + 3]); w.z = pk2(e[o + 4], e[o + 5]); w.w = pk2(e[o + 6], e[o + 7]); return w; }
static __device__ __noinline__ void h1_unit(const Frame F, int u) {
    const int ch = u / NCH, p = u - ch * NCH; const int dir = ch >> 3, b = (ch >> 2) & 1, h = ch & 3;
    LAS bf16_t* KT = (LAS bf16_t*)F.lds; LAS bf16_t* VT = (LAS bf16_t*)(F.lds + 18432); LAS float* tot = (LAS float*)(F.lds + 36864);
    const GAS float* LF = WSP(float, WS_LF); const GAS bf16_t* P = WSP(bf16_t, WS_P);
    const int k = F.tid & 127, seg = F.tid >> 7;
    float lf[16]; u32x4 vreg[2];
#pragma unroll
    for (int j = 0; j < 16; ++j) { const int row = hg_row(dir, b, p, seg * 16 + j); lf[j] = LF[(size_t)row * 1024 + dir * 512 + h * 128 + k]; }
#pragma unroll
    for (int i = 0; i < 2; ++i) { const int idx8 = F.tid + NT * i; const int rho = idx8 >> 4, c8 = (idx8 & 15) * 8; const int row = hg_row(dir, b, p, rho);
        vreg[i] = *(const GAS u32x4*)(P + (size_t)row * PC + P_I + h * 128 + c8); }
    float cs[16]; float run = 0.f;
#pragma unroll
    for (int j = 0; j < 16; ++j) { run += lf[j]; cs[j] = run; }
    tot[seg * 128 + k] = run;
#pragma unroll
    for (int i = 0; i < 2; ++i) { const int idx8 = F.tid + NT * i; const int rho = idx8 >> 4, c8 = (idx8 & 15) * 8; LAS bf16_t* vt = VT + c8 * 72 + (rho ^ (((c8 >> 3) & 7) << 3));
        vt[0 * 72] = (bf16_t)(vreg[i].x & 0xFFFF); vt[1 * 72] = (bf16_t)(vreg[i].x >> 16); vt[2 * 72] = (bf16_t)(vreg[i].y & 0xFFFF); vt[3 * 72] = (bf16_t)(vreg[i].y >> 16);
        vt[4 * 72] = (bf16_t)(vreg[i].z & 0xFFFF); vt[5 * 72] = (bf16_t)(vreg[i].z >> 16); vt[6 * 72] = (bf16_t)(vreg[i].w & 0xFFFF); vt[7 * 72] = (bf16_t)(vreg[i].w >> 16); }
    __syncthreads();
    { const float t0 = tot[k], t1 = tot[128 + k], t2 = tot[256 + k], t3 = tot[384 + k];
      const float off = seg == 0 ? 0.f : (seg == 1 ? t0 : (seg == 2 ? t0 + t1 : t0 + t1 + t2)); const float rem = (t0 + t1 + t2 + t3) - off;
      if (seg == 0) WSP(float, WS_DEC)[(size_t)u * 128 + k] = __expf(rem);
      float kt[16];
#pragma unroll
      for (int j = 0; j < 16; ++j) kt[j] = (1.0f - __expf(lf[j])) * __expf(rem - cs[j]);
      *(LAS u32x4*)(KT + k * 72 + seg * 16) = pack8(kt, 0); *(LAS u32x4*)(KT + k * 72 + seg * 16 + 8) = pack8(kt, 8); }
    __syncthreads();
    { const int r = F.lane & 31, hh = F.lane >> 5; const int mt = F.wave >> 1, nt0 = (F.wave & 1) * 2;
      LAS bf16_t* stg = (LAS bf16_t*)(F.lds + 40960);
#pragma unroll
      for (int q = 0; q < 2; ++q) { const int nt = nt0 + q; f32x16 acc;
#pragma unroll
          for (int e = 0; e < 16; ++e) acc[e] = 0.f;
#pragma unroll
          for (int ks = 0; ks < 4; ++ks) { const bf16x8 A = *(const LAS bf16x8*)(VT + (32 * mt + r) * 72 + ((16 * ks + 8 * hh) ^ ((((32 * mt + r) >> 3) & 7) << 3))); const bf16x8 B = *(const LAS bf16x8*)(KT + (32 * nt + r) * 72 + 16 * ks + 8 * hh);
              acc = MFMA32(A, B, acc); }
#pragma unroll
          for (int e = 0; e < 16; e += 2) { const int vrow = 32 * mt + (e & 3) + 8 * (e >> 2) + 4 * hh; const unsigned w = pk2(acc[e], acc[e + 1]);
              stg[vrow * 136 + 32 * nt + r] = (bf16_t)(w & 0xFFFFu); stg[(vrow + 1) * 136 + 32 * nt + r] = (bf16_t)(w >> 16); } } }
    __syncthreads();
    { GAS bf16_t* dst = WSP(bf16_t, WS_DS) + (size_t)u * 16384; const LAS bf16_t* stg = (const LAS bf16_t*)(F.lds + 40960);
#pragma unroll
      for (int i = 0; i < 4; ++i) { const int idx = F.tid + NT * i; const int v = idx >> 4, k8 = (idx & 15) * 8; *(GAS u32x4*)(dst + v * 128 + k8) = *(const LAS u32x4*)(stg + v * 136 + k8); } }
    __syncthreads();
}
static __device__ __noinline__ void h2_phase(const Frame F) {
    LAS float* dcs = (LAS float*)F.lds;
    const int bidu = __builtin_amdgcn_readfirstlane(F.bid), Gu = __builtin_amdgcn_readfirstlane(F.G);
    for (int e0 = bidu * NT; e0 < 131072; e0 += Gu * NT) {
        const int ch = e0 >> 13; const unsigned el = (unsigned)(((e0 + F.tid) & 8191) * 2); const int k = el & 127;
        { const GAS float* DEC = WSP(float, WS_DEC) + (size_t)ch * NCH * 128;
          for (int idx = F.tid; idx < NCH * 32; idx += NT) *(LAS f32x4*)(dcs + idx * 4) = *(const GAS f32x4*)(DEC + idx * 4); }
        float s0 = 0.f, s1 = 0.f;
        const GAS bf16_t* DSu = WSP(bf16_t, WS_DS) + (size_t)ch * NCH * 16384; GAS bf16_t* STu = WSP(bf16_t, WS_ST) + (size_t)ch * NCH * 16384;
        unsigned ds[44];
#pragma unroll
        for (int j = 0; j < 44; ++j) ds[j] = *(const GAS unsigned*)(DSu + (size_t)j * 16384 + el);
        __syncthreads();
#pragma unroll 1
        for (int p0 = 0; p0 < NCH; p0 += 44) {
            const bool more = p0 + 44 < NCH;
#pragma unroll
            for (int j = 0; j < 44; ++j) { const f2 dc = *(const LAS f2*)(dcs + (p0 + j) * 128 + k); *(GAS unsigned*)(STu + (size_t)(p0 + j) * 16384 + el) = pk2(s0, s1); s0 = dc.x * s0 + lo16(ds[j]); s1 = dc.y * s1 + hi16(ds[j]);
                if (more) ds[j] = *(const GAS unsigned*)(DSu + (size_t)(p0 + 44 + j) * 16384 + el); }
        }
        __syncthreads();
    }
}
static __device__ __noinline__ void h3_unit(const Frame F, int u) {
    const int ch = u / NCH, p = u - ch * NCH; const int dir = ch >> 3, b = (ch >> 2) & 1, h = ch & 3;
    LAS float* bs = (LAS float*)F.lds;
    LAS bf16_t* ATT = (LAS bf16_t*)F.lds;
    LAS bf16_t* QF = (LAS bf16_t*)(F.lds + 32768);
    LAS bf16_t* QS = (LAS bf16_t*)(F.lds + 32768 + 17408);
    LAS bf16_t* KS = (LAS bf16_t*)(F.lds + 32768 + 2 * 17408);
    LAS bf16_t* VT = (LAS bf16_t*)(F.lds + 32768 + 2 * 17408 + 43520);
    const GAS float* LF = WSP(float, WS_LF); const GAS bf16_t* P = WSP(bf16_t, WS_P);
    f2 lfr[8]; unsigned qr[8]; bf16x8 sB[8];
    const int k2 = (F.tid & 63) * 2;
#pragma unroll
    for (int i = 0; i < 8; ++i) { const int rho = (F.tid >> 6) + 8 * i; const int row = hg_row(dir, b, p, rho);
        lfr[i] = *(const GAS f2*)(LF + (size_t)row * 1024 + dir * 512 + h * 128 + k2); qr[i] = *(const GAS unsigned*)(P + (size_t)row * PC + P_HQ + h * 128 + k2); }
    { const int r = F.lane & 31, hh = F.lane >> 5; const int nt = F.wave >> 1; const GAS bf16_t* ST = WSP(bf16_t, WS_ST) + (size_t)u * 16384;
#pragma unroll
      for (int ks = 0; ks < 8; ++ks) sB[ks] = *(const GAS bf16x8*)(ST + (32 * nt + r) * 128 + 16 * ks + 8 * hh); }
#pragma unroll
    for (int i = 0; i < 4; ++i) { const int idx = F.tid + NT * i; const int rho = idx >> 5, k4 = (idx & 31) * 4; const int row = hg_row(dir, b, p, rho);
        *(LAS f32x4*)(bs + rho * 128 + k4) = *(const GAS f32x4*)(LF + (size_t)row * 1024 + dir * 512 + h * 128 + k4); }
#pragma unroll
    for (int i = 0; i < 2; ++i) { const int idx8 = F.tid + NT * i; const int rho = idx8 >> 4, c8 = (idx8 & 15) * 8; const int row = hg_row(dir, b, p, rho);
        const u32x4 vv = *(const GAS u32x4*)(P + (size_t)row * PC + P_I + h * 128 + c8);
        LAS bf16_t* vt = VT + c8 * 72 + (rho ^ (((c8 >> 3) & 7) << 3));
        vt[0 * 72] = (bf16_t)(vv.x & 0xFFFF); vt[1 * 72] = (bf16_t)(vv.x >> 16); vt[2 * 72] = (bf16_t)(vv.y & 0xFFFF); vt[3 * 72] = (bf16_t)(vv.y >> 16);
        vt[4 * 72] = (bf16_t)(vv.z & 0xFFFF); vt[5 * 72] = (bf16_t)(vv.z >> 16); vt[6 * 72] = (bf16_t)(vv.w & 0xFFFF); vt[7 * 72] = (bf16_t)(vv.w >> 16); }
    __syncthreads();
    if (F.tid < 128) { float run = 0.f;
#pragma unroll 16
        for (int rho = 0; rho < 64; ++rho) { run += bs[rho * 128 + F.tid]; bs[rho * 128 + F.tid] = run; } }
    __syncthreads();
    { const f2 r1 = *(const LAS f2*)(bs + 15 * 128 + k2), r2 = *(const LAS f2*)(bs + 31 * 128 + k2), r3 = *(const LAS f2*)(bs + 47 * 128 + k2);
#pragma unroll
      for (int i = 0; i < 8; ++i) { const int rho = (F.tid >> 6) + 8 * i; const int i4 = rho >> 4;
        const f2 lf = lfr[i]; const float kc0 = 1.0f - __expf(lf.x), kc1 = 1.0f - __expf(lf.y);
        const float q0 = lo16(qr[i]), q1 = hi16(qr[i]);
        const f2 bb = *(const LAS f2*)(bs + rho * 128 + k2);
        const f2 ri = i4 == 0 ? mk2(0.f, 0.f) : (i4 == 1 ? r1 : (i4 == 2 ? r2 : r3));
        *(LAS unsigned*)(QF + rho * 136 + k2) = pk2(q0 * __expf(bb.x), q1 * __expf(bb.y)); *(LAS unsigned*)(QS + rho * 136 + k2) = pk2(q0 * __expf(bb.x - ri.x), q1 * __expf(bb.y - ri.y));
        if (i4 <= 0) *(LAS unsigned*)(KS + (0 + rho) * 136 + k2) = pk2(kc0 * __expf(0.f - bb.x), kc1 * __expf(0.f - bb.y));
        if (i4 <= 1) *(LAS unsigned*)(KS + (16 + rho) * 136 + k2) = pk2(kc0 * __expf(r1.x - bb.x), kc1 * __expf(r1.y - bb.y));
        if (i4 <= 2) *(LAS unsigned*)(KS + (48 + rho) * 136 + k2) = pk2(kc0 * __expf(r2.x - bb.x), kc1 * __expf(r2.y - bb.y));
        *(LAS unsigned*)(KS + (96 + rho) * 136 + k2) = pk2(kc0 * __expf(r3.x - bb.x), kc1 * __expf(r3.y - bb.y)); } }
    __syncthreads();
    for (int idx = F.tid; idx < 4096; idx += NT) { const int t = idx >> 6, s = idx & 63; if ((s >> 4) > (t >> 4)) ATT[t * 72 + s] = 0; }
    { const int c16 = F.lane & 15, g = F.lane >> 4;
      for (int bl = F.wave; bl < 10; bl += 8) {
          const int bi = bl < 1 ? 0 : (bl < 3 ? 1 : (bl < 6 ? 2 : 3)); const int bj = bl - (bi * (bi + 1)) / 2; const int kbase = bi == 0 ? 0 : (bi == 1 ? 16 : (bi == 2 ? 48 : 96));
          f32x4 acc = {0.f, 0.f, 0.f, 0.f};
#pragma unroll
          for (int ks = 0; ks < 4; ++ks) { const bf16x8 A = *(const LAS bf16x8*)(QS + (16 * bi + c16) * 136 + 32 * ks + 8 * g); const bf16x8 B = *(const LAS bf16x8*)(KS + (kbase + 16 * bj + c16) * 136 + 32 * ks + 8 * g);
              acc = MFMA16(A, B, acc); }
#pragma unroll
          for (int e = 0; e < 4; ++e) { const int t = 4 * g + e, s = c16; const float val = (bi == bj && s > t) ? 0.f : acc[e]; ATT[(16 * bi + t) * 72 + 16 * bj + s] = f2bf(val); } } }
    __syncthreads();
    { const int r = F.lane & 31, hh = F.lane >> 5; const int mt = F.wave & 1, nt = F.wave >> 1;
      const GAS bf16_t* ST = WSP(bf16_t, WS_ST) + (size_t)u * 16384;
      f32x16 acc;
#pragma unroll
      for (int e = 0; e < 16; ++e) acc[e] = 0.f;
#pragma unroll
      for (int ks = 0; ks < 8; ++ks) { const bf16x8 A = *(const LAS bf16x8*)(QF + (32 * mt + r) * 136 + 16 * ks + 8 * hh); acc = MFMA32(A, sB[ks], acc); }
#pragma unroll
      for (int ks = 0; ks < 4; ++ks) { const bf16x8 A = *(const LAS bf16x8*)(ATT + (32 * mt + r) * 72 + 16 * ks + 8 * hh); const bf16x8 B = *(const LAS bf16x8*)(VT + (32 * nt + r) * 72 + ((16 * ks + 8 * hh) ^ ((((32 * nt + r) >> 3) & 7) << 3)));
          acc = MFMA32(A, B, acc); }
      GAS float* OH = WSP(float, WS_OH) + (size_t)dir * R * 512;
#pragma unroll
      for (int e = 0; e < 16; ++e) { const int t = 32 * mt + (e & 3) + 8 * (e >> 2) + 4 * hh; const int row = hg_row(dir, b, p, t); OH[(size_t)row * 512 + h * 128 + 32 * nt + r] = acc[e]; } }
    __syncthreads();
}
static __device__ __noinline__ void h4_phase(const Frame F, int l) {
    const GAS float* OH = WSP(float, WS_OH); const GAS bf16_t* P = WSP(bf16_t, WS_P); GAS bf16_t* MIX = WSP(bf16_t, WS_MIX);
    const int nrows = (l == 0) ? R : RL; const int c = 8 * F.lane; const int step = F.G * 8;
    for (int row0 = F.bid * 8 + F.wave; row0 < nrows; row0 += 4 * step) {
        f32x4 a0[4], a1[4], b0[4], b1[4]; u32x4 gt[4];
#pragma unroll
        for (int j = 0; j < 4; ++j) { const int row = row0 + j * step; if (row < nrows) {
            a0[j] = *(const GAS f32x4*)(OH + (size_t)row * 512 + c); a1[j] = *(const GAS f32x4*)(OH + (size_t)row * 512 + c + 4);
            b0[j] = *(const GAS f32x4*)(OH + ((size_t)R + row) * 512 + c); b1[j] = *(const GAS f32x4*)(OH + ((size_t)R + row) * 512 + c + 4);
            gt[j] = *(const GAS u32x4*)(P + (size_t)row * PC + P_HG + c); } }
#pragma unroll
        for (int j = 0; j < 4; ++j) { const int row = row0 + j * step; if (row < nrows) {
            const f32x4 o0 = a0[j] + b0[j], o1 = a1[j] + b1[j];
            float ss = o0[0] * o0[0] + o0[1] * o0[1] + o0[2] * o0[2] + o0[3] * o0[3] + o1[0] * o1[0] + o1[1] * o1[1] + o1[2] * o1[2] + o1[3] * o1[3];
            ss += __shfl_xor(ss, 1); ss += __shfl_xor(ss, 2); ss += __shfl_xor(ss, 4); ss += __shfl_xor(ss, 8);
            const float rn = rsqrtf(ss * (1.0f / 128.0f) + EPS);
            u32x4 w; w.x = pk2(o0[0] * rn * lo16(gt[j].x), o0[1] * rn * hi16(gt[j].x)); w.y = pk2(o0[2] * rn * lo16(gt[j].y), o0[3] * rn * hi16(gt[j].y));
            w.z = pk2(o1[0] * rn * lo16(gt[j].z), o1[1] * rn * hi16(gt[j].z)); w.w = pk2(o1[2] * rn * lo16(gt[j].w), o1[3] * rn * hi16(gt[j].w));
            *(GAS u32x4*)(MIX + (size_t)row * 1536 + c) = w; } }
    }
}

__device__ __forceinline__ void na_norm(const u32x4 ra, const u32x4 rb, int hf, int sub, const GAS float* gain, float (&a)[8], float (&bq)[8]) {
    a[0] = lo16(ra.x); a[1] = hi16(ra.x); a[2] = lo16(ra.y); a[3] = hi16(ra.y); a[4] = lo16(ra.z); a[5] = hi16(ra.z); a[6] = lo16(ra.w); a[7] = hi16(ra.w);
    bq[0] = lo16(rb.x); bq[1] = hi16(rb.x); bq[2] = lo16(rb.y); bq[3] = hi16(rb.y); bq[4] = lo16(rb.z); bq[5] = hi16(rb.z); bq[6] = lo16(rb.w); bq[7] = hi16(rb.w);
    float ss = 0.f;
#pragma unroll
    for (int j = 0; j < 8; ++j) ss += a[j] * a[j] + bq[j] * bq[j];
    ss += __shfl_xor(ss, 1); ss += __shfl_xor(ss, 2);
    const float rn = rsqrtf(ss * (1.0f / 64.0f) + EPS);
#pragma unroll
    for (int j = 0; j < 8; ++j) { a[j] *= rn * gain[32 * hf + 8 * sub + j]; bq[j] *= rn * gain[32 * hf + 16 + 8 * sub + j]; }
}
__device__ __forceinline__ void na_store16(LAS bf16_t* dst, const float (&a)[8], const float (&bq)[8], float sc) {
    u32x4 w; w.x = pk2(a[0] * sc, a[1] * sc); w.y = pk2(a[2] * sc, a[3] * sc); w.z = pk2(a[4] * sc, a[5] * sc); w.w = pk2(a[6] * sc, a[7] * sc);
    *(LAS u32x4*)dst = w;
    w.x = pk2(bq[0] * sc, bq[1] * sc); w.y = pk2(bq[2] * sc, bq[3] * sc); w.z = pk2(bq[4] * sc, bq[5] * sc); w.w = pk2(bq[6] * sc, bq[7] * sc);
    *(LAS u32x4*)(dst + 16) = w;
}
__device__ __forceinline__ void na_rope(float (&a)[8], float (&bq)[8], const LAS f2* rt, int sub) {
#pragma unroll
    for (int j = 0; j < 8; ++j) { const f2 cs = rt[8 * sub + j]; const float x = a[j], y = bq[j]; a[j] = x * cs.x - y * cs.y; bq[j] = x * cs.y + y * cs.x; }
}
static __device__ __noinline__ void nk_unit(const Frame F, int l, int u) {
    GAS bf16_t* P = WSP(bf16_t, WS_P); const GAS f2* ROPE = WSP(f2, WS_ROPE); const GAS float* kg = F.in[I_KG] + (size_t)l * 64;
    const int row = u * 16 + (F.tid >> 5), head = (F.tid >> 2) & 7, part = F.tid & 3, hf = part >> 1, sub = part & 1;
    GAS bf16_t* kp = P + (size_t)row * PC + P_NK + head * 64 + 32 * hf + 8 * sub;
    const u32x4 ra = *(const GAS u32x4*)kp, rb = *(const GAS u32x4*)(kp + 16);
    float a[8], bq[8];
    na_norm(ra, rb, hf, sub, kg, a, bq);
    if (row < RL) { const int rr = (row >> 6) & 127, cc = row & 63;
        const GAS f2* rt = ROPE + (hf == 0 ? rr * 16 : 128 * 16 + cc * 16) + 8 * sub;
#pragma unroll
        for (int j = 0; j < 8; ++j) { const f2 cs = rt[j]; const float x = a[j], y = bq[j]; a[j] = x * cs.x - y * cs.y; bq[j] = x * cs.y + y * cs.x; } }
    u32x4 w; w.x = pk2(a[0], a[1]); w.y = pk2(a[2], a[3]); w.z = pk2(a[4], a[5]); w.w = pk2(a[6], a[7]);
    *(GAS u32x4*)kp = w;
    w.x = pk2(bq[0], bq[1]); w.y = pk2(bq[2], bq[3]); w.z = pk2(bq[4], bq[5]); w.w = pk2(bq[6], bq[7]);
    *(GAS u32x4*)(kp + 16) = w;
}
static __device__ __noinline__ void na_unit(const Frame F, int l, int u, bool ctxq) {
    const int hp = u & 3, br = u >> 2; const int b = ctxq ? (br >> 2) : (br >> 7); const int r = ctxq ? (br & 3) : (br & 127);
    const int hs = F.wave >> 2, head = hp * 2 + hs, wq = F.wave & 3, tl = F.tid & 255;
    LAS unsigned char* hb = F.lds + hs * 54272;
    LAS bf16_t* QR = (LAS bf16_t*)hb; LAS bf16_t* QP = (LAS bf16_t*)(hb + 9216); LAS bf16_t* KT = (LAS bf16_t*)(hb + 18432); LAS bf16_t* VT = (LAS bf16_t*)(hb + 36864);
    LAS float* rpb = (LAS float*)(F.lds + 108544) + hs * 465;
    LAS f2* crope = (LAS f2*)(F.lds + 112640);
    LAS f2* rrope = (LAS f2*)(F.lds + 120832);
    const GAS bf16_t* P = WSP(bf16_t, WS_P); const GAS f2* ROPE = WSP(f2, WS_ROPE);
    const GAS float* qg = F.in[I_QG] + (size_t)l * 64; const GAS float* kg = F.in[I_KG] + (size_t)l * 64;
    const int rs = min(max(r - 4, 0), 120);
    const size_t qrow0 = ctxq ? (size_t)RL + (size_t)b * CTX + (size_t)r * 64 : (size_t)b * SEQ + (size_t)r * 64;
    for (int idx = tl; idx < 465; idx += 256) rpb[idx] = F.in[I_RPB][((size_t)l * 8 + head) * 465 + idx];
    for (int idx = F.tid; idx < 1024; idx += NT) crope[idx] = ROPE[128 * 16 + idx];
    if (F.tid < 144) { const int rr = F.tid >> 4; rrope[F.tid] = ROPE[(rr < 8 ? rs + rr : r) * 16 + (F.tid & 15)]; }
    __syncthreads();
    { const int qi = tl >> 2, part = tl & 3, hf = part >> 1, sub = part & 1;
      float a[8], bq[8];
      { const GAS bf16_t* qp = P + (qrow0 + qi) * PC + P_NQ + head * 64;
        na_norm(*(const GAS u32x4*)(qp + 32 * hf + 8 * sub), *(const GAS u32x4*)(qp + 32 * hf + 16 + 8 * sub), hf, sub, qg, a, bq); }
      na_store16(QP + qi * 72 + 32 * hf + 8 * sub, a, bq, 0.125f);
      if (!ctxq) { na_rope(a, bq, hf == 0 ? rrope + 8 * 16 : crope + qi * 16, sub); na_store16(QR + qi * 72 + 32 * hf + 8 * sub, a, bq, 0.125f); } }
    __syncthreads();
    const int c16 = F.lane & 15, g = F.lane >> 4;
    f32x4 O[4];
#pragma unroll
    for (int dt = 0; dt < 4; ++dt) O[dt] = (f32x4){0.f, 0.f, 0.f, 0.f};
    float m_run = -1e30f, l_run = 0.f;
    const int qc = 16 * wq + c16;
    const int cs = min(max(qc - 8, 0), 48);
    u32x4 kr[2][2];
#define NA_LOAD(KT) do { _Pragma("unroll") for (int it = 0; it < 2; ++it) { const int item = tl + 256 * it; const int kap = item >> 2, part = item & 3, hf = part >> 1, sub = part & 1; \
        const bool w_ = (KT) < 4; const int kr_ = rs + 2 * (KT) + (kap >> 6), kc_ = kap & 63; \
        const size_t row = w_ ? (size_t)b * SEQ + (size_t)kr_ * 64 + kc_ : (size_t)RL + (size_t)b * CTX + (size_t)((KT) - 4) * 128 + kap; \
        const GAS bf16_t* kp = P + row * PC + P_NK + head * 64; const GAS bf16_t* vp = P + row * PC + P_NV + head * 64; \
        if (it == 0) { kr[it][0] = *(const GAS u32x4*)(kp + 32 * hf + 8 * sub); kr[it][1] = *(const GAS u32x4*)(kp + 32 * hf + 16 + 8 * sub); } (void)vp; } } while (0)
    for (int kt = ctxq ? 4 : 0; kt < 6; ++kt) {
        const bool win = kt < 4;
        u32x4 vr[2][2];
#pragma unroll
        for (int it = 0; it < 2; ++it) { const int item = tl + 256 * it; const int kap = item >> 2, part = item & 3, hf = part >> 1, sub = part & 1; const int kr_ = rs + 2 * kt + (kap >> 6), kc_ = kap & 63;
            const size_t row = win ? (size_t)b * SEQ + (size_t)kr_ * 64 + kc_ : (size_t)RL + (size_t)b * CTX + (size_t)(kt - 4) * 128 + kap;
            const GAS bf16_t* vp = P + row * PC + P_NV + head * 64;
            vr[it][0] = *(const GAS u32x4*)(vp + 32 * hf + 8 * sub); vr[it][1] = *(const GAS u32x4*)(vp + 32 * hf + 16 + 8 * sub);
            kr[it][0] = *(const GAS u32x4*)(P + row * PC + P_NK + head * 64 + 32 * hf + 8 * sub); kr[it][1] = *(const GAS u32x4*)(P + row * PC + P_NK + head * 64 + 32 * hf + 16 + 8 * sub); }
#pragma unroll
        for (int it = 0; it < 2; ++it) { const int item = tl + 256 * it; const int kap = item >> 2, part = item & 3, hf = part >> 1, sub = part & 1;
            const int kr_ = rs + 2 * kt + (kap >> 6), kc_ = kap & 63;
            *(LAS u32x4*)(KT + kap * 72 + 32 * hf + 8 * sub) = kr[it][0]; *(LAS u32x4*)(KT + kap * 72 + 32 * hf + 8 * sub + 16) = kr[it][1];
            const u32x4 va = vr[it][0], vb = vr[it][1];
            LAS bf16_t* vt = VT + (32 * hf + 8 * sub) * 132 + (kap ^ (hf << 4));
            vt[0 * 132] = (bf16_t)(va.x & 0xFFFF); vt[1 * 132] = (bf16_t)(va.x >> 16); vt[2 * 132] = (bf16_t)(va.y & 0xFFFF); vt[3 * 132] = (bf16_t)(va.y >> 16);
            vt[4 * 132] = (bf16_t)(va.z & 0xFFFF); vt[5 * 132] = (bf16_t)(va.z >> 16); vt[6 * 132] = (bf16_t)(va.w & 0xFFFF); vt[7 * 132] = (bf16_t)(va.w >> 16);
            vt += 16 * 132;
            vt[0 * 132] = (bf16_t)(vb.x & 0xFFFF); vt[1 * 132] = (bf16_t)(vb.x >> 16); vt[2 * 132] = (bf16_t)(vb.y & 0xFFFF); vt[3 * 132] = (bf16_t)(vb.y >> 16);
            vt[4 * 132] = (bf16_t)(vb.z & 0xFFFF); vt[5 * 132] = (bf16_t)(vb.z >> 16); vt[6 * 132] = (bf16_t)(vb.w & 0xFFFF); vt[7 * 132] = (bf16_t)(vb.w >> 16); }
        __syncthreads();
        f32x4 s[8];
        float mt_max = -1e30f;
        const unsigned skS = (unsigned)__builtin_amdgcn_readfirstlane(win ? (wq == 0 ? 0xCC : (wq == 3 ? 0x33 : (wq == 1 ? 0x88 : 0x11))) : 0);
        const unsigned skP = (unsigned)__builtin_amdgcn_readfirstlane(win ? (wq == 0 ? 0xA : (wq == 3 ? 0x5 : 0)) : 0);
        const LAS bf16_t* QX = win ? QR : QP;
        const bf16x8 q0 = *(const LAS bf16x8*)(QX + (16 * wq + c16) * 72 + 8 * g), q1 = *(const LAS bf16x8*)(QX + (16 * wq + c16) * 72 + 32 + 8 * g);
#pragma unroll
        for (int mt = 0; mt < 8; ++mt) {
            f32x4 acc = {0.f, 0.f, 0.f, 0.f};
            if ((skS >> mt) & 1u) { s[mt] = (f32x4){-1e30f, -1e30f, -1e30f, -1e30f}; continue; }
            const bf16x8 A0 = *(const LAS bf16x8*)(KT + (16 * mt + c16) * 72 + 8 * g), A1 = *(const LAS bf16x8*)(KT + (16 * mt + c16) * 72 + 32 + 8 * g);
            acc = MFMA16(A0, q0, acc); acc = MFMA16(A1, q1, acc);
            if (win) { const int kr = rs + 2 * kt + (mt >> 2);
#pragma unroll
                for (int e = 0; e < 4; ++e) { const int kc = 16 * (mt & 3) + 4 * g + e; const bool valid = (kc >= cs) && (kc < cs + 16);
                    const int bi = (kr - r + 7) * 31 + (kc - qc + 15);
                    acc[e] = valid ? acc[e] + rpb[valid ? bi : 0] : -1e30f; } }
            s[mt] = acc;
            mt_max = fmaxf(mt_max, fmaxf(fmaxf(acc[0], acc[1]), fmaxf(acc[2], acc[3])));
        }
        mt_max = fmaxf(mt_max, __shfl_xor(mt_max, 16)); mt_max = fmaxf(mt_max, __shfl_xor(mt_max, 32));
        const float m_new = fmaxf(m_run, mt_max); const float alpha = __expf(m_run - m_new); m_run = m_new;
        float psum = 0.f;
#pragma unroll
        for (int mt = 0; mt < 8; ++mt)
#pragma unroll
            for (int e = 0; e < 4; ++e) { const float pv = __expf(s[mt][e] - m_new); s[mt][e] = pv; psum += pv; }
        l_run = l_run * alpha + psum;
#pragma unroll
        for (int dt = 0; dt < 4; ++dt) O[dt] *= alpha;
#pragma unroll
        for (int k2 = 0; k2 < 4; ++k2) {
            if ((skP >> k2) & 1u) continue;
            u32x4 pw; pw.x = pk2(s[2 * k2][0], s[2 * k2][1]); pw.y = pk2(s[2 * k2][2], s[2 * k2][3]); pw.z = pk2(s[2 * k2 + 1][0], s[2 * k2 + 1][1]); pw.w = pk2(s[2 * k2 + 1][2], s[2 * k2 + 1][3]);
            bf16x8 pf; __builtin_memcpy(&pf, &pw, 16);
#pragma unroll
            for (int dt = 0; dt < 4; ++dt) {
                const u32x2 lo = *(const LAS u32x2*)(VT + (16 * dt + c16) * 132 + 32 * k2 + 4 * g + (dt >= 2 ? 16 : 0)), hi = *(const LAS u32x2*)(VT + (16 * dt + c16) * 132 + 32 * k2 + 4 * g + (dt >= 2 ? 0 : 16));
                u32x4 aw; aw.x = lo.x; aw.y = lo.y; aw.z = hi.x; aw.w = hi.y; bf16x8 af; __builtin_memcpy(&af, &aw, 16);
                O[dt] = MFMA16(af, pf, O[dt]); } }
        __syncthreads();
    }
    l_run += __shfl_xor(l_run, 16); l_run += __shfl_xor(l_run, 32);
    const float inv = 1.0f / l_run;
    GAS bf16_t* MIX = WSP(bf16_t, WS_MIX) + (qrow0 + qc) * 1536 + 512 + head * 64;
#pragma unroll
    for (int dt = 0; dt < 4; ++dt) { u32x2 w; w.x = pk2(O[dt][0] * inv, O[dt][1] * inv); w.y = pk2(O[dt][2] * inv, O[dt][3] * inv); *(GAS u32x2*)(MIX + 16 * dt + 4 * g) = w; }
}


static __device__ __noinline__ void gs_phase(const Frame F, int l) {
    const GAS bf16_t* T = WSP(bf16_t, WS_T); const GAS bf16_t* P = WSP(bf16_t, WS_P); GAS bf16_t* M = WSP(bf16_t, WS_HX);
    const int nrows = (l == 0) ? R : RL; const int step = F.G * 8;
    for (int row0 = F.bid * 8 + F.wave; row0 < nrows; row0 += 2 * step) {
        u32x4 t[2][3][2], g[2][3][2];
#pragma unroll
        for (int j = 0; j < 2; ++j) { const int row = row0 + j * step; if (row < nrows) {
            const GAS bf16_t* tp = T + (size_t)row * 3072 + 8 * F.lane; const GAS bf16_t* gp = P + (size_t)row * PC + P_GATE + 8 * F.lane;
#pragma unroll
            for (int br = 0; br < 3; ++br)
#pragma unroll
                for (int i = 0; i < 2; ++i) { t[j][br][i] = *(const GAS u32x4*)(tp + 1024 * br + 512 * i); g[j][br][i] = *(const GAS u32x4*)(gp + 1024 * br + 512 * i); } } }
#pragma unroll
        for (int j = 0; j < 2; ++j) { const int row = row0 + j * step; if (row < nrows) {
#pragma unroll
            for (int i = 0; i < 2; ++i) { u32x4 w;
#define GS_MIX(F_) (lo16(t[j][0][i].F_) * lo16(g[j][0][i].F_) + lo16(t[j][1][i].F_) * lo16(g[j][1][i].F_) + lo16(t[j][2][i].F_) * lo16(g[j][2][i].F_))
#define GS_MIXH(F_) (hi16(t[j][0][i].F_) * hi16(g[j][0][i].F_) + hi16(t[j][1][i].F_) * hi16(g[j][1][i].F_) + hi16(t[j][2][i].F_) * hi16(g[j][2][i].F_))
                w.x = pk2(GS_MIX(x), GS_MIXH(x)); w.y = pk2(GS_MIX(y), GS_MIXH(y)); w.z = pk2(GS_MIX(z), GS_MIXH(z)); w.w = pk2(GS_MIX(w), GS_MIXH(w));
#undef GS_MIX
#undef GS_MIXH
                *(GAS u32x4*)(M + (size_t)row * 1024 + 8 * F.lane + 512 * i) = w; } } }
    }
}

struct EpiNull {
    static constexpr bool PERM = true;
    __device__ __forceinline__ void operator()(const f32x4 (&acc)[2][2][4][2], const pg8::Unit& u, int wr, int wc, int fr, int fq) const {
#pragma unroll
        for (int ai = 0; ai < 2; ++ai)
#pragma unroll
            for (int bj = 0; bj < 2; ++bj)
#pragma unroll
                for (int m = 0; m < 4; ++m)
#pragma unroll
                    for (int n = 0; n < 2; ++n) asm volatile("" :: "v"(acc[ai][bj][m][n]));
    }
};
template <int MODE>
static __device__ __forceinline__ void gemm_run_t(Frame F, int l) {
    asm volatile("" : "+s"(F.ws), "+s"(l));
    const bool ctx_on = (l == 0);
    if constexpr (MODE == 0) {
        pg8::Gemm g{1024, 1024, 1024};
        SchedIn S{(const char*)WSP(bf16_t, WS_HX), (const char*)(WSP(bf16_t, WS_WIN) + (size_t)l * INC * 1024), F.G, F.bid, ctx_on ? 34 : 10};
        EpiIn E{WSP(float, WS_LF), WSP(bf16_t, WS_P), WSP(f2, WS_LBC) + (size_t)l * 1024};
        pg8::gemm_phase(F.lds, g, S, E, true);
    } else if constexpr (MODE == 1) {
        pg8::Gemm g{1536, 512, 512};
        SchedBr S{(const char*)WSP(bf16_t, WS_MIX), (const char*)(WSP(bf16_t, WS_WBR) + (size_t)l * 3 * 1024 * 512), F.G, F.bid, ctx_on ? 66 : 64};
        EpiBr E{WSP(bf16_t, WS_T), WSP(bf16_t, WS_P)};
        pg8::gemm_phase(F.lds, g, S, E, true);
    } else if constexpr (MODE == 2) {
        pg8::Gemm g{1024, 3072, 1024};
        SchedOut S{(const char*)WSP(bf16_t, WS_HX), (const char*)(WSP(bf16_t, WS_WO3) + (size_t)l * 1024 * 3072), F.G, F.bid, ctx_on ? 66 : 64};
        EpiOut E{WSP(bf16_t, WS_T)};
        pg8::gemm_phase(F.lds, g, S, E, true);
    } else if constexpr (MODE == 6) {
        pg8::Gemm g{1024, 1024, 1024};
        SchedGU S{(const char*)WSP(bf16_t, WS_XG), (const char*)WSP(bf16_t, WS_WGU), F.G, F.bid, ctx_on ? 9 : 8};
        EpiNull E{};
        pg8::gemm_phase(F.lds, g, S, E, true);
    } else if constexpr (MODE == 7) {
        pg8::Gemm g{FF, FF, FF};
        SchedDn S{(const char*)WSP(bf16_t, WS_H), (const char*)WSP(bf16_t, WS_WDN), F.G, F.bid, ctx_on ? 9 : 8};
        EpiNull E{};
        pg8::gemm_phase(F.lds, g, S, E, true);
    } else if constexpr (MODE == 3) {
        pg8::Gemm g{1024, 1024, 1024};
        SchedGU S{(const char*)WSP(bf16_t, WS_XG), (const char*)WSP(bf16_t, WS_WGU), F.G, F.bid, ctx_on ? 9 : 8};
        EpiGU E{WSP(bf16_t, WS_H)};
        pg8::gemm_phase(F.lds, g, S, E, true);
    } else {
        pg8::Gemm g{FF, FF, FF};
        SchedDn S{(const char*)WSP(bf16_t, WS_H), (const char*)WSP(bf16_t, WS_WDN), F.G, F.bid, ctx_on ? 9 : 8};
        EpiDn E{WSP(bf16_t, WS_Y)};
        pg8::gemm_phase(F.lds, g, S, E, true);
    }
}

constexpr int NPH_LAYER = 15, NPHASES = 1 + 2 * NPH_LAYER;
__global__ void __launch_bounds__(NT, 2) fwd_kernel(KArgs args) {
    extern __shared__ __attribute__((aligned(16))) unsigned char smem[];
    Frame F; F.in = (const GAS float* LAS*)((LAS unsigned char*)smem + LDS_MISC + 64); F.out = (GAS float*)args.out; F.ws = (GAS unsigned char*)args.ws; F.lds = (LAS unsigned char*)smem; F.tid = threadIdx.x; F.lane = F.tid & 63; F.wave = __builtin_amdgcn_readfirstlane(F.tid >> 6);
    F.G = gridDim.x; F.bid = blockIdx.x;
    volatile LAS unsigned* misc = (volatile LAS unsigned*)(F.lds + LDS_MISC);
    if (F.tid < 4) misc[F.tid] = 0u;
    if (F.tid == 0) {
#pragma unroll
        for (int i = 0; i < 31; ++i) F.in[i] = (const GAS float*)args.in[i];
    }
    __syncthreads();
    const int lo = args.ph_lo, hi = args.ph_hi;
    XcdBarrier bar; bar.bar = (unsigned*)(args.ws + WS_CTL); bar.x = 0; bar.st = misc;
    if (hi - lo > 1) bar = xcd_barrier_post((unsigned*)(args.ws + WS_CTL), misc);
#ifndef PHASE_MASK
#define PHASE_MASK 0xFFFF
#endif
#define PH_ON(j) (((PHASE_MASK) >> (j)) & 1)
#ifndef DUP_MASK
#define DUP_MASK 0
#endif
#define REPS(j) ((((DUP_MASK) >> (j)) & 1) ? 2 : 1)

#define IN(k) (lo <= (k) && (k) < hi)
#define SEAM(k) do { if ((k) + 1 < hi) xcd_barrier(bar); } while (0)
    const int G = F.G, bid = F.bid;

    if (PH_ON(15) && IN(0)) { for (int rep = 0; rep < REPS(15); ++rep) prologue_phase(F); SEAM(0); }

    for (int l = 0; l < 2; ++l) {
        const int pb = 1 + NPH_LAYER * l;
        const bool ctx_on = (l == 0);
        const int pre1 = (G & 7) == 0 ? 2112 : 0;
        const int e2u = ctx_on ? 64 : 32, e2idle = G > e2u ? G - e2u : 0, bgc2 = 8448 - e2idle * 5;
        const bool g256 = G == 256;
        const int tA2_first = ctx_on ? 196 : 148, tA2_n = g256 ? (256 - tA2_first) * 4 : 0, tG1_n = (g256 && ctx_on) ? 232 * 2 : 0, tG2_n = (g256 && ctx_on) ? 248 * 4 : 0;
        const int tA2_lo = l == 0 ? 0 : pre1, tG1_lo = tA2_lo + tA2_n, tG2_lo = tG1_lo + tG1_n;
        const int bgc0 = tG2_lo + tG2_n, bgc1 = l == 0 ? (g256 ? 4200 : 2816) : 4500;
#define TAILC(first_idle, lo_, cnt_) do { if ((cnt_) > 0 && bid >= (first_idle)) { int b2 = bid; asm volatile("" : "+s"(b2)); conv_stream(F, 1, l, (lo_) + b2 - (first_idle), (lo_) + (cnt_), 256 - (first_idle)); } } while (0)
        if (PH_ON(0) && IN(pb + 0) && !(l == 1 && g256)) { for (int rep = 0; rep < REPS(0); ++rep) {
            for (int u = bid; u < 512; u += G) f2_unit(F, l, u);
            SREP(2) if (l == 0) norm1_rows(F, l);
            } SEAM(pb + 0);
        }
        if (PH_ON(1) && IN(pb + 1)) { for (int rep = 0; rep < REPS(1); ++rep) {
            gemm_run_t<0>(F, l);
            TAILC(tA2_first, tA2_lo, tA2_n);
            } SEAM(pb + 1);
        }
        if (PH_ON(2) && IN(pb + 2)) { for (int rep = 0; rep < REPS(2); ++rep) {
#ifndef M1_MASK
#define M1_MASK 31
#endif
#define BGC(slot, pos) do { if ((bid & 3) == (pos)) conv_stream(F, 1, l, ((slot) == 0 ? bgc0 : bgc1) + bid, (slot) == 0 ? bgc1 : bgc2, G); } while (0)
            BGC(0, 0);
            SREP(3) if (M1_MASK & 1) { for (int u = bid; u < R / 16; u += G) nk_unit(F, l, u); }
            BGC(0, 1);
            SREP(4) if (M1_MASK & 4) for (int u = (bid + 160) % G; u < NCHAIN * NCH; u += G) h1_unit(F, u);
            BGC(0, 2);
            SREP(5) if (M1_MASK & 8) for (int u = bid; u < 2048; u += G) y1_unit(F, l, u);
            BGC(0, 3);
            SREP(6) if ((M1_MASK & 16) && ctx_on) for (int u = (bid + 64) % G; u < 128; u += G) yctx_unit(F, u);
            } SEAM(pb + 2);
        }
        if (PH_ON(3) && IN(pb + 3)) { for (int rep = 0; rep < REPS(3); ++rep) {
            BGC(1, 0);
            { const int nna = 1024 + (ctx_on ? 32 : 0); for (int u = bid; u < nna; u += G) na_unit(F, l, u < 1024 ? u : u - 1024, u >= 1024); }
            SREP(7) for (int u = bid; u < 512; u += G) { y2_unit(F, u); if (u < G) BGC(1, 1); }
            BGC(1, 2);
            SREP(8) h2_phase(F);
            BGC(1, 3);
            } SEAM(pb + 3);
        }
        if (PH_ON(4) && IN(pb + 4)) { for (int rep = 0; rep < REPS(4); ++rep) {
            SREP(9) { if (ctx_on) { for (int u = bid; u < NCHAIN * NCH; u += G) h3_unit(F, u); }
            else { for (int v = bid; v < NCHAIN * 128; v += G) h3_unit(F, (v >> 7) * NCH + 4 + (v & 127)); } }
            SREP(10) for (int u = (bid + 64) % G; u < 2048; u += G) y3_unit(F, l, u);
            } SEAM(pb + 4);
        }
        if (PH_ON(5) && IN(pb + 5)) { for (int rep = 0; rep < REPS(5); ++rep) { h4_phase(F, l); } SEAM(pb + 5); }
        if (PH_ON(6) && IN(pb + 6)) { for (int rep = 0; rep < REPS(6); ++rep) {
            gemm_run_t<1>(F, l);
            TAILC(24, tG1_lo, tG1_n);
            } SEAM(pb + 6);
        }
        if (PH_ON(7) && IN(pb + 7)) { for (int rep = 0; rep < REPS(7); ++rep) { gs_phase(F, l); } SEAM(pb + 7); }
        if (PH_ON(8) && IN(pb + 8)) { for (int rep = 0; rep < REPS(8); ++rep) {
            gemm_run_t<2>(F, l);
            TAILC(8, tG2_lo, tG2_n);
            if (g256 && ctx_on && bid >= 8 && bid < 40) { int b2 = bid; asm volatile("" : "+s"(b2)); f2_unit(F, 1, 480 + b2 - 8); }
            } SEAM(pb + 8);
        }
        if (PH_ON(9) && IN(pb + 9)) { for (int rep = 0; rep < REPS(9); ++rep) { e1_phase(F, l); } SEAM(pb + 9); }
        if (PH_ON(10) && IN(pb + 10)) { for (int rep = 0; rep < REPS(10); ++rep) { for (int u = bid; u < e2u; u += G) e2_unit(F, u & 31, u >= 32);
            if (bid >= e2u) { int b2 = bid; asm volatile("" : "+s"(b2)); conv_stream(F, 1, l, bgc2 + b2 - e2u, 8448, e2idle); } } SEAM(pb + 10); }
        if (PH_ON(11) && IN(pb + 11)) { for (int rep = 0; rep < REPS(11); ++rep) { e3_phase(F, l); } SEAM(pb + 11); }
        if (PH_ON(12) && IN(pb + 12)) { for (int rep = 0; rep < REPS(12); ++rep) {
            gemm_run_t<3>(F, l);
            if (l == 0 && g256 && (bid & 7) >= 3) { int b2 = bid; asm volatile("" : "+s"(b2)); __syncthreads(); for (int u = (b2 >> 3) * 5 + (b2 & 7) - 3; u < 480; u += 160) f2_unit(F, 1, u); }
#ifdef PROBE_GEMM_E
            gemm_run_t<6>(F, l);
#endif
            } SEAM(pb + 12);
        }
        if (PH_ON(13) && IN(pb + 13)) { for (int rep = 0; rep < REPS(13); ++rep) {
            gemm_run_t<4>(F, l);
#ifdef PROBE_GEMM_E
            gemm_run_t<7>(F, l);
#endif
            if (l == 0 && pre1 && (bid & 7) >= 2) { int b2 = bid; asm volatile("" : "+s"(b2)); conv_stream(F, 1, 1, (b2 >> 3) * 6 + (b2 & 7) - 2, pre1, (G >> 3) * 6); }
            } SEAM(pb + 13);
        }
        if (PH_ON(14) && IN(pb + 14)) { for (int rep = 0; rep < REPS(14); ++rep) { e6_phase(F, l); } SEAM(pb + 14); }
    }
#undef IN
#undef SEAM
}

extern "C" void kernel_launch(void* const* d_in, const int* in_sizes, int n_in, void* d_out, int out_size, void* d_ws, size_t ws_size, hipStream_t stream) {
    static int grid = 0;
    if (grid == 0) {
        if (n_in != 31 || out_size != RL * D || ws_size < WS_END) { fprintf(stderr, "kernel_launch: unexpected shapes (n_in %d out %d ws %zu need %zu)\n", n_in, out_size, ws_size, (size_t)WS_END); grid = -1; return; }
        int dev = 0, cus = 0, per_cu = 0;
        if (hipGetDevice(&dev) != hipSuccess || hipDeviceGetAttribute(&cus, hipDeviceAttributeMultiprocessorCount, dev) != hipSuccess) { grid = -1; return; }
        if (hipFuncSetAttribute((const void*)fwd_kernel, hipFuncAttributeMaxDynamicSharedMemorySize, LDS_BYTES) != hipSuccess) { fprintf(stderr, "kernel_launch: hipFuncSetAttribute failed\n"); grid = -1; return; }
        if (hipOccupancyMaxActiveBlocksPerMultiprocessor(&per_cu, (const void*)fwd_kernel, NT, LDS_BYTES) != hipSuccess || per_cu < 1) fprintf(stderr, "kernel_launch: occupancy query says %d\n", per_cu);
        (void)hipGetLastError();
        grid = cus;
    }
    if (grid < 0) return;
    (void)hipMemsetAsync((char*)d_ws + WS_CTL, 0, 16384, stream);
    KArgs a{};
    for (int i = 0; i < 31; ++i) a.in[i] = (const float*)d_in[i];
    a.out = (float*)d_out; a.ws = (unsigned char*)d_ws;
#if N_LAUNCH_MODE == 1
    a.ph_lo = 0; a.ph_hi = NPHASES;
    hipLaunchKernelGGL(fwd_kernel, dim3(grid), dim3(NT), LDS_BYTES, stream, a);
#else
    for (int ph = 0; ph < NPHASES; ++ph) { a.ph_lo = ph; a.ph_hi = ph + 1; hipLaunchKernelGGL(fwd_kernel, dim3(grid), dim3(NT), LDS_BYTES, stream, a); }
#endif
}
```

```cpp
#include <hip/hip_runtime.h>
#include <stdint.h>
#include <stdio.h>

#ifndef N_LAUNCH_MODE
#define N_LAUNCH_MODE 1
#endif

#ifndef SUB_DUP
#define SUB_DUP 0
#endif
#define SREP(k) for (int srep = 0; srep < ((((SUB_DUP) >> (k)) & 1) ? 2 : 1); ++srep)
#define LAS __attribute__((address_space(3)))
#define GAS __attribute__((address_space(1)))
#define CAS __attribute__((address_space(4)))
typedef unsigned short bf16_t;
typedef short bf16x8 __attribute__((ext_vector_type(8)));
typedef short bf16x4 __attribute__((ext_vector_type(4)));
typedef float f32x4 __attribute__((ext_vector_type(4)));
typedef float f32x16 __attribute__((ext_vector_type(16)));
typedef unsigned u32x4 __attribute__((ext_vector_type(4)));
typedef unsigned u32x2 __attribute__((ext_vector_type(2)));
typedef float f2 __attribute__((ext_vector_type(2)));
__device__ __forceinline__ f2 mk2(float x, float y) { f2 r; r.x = x; r.y = y; return r; }

constexpr int D = 1024, NB = 2, SEQ = 8192, CTX = 256, GW = 64, GROWS = 128;
constexpr int RL = NB * SEQ;
constexpr int RC = NB * CTX;
constexpr int R = RL + RC;
constexpr int INC = 8704;
constexpr int PC = 7680;
constexpr int P_I = 0, P_NK = 512, P_NV = 1024, P_HQ = 1536, P_NQ = 2048, P_HG = 2560, P_HY = 3072, P_GATE = 4608;
constexpr int NE = 16, FF = 2816, CAP = 1024, CAPC = 32;
constexpr int XROWS = 2304;
constexpr int NCH = 132;
constexpr int NCHAIN = 16;
constexpr int NT = 512;
constexpr float EPS = 1e-6f;

constexpr size_t WS_CTL  = 0;
constexpr size_t WS_MOD  = 16384;
constexpr size_t WS_LBC  = WS_MOD + 147456;
constexpr size_t WS_TW   = WS_LBC + 16384;
constexpr size_t WS_ROPE = WS_TW + 131072;
constexpr size_t WS_PS   = WS_ROPE + 24576;
constexpr size_t WS_PSC  = WS_PS + 262144;
constexpr size_t WS_HTC  = WS_PSC + 4096;
constexpr size_t WS_HT   = WS_HTC + 1048576;
constexpr size_t WS_KF   = WS_HT + 67108864;
constexpr size_t WS_WIN  = WS_KF + 67108864;
constexpr size_t WS_WBR  = WS_WIN + 35651584;
constexpr size_t WS_WO3  = WS_WBR + 6291456;
constexpr size_t WS_WGU  = WS_WO3 + 12582912;
constexpr size_t WS_WDN  = WS_WGU + 184549376;
constexpr size_t WS_HX   = WS_WDN + 92274688;
constexpr size_t WS_XM   = WS_HX + 34603008;
constexpr size_t WS_AFF  = WS_XM + 69206016;
constexpr size_t WS_SLOT = WS_AFF + 1048576 + 32768;
constexpr size_t WS_IDX  = WS_SLOT + 1081344;
constexpr size_t WS_T    = WS_IDX + 131072 + 4096;
constexpr size_t WS_MIX  = WS_T + 103809024;
constexpr size_t WS_REG  = WS_MIX + 51904512;
constexpr size_t WS_LF   = WS_REG;
constexpr size_t WS_P    = WS_LF + 69206016;
constexpr size_t WS_DS   = WS_P + 259522560;
constexpr size_t WS_DEC  = WS_DS + 138412032;
constexpr size_t WS_ST   = WS_DEC + 1081344;
constexpr size_t WS_OH   = WS_ST + 69206016;
constexpr size_t WS_UT   = WS_OH + 69206016;
constexpr size_t WS_YT   = WS_UT + 33554432;
constexpr size_t WS_END1 = WS_YT + 33554432;
constexpr size_t WS_XG   = WS_REG;
constexpr size_t WS_H    = WS_XG + 75497472;
constexpr size_t WS_Y    = WS_H + 207618048;
constexpr size_t WS_END2 = WS_Y + 75497472;
constexpr size_t WS_END  = WS_END1 > WS_END2 ? WS_END1 : WS_END2;
static_assert(WS_END <= 1476395008ull, "workspace map exceeds the guaranteed d_ws size");
static_assert((WS_REG & 255) == 0 && (WS_P & 255) == 0 && (WS_DS & 255) == 0 && (WS_ST & 255) == 0, "alignment");

constexpr int LDS_STAGE = 131072;
constexpr int LDS_MISC = 143360;
constexpr int LDS_BYTES = LDS_MISC + 1024;

__device__ __forceinline__ float bf2f(bf16_t b) { return __uint_as_float(((unsigned)b) << 16); }
__device__ __forceinline__ bf16_t f2bf(float f) { unsigned u = __float_as_uint(f); u += 0x7FFFu + ((u >> 16) & 1u); return (bf16_t)(u >> 16); }
typedef float f32x2n __attribute__((ext_vector_type(2)));
typedef __bf16 bf16x2n __attribute__((ext_vector_type(2)));
__device__ __forceinline__ unsigned pk2(float lo, float hi) { f32x2n v; v.x = lo; v.y = hi; const bf16x2n b = __builtin_convertvector(v, bf16x2n); unsigned r; __builtin_memcpy(&r, &b, 4); return r; }
__device__ __forceinline__ float lo16(unsigned w) { return __uint_as_float(w << 16); }
__device__ __forceinline__ float hi16(unsigned w) { return __uint_as_float(w & 0xFFFF0000u); }
__device__ __forceinline__ float sigmoidf_(float x) { return __builtin_amdgcn_rcpf(1.f + __expf(-x)); }
__device__ __forceinline__ float siluf_(float x) { return x * __builtin_amdgcn_rcpf(1.f + __expf(-x)); }
__device__ __forceinline__ float logsigf_(float z) { return fminf(z, 0.f) - log1pf(__expf(-fabsf(z))); }
__device__ __forceinline__ float wave_sum(float v) {
#pragma unroll
    for (int o = 32; o >= 1; o >>= 1) v += __shfl_xor(v, o);
    return v;
}

#define XB_TMO      128
#define XB_XCNT(j)  (256  + 64 * (j))
#define XB_XSUB(j)  (1280 + 64 * (j))
#define XB_XGEN(j)  (2304 + 64 * (j))
#define XB_TOP      3328
#define XB_TOPGEN   3392
#define XCD_BAR_WORDS 3456
#define XB_SPIN_CAP (1u << 22)

__device__ __forceinline__ unsigned xb_ld(unsigned* p)              { return __hip_atomic_load(p, __ATOMIC_RELAXED, __HIP_MEMORY_SCOPE_AGENT); }
__device__ __forceinline__ unsigned xb_add(unsigned* p, unsigned v) { return __hip_atomic_fetch_add(p, v, __ATOMIC_RELAXED, __HIP_MEMORY_SCOPE_AGENT); }
__device__ __forceinline__ unsigned xb_xcc_id() { return (unsigned)__builtin_amdgcn_s_getreg((3 << 11) | 20) & 0xFu; }
#define XB_SPIN(cond, bar) do { unsigned _sp = 0; while (cond) { __builtin_amdgcn_s_sleep(1); \
    if ((++_sp & 255u) == 0u) { if (xb_ld(&(bar)[XB_TMO])) break; if (_sp > XB_SPIN_CAP) { atomicAdd(&(bar)[XB_TMO], 1u); break; } } } } while (0)

struct XcdBarrier { unsigned* bar; unsigned x; volatile LAS unsigned* st; };

__device__ __forceinline__ XcdBarrier xcd_barrier_post(unsigned* bar, volatile LAS unsigned* st) {
    XcdBarrier b; b.bar = bar; b.x = xb_xcc_id(); b.st = st;
    if (threadIdx.x == 0) (void)xb_add(&bar[XB_XCNT(b.x)], 1u);
    return b;
}
__device__ __forceinline__ void xcd_barrier_complete(unsigned* bar, unsigned x, unsigned& nloc, unsigned& nx) {
    const unsigned G = gridDim.x * gridDim.y * gridDim.z;
    unsigned sum, cnt, mine, sp = 0u;
    for (;;) {
        sum = 0u; cnt = 0u; mine = 0u;
#pragma unroll
        for (unsigned j = 0; j < 16; ++j) { const unsigned c = xb_ld(&bar[XB_XCNT(j)]); sum += c; cnt += (c > 0u) ? 1u : 0u; mine = (j == x) ? c : mine; }
        if (sum == G) break;
        __builtin_amdgcn_s_sleep(1);
        if ((++sp & 255u) == 0u) { if (xb_ld(&bar[XB_TMO])) break; if (sp > XB_SPIN_CAP) { atomicAdd(&bar[XB_TMO], 1u); break; } }
    }
    nloc = mine > 0u ? mine : 1u; nx = cnt > 0u ? cnt : 1u;
}
__device__ __forceinline__ void xcd_barrier(const XcdBarrier& b) {
    asm volatile("s_waitcnt vmcnt(0)" ::: "memory");
    __syncthreads();
    if (threadIdx.x == 0) {
        unsigned* bar = b.bar;
        __builtin_amdgcn_s_waitcnt(0);
        unsigned nloc = b.st[0], nx = b.st[1];
        if (nloc == 0u) { xcd_barrier_complete(bar, b.x, nloc, nx); b.st[0] = nloc; b.st[1] = nx; }
        const unsigned old = xb_add(&bar[XB_XSUB(b.x)], 1u);
        const unsigned gen = old / nloc;
        if (old + 1u == (gen + 1u) * nloc) {
            __builtin_amdgcn_fence(__ATOMIC_RELEASE, "agent");
            asm volatile("s_waitcnt vmcnt(0)" ::: "memory");
            const unsigned og = xb_add(&bar[XB_TOP], 1u);
            const unsigned tg = og / nx;
            if (og + 1u == (tg + 1u) * nx) xb_add(&bar[XB_TOPGEN], 1u);
            else XB_SPIN(xb_ld(&bar[XB_TOPGEN]) == tg, bar);
            __builtin_amdgcn_fence(__ATOMIC_ACQUIRE, "agent");
            xb_add(&bar[XB_XGEN(b.x)], 1u);
            asm volatile("s_waitcnt vmcnt(0)" ::: "memory");
        } else {
            XB_SPIN(xb_ld(&bar[XB_XGEN(b.x)]) == gen, bar);
            __builtin_amdgcn_fence(__ATOMIC_ACQUIRE, "agent");
            asm volatile("s_waitcnt vmcnt(0)" ::: "memory");
        }
    }
    __syncthreads();
}

namespace pg8 {
constexpr int BM = 256, BK = 64, HALF = 128, HTB = HALF * BK * 2, STAGE_BYTES = 8 * HTB, NXCD = 8, WGM = 8;
__device__ __forceinline__ int lds_byte(int r, int c) { const int st = (r >> 4) * 2 + (c >> 5), rr = r & 15, cc = c & 31, ob = rr * 64 + cc * 2; return st * 1024 + (ob ^ (((ob >> 9) & 1) << 5)); }
__device__ __forceinline__ void stage_rc(int b, int& Rr, int& C) { const int st = b / 1024, sb = b % 1024, swz = sb ^ (((sb >> 9) & 1) << 5); Rr = (st >> 1) * 16 + swz / 64; C = (st & 1) * 32 + (swz % 64) / 2; }
__device__ __forceinline__ int perm32(int rho) { const int n = rho >> 4, i = rho & 15; return 8 * (i >> 2) + 4 * n + (i & 3); }

struct Unit { int pm, pn, g; };
struct Gemm { int lda, ldb, K; };

__device__ __forceinline__ void tile_order(int L, int nM, int nN, int& pm, int& pn) {
    const int nwg = nM * nN; int wgid = L;
    { const int q = nwg / NXCD, r = nwg % NXCD, xcd = wgid % NXCD, off = wgid / NXCD; wgid = (xcd < r ? xcd * (q + 1) : r * (q + 1) + (xcd - r) * q) + off; }
    const int nig = WGM * nN, gid = wgid / nig, fm = gid * WGM, gsz = (nM - fm) < WGM ? (nM - fm) : WGM;
    pm = fm + ((wgid % nig) % gsz); pn = (wgid % nig) / gsz;
}

template <class Epi, class Sched>
__device__ __forceinline__ void gemm_phase(LAS unsigned char* lds, const Gemm g, const Sched& S, const Epi& E, const bool perm) {
    int tid = threadIdx.x; asm volatile("" : "+v"(tid));
    const int wid = __builtin_amdgcn_readfirstlane(tid >> 6), lane = tid & 63, wr = wid >> 2, wc = wid & 3, fr = lane & 15, fq = lane >> 4;
    const int K = g.K, nt = K / BK;
    unsigned voffA[2], voffB[2];
#pragma unroll
    for (int i = 0; i < 2; ++i) { int Rr, C; stage_rc(tid * 16 + i * 8192, Rr, C); const int Rb = perm ? ((Rr & ~31) + perm32(Rr & 31)) : Rr;
        voffA[i] = (unsigned)(Rr * g.lda + C) * 2u; voffB[i] = (unsigned)(Rb * g.ldb + C) * 2u; }
    const size_t kstep = (size_t)(BK * 2);
    const size_t hstepA = (size_t)HALF * g.lda * 2, hstepB = (size_t)HALF * g.ldb * 2;
    const unsigned ldsw = (unsigned)wid * 1024u;
    const int aoff = lds_byte(wr * 64 + fr, fq * 8), boff = lds_byte(wc * 32 + fr, fq * 8);
#define PG8_SA(b, h) (((b) * 2 + (h)) * HTB)
#define PG8_SB(b, h) ((4 + (b) * 2 + (h)) * HTB)
#define PG8_STAGE(bufoff, gbase, voff) do { _Pragma("unroll") for (int _i = 0; _i < 2; ++_i) \
        __builtin_amdgcn_global_load_lds((const unsigned*)((const char*)(gbase) + (voff)[_i]), (LAS unsigned*)(lds + (bufoff) + ldsw + _i * 8192), 16, 0, 0); } while (0)
#define PG8_LDA(dst, b, h) do { _Pragma("unroll") for (int m = 0; m < 4; ++m) _Pragma("unroll") for (int k = 0; k < 2; ++k) dst[m][k] = *(const LAS bf16x8*)(lds + PG8_SA(b, h) + aoff + m * 2048 + k * 1024); } while (0)
#define PG8_LDB(dst, b, h) do { _Pragma("unroll") for (int n = 0; n < 2; ++n) _Pragma("unroll") for (int k = 0; k < 2; ++k) dst[n][k] = *(const LAS bf16x8*)(lds + PG8_SB(b, h) + boff + n * 2048 + k * 1024); } while (0)
#define PG8_MMA(ai, bj, At, Bt) do { __builtin_amdgcn_s_setprio(1); _Pragma("unroll") for (int m = 0; m < 4; ++m) _Pragma("unroll") for (int n = 0; n < 2; ++n) _Pragma("unroll") for (int k = 0; k < 2; ++k) \
        acc[ai][bj][m][n] = __builtin_amdgcn_mfma_f32_16x16x32_bf16(Bt[n][k], At[m][k], acc[ai][bj][m][n], 0, 0, 0); __builtin_amdgcn_s_setprio(0); } while (0)
#define PG8_WAIT_V(n) asm volatile("s_waitcnt vmcnt(" #n ")" ::: "memory")
#define PG8_WAIT_L(n) asm volatile("s_waitcnt lgkmcnt(" #n ")" ::: "memory")
#define PG8_BAR __builtin_amdgcn_s_barrier()
#define PG8_SCHED __builtin_amdgcn_sched_barrier(0)
    Unit cur, nxt; int ui = 0;
    if (!S.next(0, cur)) return;
    f32x4 acc[2][2][4][2];
#pragma unroll
    for (int a = 0; a < 2; ++a)
#pragma unroll
        for (int b = 0; b < 2; ++b)
#pragma unroll
            for (int m = 0; m < 4; ++m)
#pragma unroll
                for (int n = 0; n < 2; ++n) acc[a][b][m][n] = (f32x4){0.f, 0.f, 0.f, 0.f};
    bf16x8 At[4][2], B0[2][2], B1[2][2];
    const char* cA = S.a_ptr(cur); const char* cB = S.b_ptr(cur);
    PG8_STAGE(PG8_SB(0, 0), cB, voffB); PG8_STAGE(PG8_SA(0, 0), cA, voffA); PG8_STAGE(PG8_SB(0, 1), cB + hstepB, voffB); PG8_STAGE(PG8_SA(0, 1), cA + hstepA, voffA);
    if (wr == 1) PG8_BAR;
    PG8_WAIT_V(4); PG8_BAR;
    PG8_STAGE(PG8_SB(1, 0), cB + kstep, voffB); PG8_STAGE(PG8_SA(1, 0), cA + kstep, voffA); PG8_STAGE(PG8_SB(1, 1), cB + hstepB + kstep, voffB);
    PG8_WAIT_V(6); PG8_BAR;
    for (;;) {
        const bool has_next = S.next(ui + 1, nxt);
        const char* nA = has_next ? S.a_ptr(nxt) : cA; const char* nB = has_next ? S.b_ptr(nxt) : cB;
        for (int t = 0; t < nt; t += 2) {
            const bool last = (t == nt - 2);
            const char* a1 = cA + (size_t)(t + 1) * kstep;
            const char* a2 = last ? nA : cA + (size_t)(t + 2) * kstep; const char* b2 = last ? nB : cB + (size_t)(t + 2) * kstep;
            const char* a3 = a2 + kstep; const char* b3 = b2 + kstep;
            PG8_LDB(B0, 0, 0); PG8_SCHED; PG8_LDA(At, 0, 0); PG8_STAGE(PG8_SA(1, 1), a1 + hstepA, voffA);
            PG8_WAIT_L(8); PG8_BAR; PG8_WAIT_L(0); PG8_MMA(0, 0, At, B0); PG8_BAR; PG8_SCHED;
            PG8_LDB(B1, 0, 1); PG8_STAGE(PG8_SB(0, 0), b2, voffB);
            PG8_BAR; PG8_WAIT_L(0); PG8_MMA(0, 1, At, B1); PG8_BAR;
            PG8_LDA(At, 0, 1); PG8_STAGE(PG8_SA(0, 0), a2, voffA);
            PG8_BAR; PG8_WAIT_L(0); PG8_MMA(1, 0, At, B0); PG8_BAR; PG8_SCHED;
            PG8_STAGE(PG8_SB(0, 1), b2 + hstepB, voffB);
            PG8_WAIT_V(6); PG8_BAR; PG8_MMA(1, 1, At, B1); PG8_BAR;
            PG8_LDB(B0, 1, 0); PG8_SCHED; PG8_LDA(At, 1, 0); PG8_STAGE(PG8_SA(0, 1), a2 + hstepA, voffA);
            PG8_WAIT_L(8); PG8_BAR; PG8_WAIT_L(0); PG8_MMA(0, 0, At, B0); PG8_BAR; PG8_SCHED;
            PG8_LDB(B1, 1, 1); PG8_STAGE(PG8_SB(1, 0), b3, voffB);
            PG8_BAR; PG8_WAIT_L(0); PG8_MMA(0, 1, At, B1); PG8_BAR;
            PG8_LDA(At, 1, 1); PG8_STAGE(PG8_SA(1, 0), a3, voffA);
            PG8_BAR; PG8_WAIT_L(0); PG8_MMA(1, 0, At, B0); PG8_BAR; PG8_SCHED;
            PG8_STAGE(PG8_SB(1, 1), b3 + hstepB, voffB);
            PG8_WAIT_V(6); PG8_BAR; PG8_MMA(1, 1, At, B1); PG8_BAR;
        }
        E(acc, cur, wr, wc, fr, fq);
        if (!has_next) break;
#pragma unroll
        for (int a = 0; a < 2; ++a)
#pragma unroll
            for (int b = 0; b < 2; ++b)
#pragma unroll
                for (int m = 0; m < 4; ++m)
#pragma unroll
                    for (int n = 0; n < 2; ++n) acc[a][b][m][n] = (f32x4){0.f, 0.f, 0.f, 0.f};
        cur = nxt; cA = nA; cB = nB; ++ui;
    }
    PG8_WAIT_V(0);
    if (wr == 0) PG8_BAR;
    PG8_BAR;
#undef PG8_SA
#undef PG8_SB
#undef PG8_STAGE
#undef PG8_LDA
#undef PG8_LDB
#undef PG8_MMA
#undef PG8_WAIT_V
#undef PG8_WAIT_L
#undef PG8_BAR
#undef PG8_SCHED
}
}

struct KArgs { const float* in[31]; float* out; unsigned char* ws; int ph_lo, ph_hi; };
enum { I_X = 0, I_C, I_CTX, I_CCTX, I_WMOD, I_BMOD, I_NMIX, I_NFFN, I_WIN, I_HGLB, I_QG, I_KG, I_RPB, I_CW, I_CB, I_PW1, I_PB1, I_PF1, I_PW2, I_PB2, I_PF2, I_PW3, I_SKIP,
       I_WA, I_WB, I_WC, I_WOUT, I_WR, I_WEG, I_WEU, I_WED };

struct Frame {
    const GAS float* LAS* in; GAS float* out; GAS unsigned char* ws; LAS unsigned char* lds; int tid, lane, wave, G, bid;
};
#define WSP(T, off) ((GAS T*)(F.ws + (off)))

struct SchedIn {
    const char* A; const char* B; int G, c, nctx;
    __device__ __forceinline__ bool next(int i, pg8::Unit& u) const {
        const int L = i * G + c;
        if (L < 64 * 34) { pg8::tile_order(L, 64, 34, u.pm, u.pn); u.g = 0; return true; }
        const int e = L - 64 * 34; if (e >= 2 * nctx) return false;
        const int hi_ = e >= nctx ? 1 : 0; u.pm = 64 + hi_; u.pn = e - hi_ * nctx; u.g = 0; return true;
    }
    __device__ __forceinline__ const char* a_ptr(const pg8::Unit& u) const { return A + (size_t)u.pm * 256 * 1024 * 2; }
    __device__ __forceinline__ const char* b_ptr(const pg8::Unit& u) const { return B + (size_t)u.pn * 256 * 1024 * 2; }
};
struct SchedBr {
    const char* A; const char* B; int G, c, nM;
    __device__ __forceinline__ bool next(int i, pg8::Unit& u) const {
        const int L = i * G + c; if (L >= nM * 12) return false;
        pg8::tile_order(L, nM, 12, u.pm, u.pn); u.g = u.pn >> 2; return true;
    }
    __device__ __forceinline__ const char* a_ptr(const pg8::Unit& u) const { return A + ((size_t)u.pm * 256 * 1536 + (size_t)u.g * 512) * 2; }
    __device__ __forceinline__ const char* b_ptr(const pg8::Unit& u) const { return B + (size_t)u.pn * 256 * 512 * 2; }
};
struct SchedOut {
    const char* A; const char* B; int G, c, nM;
    __device__ __forceinline__ bool next(int i, pg8::Unit& u) const {
        const int L = i * G + c; if (L >= nM * 4) return false;
        pg8::tile_order(L, nM, 4, u.pm, u.pn); u.g = 0; return true;
    }
    __device__ __forceinline__ const char* a_ptr(const pg8::Unit& u) const { return A + (size_t)u.pm * 256 * 1024 * 2; }
    __device__ __forceinline__ const char* b_ptr(const pg8::Unit& u) const { return B + (size_t)u.pn * 256 * 3072 * 2; }
};
struct SchedGU {
    const char* A; const char* B; int G, c, nMt;
    __device__ __forceinline__ bool next(int i, pg8::Unit& u) const {
        const int L = (G % 8 == 0) ? ((i * 8 + (c & 7)) * (G >> 3) + (c >> 3)) : (i * G + c);
         const int per = nMt * 22; if (L >= NE * per) return false;
        u.g = nMt == 8 ? L / 176 : L / 198; const int rem = L - u.g * per; u.pn = nMt == 8 ? (rem >> 3) : rem / 9; u.pm = rem - u.pn * nMt; return true;
    }
    __device__ __forceinline__ const char* a_ptr(const pg8::Unit& u) const { return A + ((size_t)u.g * XROWS + (size_t)u.pm * 256) * 1024 * 2; }
    __device__ __forceinline__ const char* b_ptr(const pg8::Unit& u) const { return B + ((size_t)u.g * 5632 + (size_t)u.pn * 256) * 1024 * 2; }
};
struct SchedDn {
    const char* A; const char* B; int G, c, nMt;
    __device__ __forceinline__ bool next(int i, pg8::Unit& u) const {
        const int L = (G % 8 == 0) ? ((i * 8 + (c & 7)) * (G >> 3) + (c >> 3)) : (i * G + c);
         const int per = nMt * 4; if (L >= NE * per) return false;
        u.g = nMt == 8 ? (L >> 5) : L / 36; const int rem = L - u.g * per; u.pn = nMt == 8 ? (rem >> 3) : rem / 9; u.pm = rem - u.pn * nMt; return true;
    }
    __device__ __forceinline__ const char* a_ptr(const pg8::Unit& u) const { return A + ((size_t)u.g * XROWS + (size_t)u.pm * 256) * FF * 2; }
    __device__ __forceinline__ const char* b_ptr(const pg8::Unit& u) const { return B + ((size_t)u.g * 1024 + (size_t)u.pn * 256) * FF * 2; }
};

__device__ __forceinline__ float log_forget(float z, f2 c) {
    return __logf(c.x + c.y * sigmoidf_(fmaxf(z, -60.f)));
}
struct EpiIn {
    static constexpr bool PERM = true;
    GAS float* LF; GAS bf16_t* P; const GAS f2* lbc;
    template <int BJ> __device__ __forceinline__ void part(const f32x4 (&acc)[2][2][4][2], int pn, int row0, int wc, int fq) const {
        const int act = (pn == 10 || pn == 11 || pn == 14 || pn == 15) ? 1 : (pn >= 22 ? 2 : 0);
        const int c0 = pn * 256 + BJ * 128 + wc * 32 + 8 * fq;
        if (pn < 4) {
            f2 cc[8];
#pragma unroll
            for (int e = 0; e < 8; ++e) cc[e] = lbc[c0 + e];
#pragma unroll
            for (int ai = 0; ai < 2; ++ai)
#pragma unroll
                for (int m = 0; m < 4; ++m) {
                    const int row = row0 + ai * 128 + m * 16;
                    f32x4 v0 = acc[ai][BJ][m][0], v1 = acc[ai][BJ][m][1];
#pragma unroll
                    for (int e = 0; e < 4; ++e) { v0[e] = log_forget(v0[e], cc[e]); v1[e] = log_forget(v1[e], cc[4 + e]); }
                    GAS float* p = LF + (size_t)row * 1024 + c0;
                    *(GAS f32x4*)p = v0; *(GAS f32x4*)(p + 4) = v1;
                }
        } else {
#pragma unroll
            for (int ai = 0; ai < 2; ++ai)
#pragma unroll
                for (int m = 0; m < 4; ++m) {
                    const int row = row0 + ai * 128 + m * 16;
                    f32x4 v0 = acc[ai][BJ][m][0], v1 = acc[ai][BJ][m][1];
                    if (act == 1) {
#pragma unroll
                        for (int e = 0; e < 4; ++e) { v0[e] = siluf_(v0[e]); v1[e] = siluf_(v1[e]); }
                    } else if (act == 2) {
#pragma unroll
                        for (int e = 0; e < 4; ++e) { v0[e] = sigmoidf_(v0[e]); v1[e] = sigmoidf_(v1[e]); }
                    }
                    u32x4 w; w.x = pk2(v0[0], v0[1]); w.y = pk2(v0[2], v0[3]); w.z = pk2(v1[0], v1[1]); w.w = pk2(v1[2], v1[3]);
                    *(GAS u32x4*)(P + (size_t)row * PC + (c0 - 1024)) = w;
                }
        }
    }
    __device__ __forceinline__ void operator()(const f32x4 (&acc)[2][2][4][2], const pg8::Unit& u, int wr, int wc, int fr, int fq) const {
        const int row0 = u.pm * 256 + wr * 64 + fr;
        part<0>(acc, u.pn, row0, wc, fq);
        part<1>(acc, u.pn, row0, wc, fq);
    }
};
struct EpiBr {
    static constexpr bool PERM = true;
    GAS bf16_t* T; const GAS bf16_t* P;
    __device__ __forceinline__ void operator()(const f32x4 (&acc)[2][2][4][2], const pg8::Unit& u, int wr, int wc, int fr, int fq) const {
        const int row0 = u.pm * 256 + wr * 64 + fr;
#pragma unroll
        for (int ai = 0; ai < 2; ++ai)
#pragma unroll
            for (int m = 0; m < 4; ++m) {
                const int row = row0 + ai * 128 + m * 16;
#pragma unroll
                for (int bj = 0; bj < 2; ++bj) {
                    const int c0 = u.pn * 256 + bj * 128 + wc * 32 + 8 * fq;
                    const f32x4 v0 = acc[ai][bj][m][0], v1 = acc[ai][bj][m][1];
                    u32x4 w; w.x = pk2(v0[0], v0[1]); w.y = pk2(v0[2], v0[3]); w.z = pk2(v1[0], v1[1]); w.w = pk2(v1[2], v1[3]);
                    *(GAS u32x4*)(T + (size_t)row * 3072 + c0) = w;
                }
            }
    }
};
struct EpiOut {
    static constexpr bool PERM = true;
    GAS bf16_t* DL;
    __device__ __forceinline__ void operator()(const f32x4 (&acc)[2][2][4][2], const pg8::Unit& u, int wr, int wc, int fr, int fq) const {
        const int row0 = u.pm * 256 + wr * 64 + fr;
#pragma unroll
        for (int ai = 0; ai < 2; ++ai)
#pragma unroll
            for (int m = 0; m < 4; ++m) {
                const int row = row0 + ai * 128 + m * 16;
#pragma unroll
                for (int bj = 0; bj < 2; ++bj) {
                    const int c0 = u.pn * 256 + bj * 128 + wc * 32 + 8 * fq;
                    const f32x4 v0 = acc[ai][bj][m][0], v1 = acc[ai][bj][m][1];
                    u32x4 w; w.x = pk2(v0[0], v0[1]); w.y = pk2(v0[2], v0[3]); w.z = pk2(v1[0], v1[1]); w.w = pk2(v1[2], v1[3]);
                    *(GAS u32x4*)(DL + (size_t)row * 1024 + c0) = w;
                }
            }
    }
};
struct EpiGU {
    static constexpr bool PERM = true;
    GAS bf16_t* H;
    __device__ __forceinline__ void operator()(const f32x4 (&acc)[2][2][4][2], const pg8::Unit& u, int wr, int wc, int fr, int fq) const {
        const int row0 = u.g * XROWS + u.pm * 256 + wr * 64 + fr;
        const int hc = u.pn * 128 + wc * 32 + 8 * fq;
#pragma unroll
        for (int ai = 0; ai < 2; ++ai)
#pragma unroll
            for (int m = 0; m < 4; ++m) {
                const int row = row0 + ai * 128 + m * 16;
                const f32x4 g0 = acc[ai][0][m][0], g1 = acc[ai][0][m][1], u0 = acc[ai][1][m][0], u1 = acc[ai][1][m][1];
                u32x4 w; w.x = pk2(siluf_(g0[0]) * u0[0], siluf_(g0[1]) * u0[1]); w.y = pk2(siluf_(g0[2]) * u0[2], siluf_(g0[3]) * u0[3]);
                w.z = pk2(siluf_(g1[0]) * u1[0], siluf_(g1[1]) * u1[1]); w.w = pk2(siluf_(g1[2]) * u1[2], siluf_(g1[3]) * u1[3]);
                *(GAS u32x4*)(H + (size_t)row * FF + hc) = w;
            }
    }
};
struct EpiDn {
    static constexpr bool PERM = true;
    GAS bf16_t* Y;
    __device__ __forceinline__ void operator()(const f32x4 (&acc)[2][2][4][2], const pg8::Unit& u, int wr, int wc, int fr, int fq) const {
        const int row0 = u.g * XROWS + u.pm * 256 + wr * 64 + fr;
#pragma unroll
        for (int ai = 0; ai < 2; ++ai)
#pragma unroll
            for (int m = 0; m < 4; ++m) {
                const int row = row0 + ai * 128 + m * 16;
#pragma unroll
                for (int bj = 0; bj < 2; ++bj) {
                    const int c0 = u.pn * 256 + bj * 128 + wc * 32 + 8 * fq;
                    const f32x4 v0 = acc[ai][bj][m][0], v1 = acc[ai][bj][m][1];
                    u32x4 w; w.x = pk2(v0[0], v0[1]); w.y = pk2(v0[2], v0[3]); w.z = pk2(v1[0], v1[1]); w.w = pk2(v1[2], v1[3]);
                    *(GAS u32x4*)(Y + (size_t)row * 1024 + c0) = w;
                }
            }
    }
};

#define MFMA32(a, b, c) __builtin_amdgcn_mfma_f32_32x32x16_bf16((a), (b), (c), 0, 0, 0)
#define MFMA16(a, b, c) __builtin_amdgcn_mfma_f32_16x16x32_bf16((a), (b), (c), 0, 0, 0)
struct CJob { const GAS float* src; GAS bf16_t* dst; int N, k0, n0, ldd, rmap, coff; };
__device__ __forceinline__ CJob conv_job_ne(const Frame& F, int jj) {
    const int l = jj / 704, j = jj - l * 704; CJob d;
    if (j < 544) { const int kt = j / 68, nt = j % 68;
        d.src = F.in[I_WIN] + (size_t)l * 1024 * INC; d.N = INC; d.k0 = kt * 128; d.n0 = nt * 128; d.dst = WSP(bf16_t, WS_WIN) + (size_t)l * INC * 1024; d.ldd = 1024; d.rmap = 0; d.coff = 0;
    } else if (j < 640) { const int q = j - 544; const int g = q >> 5, r = q & 31; const int kt = r >> 3, nt = r & 7;
        d.src = (g == 0 ? F.in[I_WA] : (g == 1 ? F.in[I_WB] : F.in[I_WC])) + (size_t)l * 512 * 1024; d.N = 1024; d.k0 = kt * 128; d.n0 = nt * 128;
        d.dst = WSP(bf16_t, WS_WBR) + (size_t)(l * 3 + g) * 1024 * 512; d.ldd = 512; d.rmap = 0; d.coff = 0;
    } else { const int q = j - 640; const int rep = q >> 6, r = q & 63; const int kt = r >> 3, nt = r & 7;
        d.src = F.in[I_WOUT] + (size_t)l * 1024 * 1024; d.N = 1024; d.k0 = kt * 128; d.n0 = nt * 128; d.dst = WSP(bf16_t, WS_WO3) + (size_t)l * 1024 * 3072; d.ldd = 3072; d.rmap = 0; d.coff = rep * 1024; }
    return d;
}
__device__ __forceinline__ CJob conv_job_ex(const Frame& F, int l, int j) {
    CJob d;
    if (j < 5632) { const int up = j >= 2816; const int q = j - up * 2816; const int e = q / 176, r = q % 176; const int kt = r / 22, nt = r % 22;
        d.src = (up ? F.in[I_WEU] : F.in[I_WEG]) + ((size_t)(l * NE + e) * 1024) * FF; d.N = FF; d.k0 = kt * 128; d.n0 = nt * 128;
        d.dst = WSP(bf16_t, WS_WGU) + (size_t)e * 5632 * 1024; d.ldd = 1024; d.rmap = 1 + up; d.coff = 0;
    } else { const int q = j - 5632; const int e = q / 176, r = q % 176; const int kt = r >> 3, nt = r & 7;
        d.src = F.in[I_WED] + ((size_t)(l * NE + e) * FF) * 1024; d.N = 1024; d.k0 = kt * 128; d.n0 = nt * 128; d.dst = WSP(bf16_t, WS_WDN) + (size_t)e * 1024 * FF; d.ldd = FF; d.rmap = 0; d.coff = 0; }
    return d;
}
static __device__ __noinline__ void conv_stream(const Frame F, int kind, int l, int first, int total, int stride) {
    LAS unsigned char* lds = F.lds;
    const int t = F.tid, lane = t & 63; const int w = __builtin_amdgcn_readfirstlane(t >> 6);
    kind = __builtin_amdgcn_readfirstlane(kind); l = __builtin_amdgcn_readfirstlane(l); first = __builtin_amdgcn_readfirstlane(first); total = __builtin_amdgcn_readfirstlane(total); stride = __builtin_amdgcn_readfirstlane(stride);
    if (first >= total) return;
    const int nmy = (total - first + stride - 1) / stride;
    __syncthreads();
    const int krow = lane >> 5, c0 = ((lane & 31) ^ (2 * w)) * 4, c1 = ((lane & 31) ^ (2 * w + 1)) * 4;
    const int kg = lane & 15, qn = lane >> 4;
#define CONV_JOB(J) (kind ? conv_job_ex(F, l, (J)) : conv_job_ne(F, (J)))
#define CONV_LOAD(D, BUF) do { const unsigned vo0 = (unsigned)(krow * (D).N + c0) * 4u, vo1 = (unsigned)(krow * (D).N + c1) * 4u; \
        const char* gb = (const char*)((D).src + (size_t)((D).k0 + 16 * w) * (D).N + (D).n0); const size_t rs2 = (size_t)(D).N * 8; \
        _Pragma("unroll") for (int pi = 0; pi < 8; ++pi) \
            __builtin_amdgcn_global_load_lds((const unsigned*)(gb + pi * rs2 + (pi < 4 ? vo0 : vo1)), (LAS unsigned*)(lds + (BUF) * 65536 + (w * 8 + pi) * 1024), 16, 0, 0); } while (0)
#define CONV_OUT(D, BUF) do { _Pragma("unroll") for (int jj = 0; jj < 4; ++jj) { const int j4 = 4 * w + jj; \
        const LAS float* rp = (const LAS float*)(lds + (BUF) * 65536) + kg * 1024 + ((j4 ^ kg) * 4) + qn; \
        float v[8]; _Pragma("unroll") for (int e = 0; e < 8; ++e) v[e] = rp[e * 128]; \
        u32x4 wv; wv.x = pk2(v[0], v[1]); wv.y = pk2(v[2], v[3]); wv.z = pk2(v[4], v[5]); wv.w = pk2(v[6], v[7]); \
        const int n = (D).n0 + 4 * j4 + qn; const int row = (D).rmap == 0 ? n : (((n >> 7) << 8) + (n & 127) + ((D).rmap == 2 ? 128 : 0)); \
        *(GAS u32x4*)((D).dst + (size_t)row * (D).ldd + (D).coff + (D).k0 + kg * 8) = wv; } } while (0)
#define CONV_WAITV(n) asm volatile("s_waitcnt vmcnt(" #n ")" ::: "memory")
#define CONV_BAR do { asm volatile("s_waitcnt lgkmcnt(0)" ::: "memory"); __builtin_amdgcn_s_barrier(); asm volatile("" ::: "memory"); } while (0)
    { const CJob d = CONV_JOB(first); CONV_LOAD(d, 0); }
    if (nmy > 1) { const CJob d = CONV_JOB(first + stride); CONV_LOAD(d, 1); }
    for (int q = 0; q < nmy; q += 2) {
        const int j = first + q * stride;
        if (q + 1 < nmy) { if (q) CONV_WAITV(12); else CONV_WAITV(8); } else CONV_WAITV(0);
        CONV_BAR;
        { const CJob d = CONV_JOB(j); CONV_OUT(d, 0); }
        if (q + 2 < nmy) { CONV_BAR; const CJob d = CONV_JOB(j + 2 * stride); CONV_LOAD(d, 0); }
        if (q + 1 < nmy) {
            if (q + 2 < nmy) CONV_WAITV(12); else CONV_WAITV(0);
            CONV_BAR;
            { const CJob d = CONV_JOB(j + stride); CONV_OUT(d, 1); }
            if (q + 3 < nmy) { CONV_BAR; const CJob d = CONV_JOB(j + 3 * stride); CONV_LOAD(d, 1); }
        }
    }
#undef CONV_LOAD
#undef CONV_OUT
#undef CONV_JOB
#undef CONV_WAITV
#undef CONV_BAR
    __syncthreads();
}
static __device__ __noinline__ void mod_unit(const Frame F, int u) {
    const int l = u / 96, jb = (u % 96) * 64; const int t = F.tid, cg = t & 15, ds = t >> 4;
    const GAS float* W = F.in[I_WMOD] + (size_t)l * 1024 * 6144;
    f32x4 acc0 = {0, 0, 0, 0}, acc1 = {0, 0, 0, 0}, acc2 = {0, 0, 0, 0};
    for (int dd = 0; dd < 32; ++dd) {
        const int d = ds * 32 + dd;
        const f32x4 w = *(const GAS f32x4*)(W + (size_t)d * 6144 + jb + cg * 4);
        const float s0 = siluf_(F.in[I_C][d]), s1 = siluf_(F.in[I_C][1024 + d]), s2 = siluf_(F.in[I_CCTX][d]);
        acc0 += w * s0; acc1 += w * s1; acc2 += w * s2;
    }
    LAS float* red = (LAS float*)F.lds;
#pragma unroll
    for (int e = 0; e < 4; ++e) { red[(ds * 3 + 0) * 64 + cg * 4 + e] = acc0[e]; red[(ds * 3 + 1) * 64 + cg * 4 + e] = acc1[e]; red[(ds * 3 + 2) * 64 + cg * 4 + e] = acc2[e]; }
    __syncthreads();
    if (t < 192) { const int r = t >> 6, c = t & 63; float s = 0.f;
        for (int q = 0; q < 32; ++q) s += red[(q * 3 + r) * 64 + c];
        WSP(float, WS_MOD)[(size_t)(l * 3 + r) * 6144 + jb + c] = s + F.in[I_BMOD][(size_t)l * 6144 + jb + c]; }
    __syncthreads();
}
__device__ __forceinline__ const CAS float* ucp(const GAS float* p) {
    const unsigned long long a = (unsigned long long)p; const unsigned lo = __builtin_amdgcn_readfirstlane((unsigned)a), hi = __builtin_amdgcn_readfirstlane((unsigned)(a >> 32));
    return (const CAS float*)(((unsigned long long)hi << 32) | lo);
}
__device__ __forceinline__ void f1_unit(const Frame F, int l, int pb, int cb, int n, GAS float* HT, GAS float* PS) {
    LAS float* h1s = (LAS float*)F.lds; LAS float* h2s = h1s + 64 * 256;
    const int t = F.tid, pos = t & 255, p = pb * 256 + pos; const int half = __builtin_amdgcn_readfirstlane(t >> 8);
    l = __builtin_amdgcn_readfirstlane(l); cb = __builtin_amdgcn_readfirstlane(cb);
    const CAS float* w1 = ucp(F.in[I_PW1] + (size_t)l * 33 * 64); const CAS float* b1 = ucp(F.in[I_PB1] + l * 64); const CAS float* fr1 = ucp(F.in[I_PF1] + l * 64);
    const CAS float* w2 = ucp(F.in[I_PW2] + (size_t)l * 64 * 64); const CAS float* b2 = ucp(F.in[I_PB2] + l * 64); const CAS float* fr2 = ucp(F.in[I_PF2] + l * 64);
    const CAS float* w3 = ucp(F.in[I_PW3] + (size_t)l * 64 * 1024);
    const float tn = (float)p * (1.0f / (float)(n - 1));
    const float rev = (float)p / (float)n;
    const float inv2pi = 0.15915494309189535f;
    float z[33];
    z[0] = tn;
#pragma unroll
    for (int j = 0; j < 16; ++j) { const float fj = 1e-4f + (float)j * ((15.0f - 1e-4f) / 15.0f); const float a = fj * rev; z[1 + j] = __builtin_amdgcn_cosf(a); z[17 + j] = -__builtin_amdgcn_sinf(a); }
    for (int mm = 0; mm < 32; ++mm) { const int m = half * 32 + mm; float acc = b1[m];
#pragma unroll
        for (int i = 0; i < 33; ++i) acc += z[i] * w1[i * 64 + m];
        h1s[m * 256 + pos] = __builtin_amdgcn_sinf(fr1[m] * acc * inv2pi); }
    __syncthreads();
    for (int q = 0; q < 2; ++q) { const int m0 = half * 32 + q * 16; float acc[16];
#pragma unroll
      for (int mm = 0; mm < 16; ++mm) acc[mm] = b2[m0 + mm];
      for (int i = 0; i < 64; ++i) { const float hv = h1s[i * 256 + pos];
#pragma unroll
          for (int mm = 0; mm < 16; ++mm) acc[mm] += hv * w2[i * 64 + m0 + mm]; }
#pragma unroll
      for (int mm = 0; mm < 16; ++mm) h2s[(m0 + mm) * 256 + pos] = __builtin_amdgcn_sinf(fr2[m0 + mm] * acc[mm] * inv2pi); }
    __syncthreads();
    LAS bf16_t* w3t = (LAS bf16_t*)F.lds;
    { const GAS float* w3g = F.in[I_PW3] + (size_t)l * 64 * 1024 + cb * 256;
#pragma unroll 8
      for (int i = 0; i < 32; ++i) { const int idx = t + 512 * i; const int m = idx >> 8, c = idx & 255; w3t[c * 72 + m] = (bf16_t)(pk2(w3g[(size_t)m * 1024 + c], 0.f) & 0xFFFFu); } }
    __syncthreads();
    { const int r = F.lane & 31, hh = F.lane >> 5, ct = F.wave;
      const float da = -3.0701134573253945f, db = -15.350567286626973f;
      bf16x8 Af[4];
#pragma unroll
      for (int ks = 0; ks < 4; ++ks) Af[ks] = *(const LAS bf16x8*)(w3t + (32 * ct + r) * 72 + 16 * ks + 8 * hh);
      float delta[16], asum[16];
#pragma unroll
      for (int e = 0; e < 16; ++e) { const int col = cb * 256 + 32 * ct + (e & 3) + 8 * (e >> 2) + 4 * hh; delta[e] = fabsf(da + (float)col * ((db - da) / 1023.0f)); asum[e] = 0.f; }
      for (int pt = 0; pt < 8; ++pt) {
          f32x16 acc;
#pragma unroll
          for (int e = 0; e < 16; ++e) acc[e] = 0.f;
#pragma unroll
          for (int ks = 0; ks < 4; ++ks) { const LAS float* hp = h2s + (16 * ks + 8 * hh) * 256 + 32 * pt + r;
              u32x4 bw; bw.x = pk2(hp[0], hp[256]); bw.y = pk2(hp[512], hp[768]); bw.z = pk2(hp[1024], hp[1280]); bw.w = pk2(hp[1536], hp[1792]);
              bf16x8 Bf; __builtin_memcpy(&Bf, &bw, 16); acc = MFMA32(Af[ks], Bf, acc); }
          const int pp = pb * 256 + 32 * pt + r; const float tnp = (float)pp * (1.0f / (float)(n - 1));
#pragma unroll
          for (int e = 0; e < 16; ++e) { const int col = cb * 256 + 32 * ct + (e & 3) + 8 * (e >> 2) + 4 * hh;
              const float val = acc[e] * __expf(-tnp * delta[e]); HT[(size_t)col * n + pp] = val; asum[e] += fabsf(val); } }
#pragma unroll
      for (int e = 0; e < 16; ++e) { float sa = asum[e]; sa += __shfl_xor(sa, 1); sa += __shfl_xor(sa, 2); sa += __shfl_xor(sa, 4); sa += __shfl_xor(sa, 8); sa += __shfl_xor(sa, 16);
          if (r == 0) PS[(size_t)pb * 1024 + cb * 256 + 32 * ct + (e & 3) + 8 * (e >> 2) + 4 * hh] = sa; } }
    __syncthreads();
}
__device__ __forceinline__ void prologue_phase(const Frame F) {
    constexpr int U_TW = 32, U_ROPE = 6, U_LBC = 4, U_MOD = 192, U_F1 = 256, U_F1C = 4;
    constexpr int O_ROPE = U_TW, O_LBC = O_ROPE + U_ROPE, O_MOD = O_LBC + U_LBC, O_F1 = O_MOD + U_MOD, O_F1C = O_F1 + U_F1, TOTAL = O_F1C + U_F1C;
    for (int st = 0; st < 2; ++st) {
      const bool do_conv = ((F.bid & 1) != 0) == (st == 0);
      if (do_conv) { conv_stream(F, 0, 0, F.bid, 1408, F.G); }
      else {
    for (int u = (F.bid + 22) % F.G; u < TOTAL; u += F.G) {
        if (u < O_ROPE) { const int m = u * 512 + F.tid; float sn, c; sincospif((float)m * (1.0f / 8192.0f), &sn, &c); WSP(f2, WS_TW)[m] = mk2(c, -sn); }
        else if (u < O_LBC) { const int idx = (u - O_ROPE) * 512 + F.tid; const int pp = idx >> 4, i = idx & 15; const int pos = pp < 128 ? pp : pp - 128;
            const float inv = powf(10000.0f, -(float)i / 16.0f); const float ang = (float)pos * inv; WSP(f2, WS_ROPE)[idx] = mk2(cosf(ang), sinf(ang)); }
        else if (u < O_MOD) { const int idx = (u - O_LBC) * 512 + F.tid; const int l = idx >> 10, rem = idx & 1023;
            const float a0 = F.in[I_HGLB][rem], a1 = F.in[I_HGLB][1024 + rem];
            f2 o; if (l == 0) o = mk2(0.f, 1.f); else o = mk2(sigmoidf_(a1 - a0), sigmoidf_(a0 - a1));
            WSP(f2, WS_LBC)[idx] = o; }
        else if (u < O_F1) mod_unit(F, u - O_MOD);
        else { const int j = u - O_F1; const bool isc = j >= U_F1; const int l = isc ? 0 : (j >> 7), pb = isc ? 0 : ((j >> 2) & 31), cb = j & 3;
            f1_unit(F, l, pb, cb, isc ? 256 : 8192, isc ? WSP(float, WS_HTC) : WSP(float, WS_HT) + (size_t)l * 1024 * 8192, isc ? WSP(float, WS_PSC) : WSP(float, WS_PS) + (size_t)l * 32 * 1024); }
    }
      }
    }

}

constexpr int MF_FI = 34816, MF_U = 69632, MF_UI = MF_U + 34816;
__device__ __forceinline__ bf16x8 mf_frag(const LAS bf16_t* M, int row, int k0) { return *(const LAS bf16x8*)(M + row * 136 + k0); }
__device__ __forceinline__ bf16x8 mf_frag_perm(const LAS bf16_t* M, int row, int s, int g) {
    const u32x2 lo = *(const LAS u32x2*)(M + row * 136 + 32 * s + 4 * g), hi = *(const LAS u32x2*)(M + row * 136 + 32 * s + 16 + 4 * g);
    u32x4 w; w.x = lo.x; w.y = lo.y; w.z = hi.x; w.w = hi.y; bf16x8 r; __builtin_memcpy(&r, &w, 16); return r; }
__device__ __forceinline__ bf16x8 mf_pack4(unsigned a, unsigned b, unsigned c, unsigned d) { u32x4 w; w.x = a; w.y = b; w.z = c; w.w = d; bf16x8 r; __builtin_memcpy(&r, &w, 16); return r; }
__device__ __forceinline__ void mf_build_F(const Frame& F) {
    LAS bf16_t* FR = (LAS bf16_t*)F.lds; LAS bf16_t* FI = (LAS bf16_t*)(F.lds + MF_FI);
    for (int idx = F.tid; idx < 8192; idx += NT) { const int a = idx >> 6, b2 = (idx & 63) * 2;
        const float r0 = (float)((a * b2) & 127) * (1.0f / 128.0f), r1 = (float)((a * (b2 + 1)) & 127) * (1.0f / 128.0f);
        *(LAS unsigned*)(FR + a * 136 + b2) = pk2(__builtin_amdgcn_cosf(r0), __builtin_amdgcn_cosf(r1));
        *(LAS unsigned*)(FI + a * 136 + b2) = pk2(-__builtin_amdgcn_sinf(r0), -__builtin_amdgcn_sinf(r1)); }
}
template <int KS1, bool REALIN>
__device__ __forceinline__ void mf_s1(const Frame& F, int w, int r, int g) {
    const LAS bf16_t* FR = (const LAS bf16_t*)F.lds; const LAS bf16_t* FI = (const LAS bf16_t*)(F.lds + MF_FI);
    LAS bf16_t* UR = (LAS bf16_t*)(F.lds + MF_U); LAS bf16_t* UI = (LAS bf16_t*)(F.lds + MF_UI);
    bf16x8 xr[KS1], xi[KS1];
#pragma unroll
    for (int ks = 0; ks < KS1; ++ks) { xr[ks] = mf_frag(UR, 16 * w + r, 32 * ks + 8 * g); if (!REALIN) xi[ks] = mf_frag(UI, 16 * w + r, 32 * ks + 8 * g); }
    __syncthreads();
#pragma unroll 1
    for (int ct = 0; ct < 8; ++ct) {
        f32x4 rr = {0.f, 0.f, 0.f, 0.f}, ii = {0.f, 0.f, 0.f, 0.f}, ri = {0.f, 0.f, 0.f, 0.f};
#pragma unroll
        for (int ks = 0; ks < KS1; ++ks) { const bf16x8 fr = mf_frag(FR, 16 * ct + r, 32 * ks + 8 * g), fi = mf_frag(FI, 16 * ct + r, 32 * ks + 8 * g);
            rr = MFMA16(xr[ks], fr, rr); ri = MFMA16(xr[ks], fi, ri);
            if (!REALIN) { ii = MFMA16(xi[ks], fi, ii); ri = MFMA16(xi[ks], fr, ri); } }
        const int k1 = 16 * ct + r; float br[4], bi[4];
#pragma unroll
        for (int e = 0; e < 4; ++e) { const int n2 = 16 * w + 4 * g + e; const float re = rr[e] - ii[e], im = ri[e];
            const float rev = (float)(k1 * n2) * (1.0f / 16384.0f); const float c = __builtin_amdgcn_cosf(rev), sn = __builtin_amdgcn_sinf(rev);
            br[e] = re * c + im * sn; bi[e] = im * c - re * sn; }
        u32x2 wr, wi; wr.x = pk2(br[0], br[1]); wr.y = pk2(br[2], br[3]); wi.x = pk2(bi[0], bi[1]); wi.y = pk2(bi[2], bi[3]);
        *(LAS u32x2*)(UR + k1 * 136 + 16 * w + 4 * g) = wr; *(LAS u32x2*)(UI + k1 * 136 + 16 * w + 4 * g) = wi;
    }
    __syncthreads();
}
static __device__ __noinline__ void f2_unit(const Frame F, int l, int c) {
    const int w = __builtin_amdgcn_readfirstlane(F.tid >> 6), r = F.lane & 15, g = F.lane >> 4;
    const GAS float* HT = WSP(float, WS_HT) + (size_t)l * 1024 * 8192; const GAS float* PS = WSP(float, WS_PS) + (size_t)l * 32 * 1024;
    float S = 0.f;
    for (int pb = 0; pb < 32; ++pb) S += PS[pb * 1024 + c] + PS[pb * 1024 + 512 + c];
    S -= fabsf(HT[(size_t)(512 + c) * 8192]);
    const float inv = 1.0f / S;
    { LAS bf16_t* UR = (LAS bf16_t*)(F.lds + MF_U);
      const GAS float* hf = HT + (size_t)c * 8192; const GAS float* hb = HT + (size_t)(512 + c) * 8192;
      float v0[16], v1[16];
#pragma unroll
      for (int i = 0; i < 16; ++i) { const int idx = F.tid + NT * i; const int n2 = idx & 127, n1 = (idx >> 7) * 2; const int n = 128 * n1 + n2;
          if (i < 8) { v0[i] = hf[n]; v1[i] = hf[n + 128]; } else { v0[i] = hb[n == 8192 ? 1 : 16384 - n]; v1[i] = hb[16384 - n - 128]; if (n == 8192) v0[i] = 0.f; } }
      mf_build_F(F);
#pragma unroll
      for (int i = 0; i < 16; ++i) { const int idx = F.tid + NT * i; const int n2 = idx & 127, n1 = (idx >> 7) * 2;
          *(LAS unsigned*)(UR + n2 * 136 + n1) = pk2(v0[i] * inv, v1[i] * inv); } }
    __syncthreads();
    mf_s1<4, true>(F, w, r, g);
    { const LAS bf16_t* FR = (const LAS bf16_t*)F.lds; const LAS bf16_t* FI = (const LAS bf16_t*)(F.lds + MF_FI);
      const LAS bf16_t* UR = (const LAS bf16_t*)(F.lds + MF_U); const LAS bf16_t* UI = (const LAS bf16_t*)(F.lds + MF_UI);
      bf16x8 br[4], bi[4];
#pragma unroll
      for (int ks = 0; ks < 4; ++ks) { br[ks] = mf_frag(UR, 16 * w + r, 32 * ks + 8 * g); bi[ks] = mf_frag(UI, 16 * w + r, 32 * ks + 8 * g); }
      GAS f2* KF = WSP(f2, WS_KF) + (size_t)c * 16384 + (16 * w + r) * 128 + 4 * g;
#pragma unroll 1
      for (int t2 = 0; t2 < 8; ++t2) {
          f32x4 rr = {0.f, 0.f, 0.f, 0.f}, ii = {0.f, 0.f, 0.f, 0.f}, ri = {0.f, 0.f, 0.f, 0.f};
#pragma unroll
          for (int ks = 0; ks < 4; ++ks) { const bf16x8 fr = mf_frag(FR, 16 * t2 + r, 32 * ks + 8 * g), fi = mf_frag(FI, 16 * t2 + r, 32 * ks + 8 * g);
              rr = MFMA16(fr, br[ks], rr); ii = MFMA16(fi, bi[ks], ii); ri = MFMA16(fr, bi[ks], ri); ri = MFMA16(fi, br[ks], ri); }
          const float sc = 1.0f / 16384.0f;
          f32x4 o0, o1; o0[0] = (rr[0] - ii[0]) * sc; o0[1] = ri[0] * sc; o0[2] = (rr[1] - ii[1]) * sc; o0[3] = ri[1] * sc; o1[0] = (rr[2] - ii[2]) * sc; o1[1] = ri[2] * sc; o1[2] = (rr[3] - ii[3]) * sc; o1[3] = ri[3] * sc;
          *(GAS f32x4*)(KF + 16 * t2) = o0; *(GAS f32x4*)(KF + 16 * t2 + 2) = o1;
      } }
    __syncthreads();
}
static __device__ __noinline__ void y2_unit(const Frame F, int c) {
    const int w = __builtin_amdgcn_readfirstlane(F.tid >> 6), r = F.lane & 15, g = F.lane >> 4;
    const LAS bf16_t* FR = (const LAS bf16_t*)F.lds; const LAS bf16_t* FI = (const LAS bf16_t*)(F.lds + MF_FI);
    LAS bf16_t* UR = (LAS bf16_t*)(F.lds + MF_U); LAS bf16_t* UI = (LAS bf16_t*)(F.lds + MF_UI);
    { const GAS f2* UT = WSP(f2, WS_UT) + (size_t)c * 8192;
      f2 v0[8], v1[8];
#pragma unroll
      for (int i = 0; i < 8; ++i) { const int idx = F.tid + NT * i; const int n2 = idx & 127, n1 = (idx >> 7) * 2; v0[i] = UT[128 * n1 + n2]; v1[i] = UT[128 * n1 + 128 + n2]; }
      mf_build_F(F);
#pragma unroll
      for (int i = 0; i < 8; ++i) { const int idx = F.tid + NT * i; const int n2 = idx & 127, n1 = (idx >> 7) * 2;
          *(LAS unsigned*)(UR + n2 * 136 + n1) = pk2(v0[i].x, v1[i].x); *(LAS unsigned*)(UI + n2 * 136 + n1) = pk2(v0[i].y, v1[i].y); } }
    __syncthreads();
    mf_s1<2, false>(F, w, r, g);
    {
        const GAS f2* KF = WSP(f2, WS_KF) + (size_t)c * 16384 + (16 * w + r) * 128 + 4 * g;
        f32x4 kfa[2][2];
        kfa[0][0] = *(const GAS f32x4*)(KF); kfa[0][1] = *(const GAS f32x4*)(KF + 2); kfa[1][0] = *(const GAS f32x4*)(KF + 16); kfa[1][1] = *(const GAS f32x4*)(KF + 18);
        bf16x8 br[4], bi[4];
#pragma unroll
        for (int ks = 0; ks < 4; ++ks) { br[ks] = mf_frag(UR, 16 * w + r, 32 * ks + 8 * g); bi[ks] = mf_frag(UI, 16 * w + r, 32 * ks + 8 * g); }
        __syncthreads();
        unsigned zr[8][2], zi[8][2];
#pragma unroll
        for (int t2 = 0; t2 < 8; ++t2) {
            f32x4 rr = {0.f, 0.f, 0.f, 0.f}, ii = {0.f, 0.f, 0.f, 0.f}, ri = {0.f, 0.f, 0.f, 0.f};
#pragma unroll
            for (int ks = 0; ks < 4; ++ks) { const bf16x8 fr = mf_frag(FR, 16 * t2 + r, 32 * ks + 8 * g), fi = mf_frag(FI, 16 * t2 + r, 32 * ks + 8 * g);
                rr = MFMA16(fr, br[ks], rr); ii = MFMA16(fi, bi[ks], ii); ri = MFMA16(fr, bi[ks], ri); ri = MFMA16(fi, br[ks], ri); }
            const f32x4 k0 = kfa[t2 & 1][0], k1v = kfa[t2 & 1][1];
            if (t2 + 2 < 8) { kfa[t2 & 1][0] = *(const GAS f32x4*)(KF + 16 * (t2 + 2)); kfa[t2 & 1][1] = *(const GAS f32x4*)(KF + 16 * (t2 + 2) + 2); }
            float cr[4], ci[4];
#pragma unroll
            for (int e = 0; e < 4; ++e) { cr[e] = rr[e] - ii[e]; ci[e] = ri[e]; }
            const float z0r = cr[0] * k0[0] - ci[0] * k0[1], z0i = cr[0] * k0[1] + ci[0] * k0[0], z1r = cr[1] * k0[2] - ci[1] * k0[3], z1i = cr[1] * k0[3] + ci[1] * k0[2];
            const float z2r = cr[2] * k1v[0] - ci[2] * k1v[1], z2i = cr[2] * k1v[1] + ci[2] * k1v[0], z3r = cr[3] * k1v[2] - ci[3] * k1v[3], z3i = cr[3] * k1v[3] + ci[3] * k1v[2];
            zr[t2][0] = pk2(z0r, z1r); zr[t2][1] = pk2(z2r, z3r); zi[t2][0] = pk2(z0i, z1i); zi[t2][1] = pk2(z2i, z3i);
        }
#pragma unroll 1
        for (int tn = 0; tn < 8; ++tn) {
            f32x4 p = {0.f, 0.f, 0.f, 0.f}, q1 = {0.f, 0.f, 0.f, 0.f}, q2 = {0.f, 0.f, 0.f, 0.f};
#pragma unroll
            for (int sx = 0; sx < 4; ++sx) { const bf16x8 za = mf_pack4(zr[2 * sx][0], zr[2 * sx][1], zr[2 * sx + 1][0], zr[2 * sx + 1][1]), zb = mf_pack4(zi[2 * sx][0], zi[2 * sx][1], zi[2 * sx + 1][0], zi[2 * sx + 1][1]);
                const bf16x8 fr = mf_frag_perm(FR, 16 * tn + r, sx, g), fi = mf_frag_perm(FI, 16 * tn + r, sx, g);
                p = MFMA16(za, fr, p); p = MFMA16(zb, fi, p); q1 = MFMA16(zb, fr, q1); q2 = MFMA16(za, fi, q2); }
            const int n2 = 16 * tn + r; float ar[4], ai[4];
#pragma unroll
            for (int e = 0; e < 4; ++e) { const int k1 = 16 * w + 4 * g + e; const float re = p[e], im = q1[e] - q2[e];
                const float rev = (float)(k1 * n2) * (1.0f / 16384.0f); const float cs = __builtin_amdgcn_cosf(rev), sn = __builtin_amdgcn_sinf(rev);
                ar[e] = re * cs - im * sn; ai[e] = im * cs + re * sn; }
            u32x2 wr, wi; wr.x = pk2(ar[0], ar[1]); wr.y = pk2(ar[2], ar[3]); wi.x = pk2(ai[0], ai[1]); wi.y = pk2(ai[2], ai[3]);
            *(LAS u32x2*)(UR + n2 * 136 + 16 * w + 4 * g) = wr; *(LAS u32x2*)(UI + n2 * 136 + 16 * w + 4 * g) = wi;
        }
        __syncthreads();
    }
    {
        bf16x8 yr[4], yi[4];
#pragma unroll
        for (int ks = 0; ks < 4; ++ks) { yr[ks] = mf_frag(UR, 16 * w + r, 32 * ks + 8 * g); yi[ks] = mf_frag(UI, 16 * w + r, 32 * ks + 8 * g); }
        GAS f2* YT = WSP(f2, WS_YT) + (size_t)c * 8192 + 16 * w + r;
#pragma unroll 1
        for (int tn1 = 0; tn1 < 4; ++tn1) {
            f32x4 p = {0.f, 0.f, 0.f, 0.f}, q1 = {0.f, 0.f, 0.f, 0.f}, q2 = {0.f, 0.f, 0.f, 0.f};
#pragma unroll
            for (int ks = 0; ks < 4; ++ks) { const bf16x8 fr = mf_frag(FR, 16 * tn1 + r, 32 * ks + 8 * g), fi = mf_frag(FI, 16 * tn1 + r, 32 * ks + 8 * g);
                p = MFMA16(fr, yr[ks], p); p = MFMA16(fi, yi[ks], p); q1 = MFMA16(fr, yi[ks], q1); q2 = MFMA16(fi, yr[ks], q2); }
#pragma unroll
            for (int e = 0; e < 4; ++e) { const int n1 = 16 * tn1 + 4 * g + e; YT[128 * n1] = mk2(p[e], q1[e] - q2[e]); }
        }
    }
    __syncthreads();
}

__device__ __forceinline__ float hy_conv3(const GAS bf16_t* P, size_t row0, int t, int n, int col, const GAS float* cw, const GAS float* cb) {
    const GAS bf16_t* p = P + (row0 + t) * PC + P_HY + col;
    const bool ha = t > 0, hc = t + 1 < n; const bf16_t pa = p[ha ? -PC : 0], pc = p[hc ? PC : 0];
    const float a = ha ? bf2f(pa) : 0.f, b = bf2f(p[0]), c = hc ? bf2f(pc) : 0.f;
    return a * cw[col] + b * cw[1536 + col] + c * cw[3072 + col] + cb[col];
}
struct C3Raw { u32x2 ra, rb, rc; f32x4 w0, w1, w2, bb; };
__device__ __forceinline__ C3Raw hy_conv3x4_load(const GAS bf16_t* P, size_t row0, int t, int n, int col, const GAS float* cw, const GAS float* cb) {
    const GAS bf16_t* p = P + (row0 + t) * PC + P_HY + col; const bool ha = t > 0, hc = t + 1 < n;
    C3Raw r; r.ra = *(const GAS u32x2*)(p - (ha ? PC : 0)); r.rb = *(const GAS u32x2*)p; r.rc = *(const GAS u32x2*)(p + (hc ? PC : 0));
    r.w0 = *(const GAS f32x4*)(cw + col); r.w1 = *(const GAS f32x4*)(cw + 1536 + col); r.w2 = *(const GAS f32x4*)(cw + 3072 + col); r.bb = *(const GAS f32x4*)(cb + col);
    return r;
}
__device__ __forceinline__ f32x4 hy_conv3x4_eval(const C3Raw& r, int t, int n) {
    const bool ha = t > 0, hc = t + 1 < n;
    const unsigned ax = ha ? r.ra.x : 0u, ay = ha ? r.ra.y : 0u, cx = hc ? r.rc.x : 0u, cy = hc ? r.rc.y : 0u;
    f32x4 o;
    o[0] = lo16(ax) * r.w0[0] + lo16(r.rb.x) * r.w1[0] + lo16(cx) * r.w2[0] + r.bb[0];
    o[1] = hi16(ax) * r.w0[1] + hi16(r.rb.x) * r.w1[1] + hi16(cx) * r.w2[1] + r.bb[1];
    o[2] = lo16(ay) * r.w0[2] + lo16(r.rb.y) * r.w1[2] + lo16(cy) * r.w2[2] + r.bb[2];
    o[3] = hi16(ay) * r.w0[3] + hi16(r.rb.y) * r.w1[3] + hi16(cy) * r.w2[3] + r.bb[3];
    return o;
}
__device__ __forceinline__ f32x4 hy_conv3x4(const GAS bf16_t* P, size_t row0, int t, int n, int col, const GAS float* cw, const GAS float* cb) {
    const C3Raw r = hy_conv3x4_load(P, row0, t, n, col, cw, cb); return hy_conv3x4_eval(r, t, n);
}
static __device__ __noinline__ void y1_unit(const Frame F, int l, int u) {
    const int nb = u >> 4, cbk = u & 15, n0 = nb * 64, c0 = cbk * 32;
    LAS f2* zt = (LAS f2*)F.lds;
    const GAS bf16_t* P = WSP(bf16_t, WS_P); const GAS float* cw = F.in[I_CW] + (size_t)l * 3 * 1536; const GAS float* cb = F.in[I_CB] + (size_t)l * 1536;
    { const int nn = F.tid >> 3, c4 = (F.tid & 7) * 4, n = n0 + nn, c = c0 + c4;
      C3Raw ra0 = hy_conv3x4_load(P, 0, n, SEQ, 512 + c, cw, cb), rv0 = hy_conv3x4_load(P, 0, n, SEQ, 1024 + c, cw, cb);
      C3Raw ra1 = hy_conv3x4_load(P, SEQ, n, SEQ, 512 + c, cw, cb), rv1 = hy_conv3x4_load(P, SEQ, n, SEQ, 1024 + c, cw, cb);
      asm volatile("" : "+v"(ra0.ra), "+v"(ra0.rb), "+v"(ra0.rc), "+v"(rv0.ra), "+v"(rv0.rb), "+v"(rv0.rc), "+v"(ra1.ra), "+v"(ra1.rb), "+v"(ra1.rc), "+v"(rv1.ra), "+v"(rv1.rb), "+v"(rv1.rc),
                        "+v"(ra0.w0), "+v"(ra0.w1), "+v"(ra0.w2), "+v"(ra0.bb), "+v"(rv0.w0), "+v"(rv0.w1), "+v"(rv0.w2), "+v"(rv0.bb) :: "memory");
      ra1.w0 = ra0.w0; ra1.w1 = ra0.w1; ra1.w2 = ra0.w2; ra1.bb = ra0.bb; rv1.w0 = rv0.w0; rv1.w1 = rv0.w1; rv1.w2 = rv0.w2; rv1.bb = rv0.bb;
      const f32x4 a0 = hy_conv3x4_eval(ra0, n, SEQ), v0 = hy_conv3x4_eval(rv0, n, SEQ), a1 = hy_conv3x4_eval(ra1, n, SEQ), v1 = hy_conv3x4_eval(rv1, n, SEQ);
#pragma unroll
      for (int e = 0; e < 4; ++e) zt[(c4 + e) * 65 + nn] = mk2(a0[e] * v0[e], a1[e] * v1[e]); }
    __syncthreads();
    { const int nn = F.tid & 63, cg = F.tid >> 6; GAS f2* UT = WSP(f2, WS_UT);
#pragma unroll
      for (int i = 0; i < 4; ++i) { const int cc = cg + 8 * i; UT[(size_t)(c0 + cc) * 8192 + n0 + nn] = zt[cc * 65 + nn]; } }
    __syncthreads();
}
static __device__ __noinline__ void y3_unit(const Frame F, int l, int u) {
    const int nb = u >> 4, cbk = u & 15, n0 = nb * 64, c0 = cbk * 32;
    LAS f2* yt = (LAS f2*)F.lds;
    const GAS bf16_t* P = WSP(bf16_t, WS_P); const GAS float* cw = F.in[I_CW] + (size_t)l * 3 * 1536; const GAS float* cb = F.in[I_CB] + (size_t)l * 1536;
    const GAS float* skip = F.in[I_SKIP] + (size_t)l * 512;
    f2 yv[4];
    { const int nn = F.tid & 63, cg = F.tid >> 6; const GAS f2* YT = WSP(f2, WS_YT);
#pragma unroll
      for (int i = 0; i < 4; ++i) { const int cc = cg + 8 * i; yv[i] = YT[(size_t)(c0 + cc) * 8192 + n0 + nn]; } }
    const int nn2 = F.tid >> 3, c4 = (F.tid & 7) * 4, n = n0 + nn2, c = c0 + c4;
    const f32x4 sk = *(const GAS f32x4*)(skip + c);
    C3Raw rx0[2], rx1[2], rvv[2];
#pragma unroll
    for (int b = 0; b < 2; ++b) { const size_t r0 = (size_t)b * SEQ; rx0[b] = hy_conv3x4_load(P, r0, n, SEQ, c, cw, cb); rx1[b] = hy_conv3x4_load(P, r0, n, SEQ, 512 + c, cw, cb); rvv[b] = hy_conv3x4_load(P, r0, n, SEQ, 1024 + c, cw, cb); }
    asm volatile("" ::: "memory");
    { const int nn = F.tid & 63, cg = F.tid >> 6;
#pragma unroll
      for (int i = 0; i < 4; ++i) { const int cc = cg + 8 * i; yt[cc * 65 + nn] = yv[i]; } }
    __syncthreads();
    { GAS bf16_t* MIX = WSP(bf16_t, WS_MIX);
#pragma unroll
      for (int b = 0; b < 2; ++b) { const size_t r0 = (size_t)b * SEQ;
          const f32x4 x0 = hy_conv3x4_eval(rx0[b], n, SEQ), x1 = hy_conv3x4_eval(rx1[b], n, SEQ), v = hy_conv3x4_eval(rvv[b], n, SEQ);
          float o[4];
#pragma unroll
          for (int e = 0; e < 4; ++e) { const f2 y = yt[(c4 + e) * 65 + nn2]; const float yb = b ? y.y : y.x; o[e] = x0[e] * (yb + sk[e] * x1[e] * v[e]); }
          u32x2 w; w.x = pk2(o[0], o[1]); w.y = pk2(o[2], o[3]);
          *(GAS u32x2*)(MIX + (r0 + n) * 1536 + 1024 + c) = w; } }
    __syncthreads();
}
static __device__ __noinline__ void yctx_unit(const Frame F, int u) {
    const int tq = u & 3, cbk = (u >> 2) & 15, b = u >> 6;
    LAS float* zs = (LAS float*)F.lds;
    LAS float* gs = zs + 8192;
    LAS float* x0s = gs + 16384;
    const GAS bf16_t* P = WSP(bf16_t, WS_P); const GAS float* cw = F.in[I_CW]; const GAS float* cb = F.in[I_CB]; const GAS float* skip = F.in[I_SKIP];
    const GAS float* HTC = WSP(float, WS_HTC); const GAS float* PSC = WSP(float, WS_PSC);
    const size_t r0 = (size_t)RL + (size_t)b * CTX; const int c0 = cbk * 32, t0 = tq * 64;
    { const int c4 = (F.tid & 7) * 4;
      C3Raw r1[4], rv[4];
#pragma unroll
      for (int i = 0; i < 4; ++i) { const int sidx = (F.tid >> 3) + 64 * i; r1[i] = hy_conv3x4_load(P, r0, sidx, CTX, 512 + c0 + c4, cw, cb); rv[i] = hy_conv3x4_load(P, r0, sidx, CTX, 1024 + c0 + c4, cw, cb); }
      const int tt = F.tid >> 3; const C3Raw rx = hy_conv3x4_load(P, r0, t0 + tt, CTX, c0 + c4, cw, cb);
      asm volatile("" ::: "memory");
#pragma unroll
      for (int i = 0; i < 4; ++i) { const int sidx = (F.tid >> 3) + 64 * i; const f32x4 x1 = hy_conv3x4_eval(r1[i], sidx, CTX), v = hy_conv3x4_eval(rv[i], sidx, CTX);
#pragma unroll
          for (int e = 0; e < 4; ++e) zs[sidx * 32 + c4 + e] = x1[e] * v[e]; }
      { const f32x4 x0 = hy_conv3x4_eval(rx, t0 + tt, CTX);
#pragma unroll
        for (int e = 0; e < 4; ++e) x0s[tt * 32 + c4 + e] = x0[e]; } }
    { const int m = F.tid & 255, cg = F.tid >> 8;
#pragma unroll
      for (int i0 = 0; i0 < 16; i0 += 8) { float p0[8], p1[8], hz[8], hfv[8], hbv[8];
#pragma unroll
          for (int i = 0; i < 8; ++i) { const int c = c0 + cg * 16 + i0 + i; p0[i] = PSC[c]; p1[i] = PSC[512 + c]; hz[i] = HTC[(size_t)(512 + c) * 256]; hfv[i] = HTC[(size_t)c * 256 + m]; hbv[i] = HTC[(size_t)(512 + c) * 256 + m]; }
          asm volatile("" ::: "memory");
#pragma unroll
          for (int i = 0; i < 8; ++i) { const int cc = cg * 16 + i0 + i; const float inv = 1.0f / (p0[i] + p1[i] - fabsf(hz[i]));
              gs[(255 + m) * 32 + cc] = hfv[i] * inv;
              if (m >= 1) gs[(255 - m) * 32 + cc] = hbv[i] * inv; } } }
    __syncthreads();
    { const int cc = F.tid & 31, tg = F.tid >> 5; const int tl = tg * 4;
      float a0 = 0.f, a1 = 0.f, a2 = 0.f, a3 = 0.f;
      const LAS float* gp = gs + (255 + t0 + tl) * 32 + cc; const LAS float* zp = zs + cc;
#pragma unroll 8
      for (int sidx = 0; sidx < 256; ++sidx) { const float zv = zp[sidx * 32];
          a0 += gp[(0 - sidx) * 32] * zv; a1 += gp[(1 - sidx) * 32] * zv; a2 += gp[(2 - sidx) * 32] * zv; a3 += gp[(3 - sidx) * 32] * zv; }
      GAS bf16_t* MIX = WSP(bf16_t, WS_MIX); const float sk = skip[c0 + cc];
      const float acc[4] = {a0, a1, a2, a3};
#pragma unroll
      for (int e = 0; e < 4; ++e) { const int t = t0 + tl + e;
          MIX[(r0 + t) * 1536 + 1024 + c0 + cc] = f2bf(x0s[(tl + e) * 32 + cc] * (acc[e] + sk * zs[t * 32 + cc])); } }
    __syncthreads();
}

__device__ __forceinline__ const GAS float* x_row(const Frame F, int l, int row) {
    if (l == 0) return row < RL ? F.in[I_X] + (size_t)row * 1024 : F.in[I_CTX] + (size_t)(row - RL) * 1024;
    return WSP(float, WS_XM) + (size_t)row * 1024;
}
static __device__ __noinline__ void norm1_rows(const Frame F, int l) {
    const GAS float* nm = F.in[I_NMIX] + (size_t)l * 1024; const GAS float* mod = WSP(float, WS_MOD) + (size_t)l * 3 * 6144; GAS bf16_t* HX = WSP(bf16_t, WS_HX);
    for (int row = F.bid * 8 + F.wave; row < R; row += F.G * 8) {
        const GAS float* src = x_row(F, l, row); const int rb = row < RL ? (row >> 13) : 2; const GAS float* md = mod + rb * 6144;
        f32x4 xa[2], xb[2]; float ss = 0.f;
        f32x4 rna[2], rnb[2], rsa[2], rsb[2], rha[2], rhb[2];
#pragma unroll
        for (int i = 0; i < 2; ++i) { const int d0 = 8 * F.lane + 512 * i; xa[i] = *(const GAS f32x4*)(src + d0); xb[i] = *(const GAS f32x4*)(src + d0 + 4);
            rna[i] = *(const GAS f32x4*)(nm + d0); rnb[i] = *(const GAS f32x4*)(nm + d0 + 4);
            rsa[i] = *(const GAS f32x4*)(md + 1024 + d0); rsb[i] = *(const GAS f32x4*)(md + 1024 + d0 + 4);
            rha[i] = *(const GAS f32x4*)(md + d0); rhb[i] = *(const GAS f32x4*)(md + d0 + 4); }
        asm volatile("" : "+v"(xa[0]), "+v"(xb[0]), "+v"(xa[1]), "+v"(xb[1]), "+v"(rna[0]), "+v"(rnb[0]), "+v"(rsa[0]), "+v"(rsb[0]), "+v"(rha[0]), "+v"(rhb[0]), "+v"(rna[1]), "+v"(rnb[1]), "+v"(rsa[1]), "+v"(rsb[1]), "+v"(rha[1]), "+v"(rhb[1]) :: "memory");
#pragma unroll
        for (int i = 0; i < 2; ++i) {
#pragma unroll
            for (int q = 0; q < 4; ++q) ss += xa[i][q] * xa[i][q] + xb[i][q] * xb[i][q]; }
        ss = wave_sum(ss); const float rs = rsqrtf(ss * (1.0f / 1024.0f) + EPS);
#pragma unroll
        for (int i = 0; i < 2; ++i) { const int d0 = 8 * F.lane + 512 * i;
            const f32x4 na = rna[i], nb = rnb[i], sa = rsa[i], sb = rsb[i], ha = rha[i], hb = rhb[i];
            float h[8];
#pragma unroll
            for (int q = 0; q < 4; ++q) { h[q] = xa[i][q] * rs * na[q] * (1.0f + sa[q]) + ha[q]; h[4 + q] = xb[i][q] * rs * nb[q] * (1.0f + sb[q]) + hb[q]; }
            u32x4 hw; hw.x = pk2(h[0], h[1]); hw.y = pk2(h[2], h[3]); hw.z = pk2(h[4], h[5]); hw.w = pk2(h[6], h[7]);
            *(GAS u32x4*)(HX + (size_t)row * 1024 + d0) = hw; }
    }
}
static __device__ __noinline__ void e1_phase(const Frame F, int l) {
    LAS float* wr = (LAS float*)F.lds;
    const GAS float* WR = F.in[I_WR] + (size_t)l * 1024 * 16;
    for (int idx = F.tid; idx < 16384; idx += NT) { const int d = idx >> 4, e = idx & 15; const int i = d >> 9, ln = (d >> 3) & 63, jj = d & 7; wr[((i * 8 + jj) * 64 + ln) * 16 + e] = WR[idx]; }
    __syncthreads();
    const GAS float* nm = F.in[I_NFFN] + (size_t)l * 1024; const GAS float* mod = WSP(float, WS_MOD) + (size_t)l * 3 * 6144; GAS bf16_t* HX = WSP(bf16_t, WS_HX);
    GAS float* AFF = WSP(float, WS_AFF);
    const int nrows = (l == 0) ? R : RL;
    for (int row = F.bid * 8 + F.wave; row < nrows; row += F.G * 8) {
        const GAS float* src = x_row(F, l, row); GAS float* xm = WSP(float, WS_XM) + (size_t)row * 1024; const GAS bf16_t* dl = WSP(bf16_t, WS_T) + (size_t)row * 1024;
        const int rb = row < RL ? (row >> 13) : 2; const GAS float* md = mod + rb * 6144;
        float v[16]; float ss = 0.f;
        f32x4 rxa[2], rxb[2], rga[2], rgb[2]; u32x4 rdw[2];
#pragma unroll
        for (int i = 0; i < 2; ++i) { const int d0 = 8 * F.lane + 512 * i;
            rxa[i] = *(const GAS f32x4*)(src + d0); rxb[i] = *(const GAS f32x4*)(src + d0 + 4); rdw[i] = *(const GAS u32x4*)(dl + d0);
            rga[i] = *(const GAS f32x4*)(md + 2048 + d0); rgb[i] = *(const GAS f32x4*)(md + 2048 + d0 + 4); }
        asm volatile("" : "+v"(rxa[0]), "+v"(rxb[0]), "+v"(rdw[0]), "+v"(rga[0]), "+v"(rgb[0]), "+v"(rxa[1]), "+v"(rxb[1]), "+v"(rdw[1]), "+v"(rga[1]), "+v"(rgb[1]) :: "memory");
#pragma unroll
        for (int i = 0; i < 2; ++i) { const int d0 = 8 * F.lane + 512 * i;
            const f32x4 xa = rxa[i], xb = rxb[i]; const u32x4 dw = rdw[i];
            const f32x4 ga = rga[i], gb = rgb[i];
            f32x4 ya, yb;
            ya[0] = xa[0] + ga[0] * lo16(dw.x); ya[1] = xa[1] + ga[1] * hi16(dw.x); ya[2] = xa[2] + ga[2] * lo16(dw.y); ya[3] = xa[3] + ga[3] * hi16(dw.y);
            yb[0] = xb[0] + gb[0] * lo16(dw.z); yb[1] = xb[1] + gb[1] * hi16(dw.z); yb[2] = xb[2] + gb[2] * lo16(dw.w); yb[3] = xb[3] + gb[3] * hi16(dw.w);
            *(GAS f32x4*)(xm + d0) = ya; *(GAS f32x4*)(xm + d0 + 4) = yb;
#pragma unroll
            for (int q = 0; q < 4; ++q) { v[8 * i + q] = ya[q]; v[8 * i + 4 + q] = yb[q]; ss += ya[q] * ya[q] + yb[q] * yb[q]; } }
        ss = wave_sum(ss); const float rs = rsqrtf(ss * (1.0f / 1024.0f) + EPS);
        float lg[16];
#pragma unroll
        for (int e = 0; e < 16; ++e) lg[e] = 0.f;
#pragma unroll
        for (int i = 0; i < 2; ++i) { const int d0 = 8 * F.lane + 512 * i;
            const f32x4 na = *(const GAS f32x4*)(nm + d0), nb = *(const GAS f32x4*)(nm + d0 + 4);
            const f32x4 sa = *(const GAS f32x4*)(md + 4096 + d0), sb = *(const GAS f32x4*)(md + 4096 + d0 + 4);
            const f32x4 ha = *(const GAS f32x4*)(md + 3072 + d0), hb = *(const GAS f32x4*)(md + 3072 + d0 + 4);
            float h[8];
#pragma unroll
            for (int q = 0; q < 4; ++q) { h[q] = v[8 * i + q] * rs * na[q] * (1.0f + sa[q]) + ha[q]; h[4 + q] = v[8 * i + 4 + q] * rs * nb[q] * (1.0f + sb[q]) + hb[q]; }
            u32x4 hw; hw.x = pk2(h[0], h[1]); hw.y = pk2(h[2], h[3]); hw.z = pk2(h[4], h[5]); hw.w = pk2(h[6], h[7]);
            *(GAS u32x4*)(HX + (size_t)row * 1024 + d0) = hw;
#pragma unroll
            for (int jj = 0; jj < 8; ++jj) {
#pragma unroll
                for (int q = 0; q < 4; ++q) { const f32x4 w = *(const LAS f32x4*)(wr + ((i * 8 + jj) * 64 + F.lane) * 16 + 4 * q);
                    lg[4 * q + 0] += h[jj] * w[0]; lg[4 * q + 1] += h[jj] * w[1]; lg[4 * q + 2] += h[jj] * w[2]; lg[4 * q + 3] += h[jj] * w[3]; }
                if (jj & 1) asm volatile("" ::: "memory"); } }
        float mx = -INFINITY;
#pragma unroll
        for (int e = 0; e < 16; ++e) { lg[e] = wave_sum(lg[e]); mx = fmaxf(mx, lg[e]); }
        float sum = 0.f;
#pragma unroll
        for (int e = 0; e < 16; ++e) { lg[e] = expf(lg[e] - mx); sum += lg[e]; }
        const float is = 1.0f / sum; float mine = 0.f;
#pragma unroll
        for (int e = 0; e < 16; ++e) mine = (F.lane == e) ? lg[e] * is : mine;
        { const bool isc = row >= RL; const int rr = isc ? row - RL : row; const int b = isc ? (rr >> 8) : (rr >> 13), n = isc ? (rr & 255) : (rr & 8191);
          const size_t li = isc ? (size_t)32 * 8192 + (size_t)(b * 16 + (F.lane & 15)) * 256 + n : (size_t)(b * 16 + (F.lane & 15)) * 8192 + n;
          if (F.lane < 16) AFF[li] = mine; }
    }
    __syncthreads();
}
__device__ __forceinline__ int e2_block_excl_scan(int v, LAS int* red, int lane, int wave) {
    int inc = v;
#pragma unroll
    for (int o = 1; o < 64; o <<= 1) { const int y = __shfl_up(inc, o); if (lane >= o) inc += y; }
    if (lane == 63) red[wave] = inc;
    __syncthreads();
    int base = inc - v;
#pragma unroll
    for (int w = 0; w < 8; ++w) { const int rw = red[w]; base += (w < wave) ? rw : 0; }
    __syncthreads();
    return base;
}
__device__ __forceinline__ void e2_unit(const Frame F, int list, bool isctx) {
    const int n = isctx ? CTX : SEQ, k = isctx ? CAPC : CAP;
    const int b = list >> 4, e = list & 15;
    const GAS float* aff = WSP(float, WS_AFF) + (isctx ? (size_t)32 * 8192 + (size_t)list * 256 : (size_t)list * 8192);
    GAS int* IDX = WSP(int, WS_IDX) + (isctx ? 32 * 1024 + list * 32 : list * 1024);
    GAS int* SLOT = WSP(int, WS_SLOT);
    LAS int* hist = (LAS int*)F.lds;
    LAS int* ctl = hist + 264;
    LAS int* red = hist + 272;
    const bool tvalid = F.tid * 16 < n;
    unsigned kh[16];
#pragma unroll
    for (int j = 0; j < 16; ++j) kh[j] = 0u;
    if (tvalid) {
#pragma unroll
        for (int j = 0; j < 16; ++j) kh[j] = __float_as_uint(aff[F.tid * 16 + j]); }
    unsigned prefix = 0u; int krem = k;
    for (int pass = 0; pass < 4; ++pass) {
        const int shift = 24 - 8 * pass;
        const unsigned himask = pass == 0 ? 0u : (0xFFFFFFFFu << (shift + 8));
        if (F.tid < 257) hist[F.tid] = 0;
        __syncthreads();
#pragma unroll
        for (int j = 0; j < 16; ++j) { const bool mt = tvalid && (kh[j] & himask) == (prefix & himask);
            if (mt) __hip_atomic_fetch_add(hist + (int)((kh[j] >> shift) & 255u), 1, __ATOMIC_RELAXED, __HIP_MEMORY_SCOPE_WORKGROUP); }
        __syncthreads();
        if (F.tid < 64) {
            const int L = F.tid; const int c0 = hist[4 * L], c1 = hist[4 * L + 1], c2 = hist[4 * L + 2], c3 = hist[4 * L + 3]; const int loc = c0 + c1 + c2 + c3;
            int suf = loc;
#pragma unroll
            for (int o = 1; o < 64; o <<= 1) { const int y = __shfl_down(suf, o); if (L + o < 64) suf += y; }
            const int above = suf - loc;
            const int cum3 = above + c3, cum2 = cum3 + c2, cum1 = cum2 + c1;
            const int bsel = cum3 >= krem ? 4 * L + 3 : (cum2 >= krem ? 4 * L + 2 : (cum1 >= krem ? 4 * L + 1 : 4 * L));
            const int cab = cum3 >= krem ? above : (cum2 >= krem ? cum3 : (cum1 >= krem ? cum2 : cum1));
            if (above < krem && above + loc >= krem) { ctl[0] = bsel; ctl[1] = cab; }
        }
        __syncthreads();
        prefix |= (unsigned)ctl[0] << shift; krem -= ctl[1];
        __syncthreads();
    }
    const unsigned th = prefix;
    int ceq = 0;
#pragma unroll
    for (int j = 0; j < 16; ++j) ceq += (tvalid && kh[j] == th) ? 1 : 0;
    int eqrun = e2_block_excl_scan(ceq, red, F.lane, F.wave);
    unsigned selmask = 0u; int csel = 0;
#pragma unroll
    for (int j = 0; j < 16; ++j) { const bool gt = tvalid && kh[j] > th, eq = tvalid && kh[j] == th;
        const bool sel = gt || (eq && eqrun < krem); eqrun += eq ? 1 : 0;
        selmask |= sel ? (1u << j) : 0u; csel += sel ? 1 : 0; }
    int base = e2_block_excl_scan(csel, red, F.lane, F.wave);
    if (tvalid) {
        int sv[16];
#pragma unroll
        for (int j = 0; j < 16; ++j) { const int i = F.tid * 16 + j; const bool sel = (selmask >> j) & 1u;
            sv[j] = sel ? base : -1;
            if (sel) IDX[base] = i;
            base += sel ? 1 : 0; }
        GAS int* sp = SLOT + (isctx ? (size_t)32 * 8192 + (size_t)list * 256 : (size_t)list * 8192) + F.tid * 16;
#pragma unroll
        for (int q = 0; q < 4; ++q) { u32x4 w; w.x = (unsigned)sv[4 * q]; w.y = (unsigned)sv[4 * q + 1]; w.z = (unsigned)sv[4 * q + 2]; w.w = (unsigned)sv[4 * q + 3]; *(GAS u32x4*)(sp + 4 * q) = w; } }
}
static __device__ __noinline__ void e3_phase(const Frame F, int l) {
    const GAS bf16_t* HX = WSP(bf16_t, WS_HX); GAS bf16_t* XG = WSP(bf16_t, WS_XG); const GAS int* IDX = WSP(int, WS_IDX);
    const int total = 32768 + (l == 0 ? 1024 : 0);
    for (int j0 = (F.bid * 8 + F.wave) * 4; j0 < total; j0 += F.G * 8 * 4) {
        int src[4], dst[4];
#pragma unroll
        for (int q = 0; q < 4; ++q) { const int j = j0 + q; const bool lat = j < 32768;
            const int jj = j - 32768;
            const int e = lat ? (j >> 11) : (jj >> 6), rem = lat ? (j & 2047) : (jj & 63), b = lat ? (rem >> 10) : (rem >> 5), slot = lat ? (rem & 1023) : (rem & 31);
            const int iw = lat ? (b * 16 + e) * 1024 + slot : 32 * 1024 + (b * 16 + e) * 32 + slot;
            src[q] = (lat ? b * SEQ : RL + b * CTX) + IDX[iw]; dst[q] = e * XROWS + (lat ? rem : 2048 + rem); }
        u32x4 v[4][2];
#pragma unroll
        for (int q = 0; q < 4; ++q) { const GAS u32x4* sp = (const GAS u32x4*)(HX + (size_t)src[q] * 1024); v[q][0] = sp[F.lane]; v[q][1] = sp[64 + F.lane]; }
#pragma unroll
        for (int q = 0; q < 4; ++q) { GAS u32x4* dp = (GAS u32x4*)(XG + (size_t)dst[q] * 1024); dp[F.lane] = v[q][0]; dp[64 + F.lane] = v[q][1]; }
    }
}
static __device__ __noinline__ void e6_phase(const Frame F, int l) {
    const GAS bf16_t* Y = WSP(bf16_t, WS_Y); const GAS int* SLOT = WSP(int, WS_SLOT); const GAS float* AFF = WSP(float, WS_AFF);
    const GAS float* mod = WSP(float, WS_MOD) + (size_t)l * 3 * 6144; GAS float* XM = WSP(float, WS_XM);
    const GAS float* nm1 = F.in[I_NMIX] + 1024; const GAS float* mod1 = WSP(float, WS_MOD) + (size_t)3 * 6144; GAS bf16_t* HX = WSP(bf16_t, WS_HX);
    const int nrows = (l == 0) ? R : RL;
    for (int row = F.bid * 8 + F.wave; row < nrows; row += F.G * 8) {
        const bool isctx = row >= RL; const int rr = isctx ? row - RL : row; const int b = isctx ? (rr >> 8) : (rr >> 13); const int n = isctx ? (rr & 255) : (rr & 8191);
        int s = -1; float a = 0.f;
        if (F.lane < 16) { const size_t li = isctx ? (size_t)32 * 8192 + (size_t)(b * 16 + F.lane) * 256 + n : (size_t)(b * 16 + F.lane) * 8192 + n; s = SLOT[li]; a = AFF[li]; }
        const GAS float* xs = XM + (size_t)row * 1024;
        f32x4 xv[4], gvv[4];
        const GAS float* g2p = mod + (isctx ? 2 : b) * 6144 + 5 * 1024;
#pragma unroll
        for (int i = 0; i < 2; ++i)
#pragma unroll
            for (int hq = 0; hq < 2; ++hq) { xv[2 * i + hq] = *(const GAS f32x4*)(xs + 8 * F.lane + 512 * i + 4 * hq); gvv[2 * i + hq] = *(const GAS f32x4*)(g2p + 8 * F.lane + 512 * i + 4 * hq); }
        unsigned long long mask = __ballot(s >= 0);
        const int off = isctx ? 2048 + b * 32 : b * 1024;
        float acc[16];
#pragma unroll
        for (int i = 0; i < 16; ++i) acc[i] = 0.f;
        while (mask) {
            u32x4 w[3][2]; float ae[3];
#pragma unroll
            for (int q = 0; q < 3; ++q) {
                if (mask) { const int e = __ffsll((long long)mask) - 1; mask &= mask - 1; const int se = __shfl(s, e); ae[q] = __shfl(a, e);
                    const GAS bf16_t* yr = Y + ((size_t)e * XROWS + off + se) * 1024 + 8 * F.lane; w[q][0] = *(const GAS u32x4*)(yr); w[q][1] = *(const GAS u32x4*)(yr + 512); }
                else { ae[q] = 0.f; w[q][0] = (u32x4){0u, 0u, 0u, 0u}; w[q][1] = (u32x4){0u, 0u, 0u, 0u}; } }
#pragma unroll
            for (int q = 0; q < 3; ++q)
#pragma unroll
                for (int i = 0; i < 2; ++i) { const u32x4 ww = w[q][i]; const float aq = ae[q];
                    acc[8 * i + 0] += aq * lo16(ww.x); acc[8 * i + 1] += aq * hi16(ww.x); acc[8 * i + 2] += aq * lo16(ww.y); acc[8 * i + 3] += aq * hi16(ww.y);
                    acc[8 * i + 4] += aq * lo16(ww.z); acc[8 * i + 5] += aq * hi16(ww.z); acc[8 * i + 6] += aq * lo16(ww.w); acc[8 * i + 7] += aq * hi16(ww.w); } }
        const int rb = isctx ? 2 : b;
        GAS float* dst = (l == 1) ? F.out + (size_t)row * 1024 : XM + (size_t)row * 1024;
        float ss = 0.f;
#pragma unroll
        for (int i = 0; i < 2; ++i)
#pragma unroll
            for (int hq = 0; hq < 2; ++hq) { const int d0 = 8 * F.lane + 512 * i + 4 * hq;
                const f32x4 gv = gvv[2 * i + hq];
                f32x4 o;
#pragma unroll
                for (int q = 0; q < 4; ++q) { o[q] = xv[2 * i + hq][q] + gv[q] * acc[8 * i + 4 * hq + q]; ss += o[q] * o[q]; }
                xv[2 * i + hq] = o;
                *(GAS f32x4*)(dst + d0) = o; }
        if (l == 0) {
            ss = wave_sum(ss); const float rs = rsqrtf(ss * (1.0f / 1024.0f) + EPS); const GAS float* md = mod1 + rb * 6144;
            f32x4 rna[2], rnb[2], rsa[2], rsb[2], rha[2], rhb[2];
#pragma unroll
            for (int i = 0; i < 2; ++i) { const int d0 = 8 * F.lane + 512 * i;
                rna[i] = *(const GAS f32x4*)(nm1 + d0); rnb[i] = *(const GAS f32x4*)(nm1 + d0 + 4);
                rsa[i] = *(const GAS f32x4*)(md + 1024 + d0); rsb[i] = *(const GAS f32x4*)(md + 1024 + d0 + 4);
                rha[i] = *(const GAS f32x4*)(md + d0); rhb[i] = *(const GAS f32x4*)(md + d0 + 4); }
            asm volatile("" : "+v"(rna[0]), "+v"(rnb[0]), "+v"(rsa[0]), "+v"(rsb[0]), "+v"(rha[0]), "+v"(rhb[0]), "+v"(rna[1]), "+v"(rnb[1]), "+v"(rsa[1]), "+v"(rsb[1]), "+v"(rha[1]), "+v"(rhb[1]) :: "memory");
#pragma unroll
            for (int i = 0; i < 2; ++i) { const int d0 = 8 * F.lane + 512 * i;
                const f32x4 na = rna[i], nb = rnb[i], sa = rsa[i], sb = rsb[i], ha = rha[i], hb = rhb[i];
                float h[8];
#pragma unroll
                for (int q = 0; q < 4; ++q) { h[q] = xv[2 * i][q] * rs * na[q] * (1.0f + sa[q]) + ha[q]; h[4 + q] = xv[2 * i + 1][q] * rs * nb[q] * (1.0f + sb[q]) + hb[q]; }
                u32x4 hw; hw.x = pk2(h[0], h[1]); hw.y = pk2(h[2], h[3]); hw.z = pk2(h[4], h[5]); hw.w = pk2(h[6], h[7]);
                *(GAS u32x4*)(HX + (size_t)row * 1024 + d0) = hw; }
        }
    }
}

__device__ __forceinline__ int hg_row(int dir, int b, int p, int rho) {
    if (dir == 0) return p < 4 ? RL + b * CTX + p * 64 + rho : b * SEQ + (p - 4) * 64 + rho;
    return p < 4 ? RL + b * CTX + (3 - p) * 64 + (63 - rho) : b * SEQ + (131 - p) * 64 + (63 - rho);
}
__device__ __forceinline__ u32x4 pack8(const float (&e)[16], int o) { u32x4 w; w.x = pk2(e[o], e[o + 1]); w.y = pk2(e[o + 2], e[o + 3]); w.z = pk2(e[o + 4], e[o + 5]); w.w = pk2(e[o + 6], e[o + 7]); return w; }
static __device__ __noinline__ void h1_unit(const Frame F, int u) {
    const int ch = u / NCH, p = u - ch * NCH; const int dir = ch >> 3, b = (ch >> 2) & 1, h = ch & 3;
    LAS bf16_t* KT = (LAS bf16_t*)F.lds; LAS bf16_t* VT = (LAS bf16_t*)(F.lds + 18432); LAS float* tot = (LAS float*)(F.lds + 36864);
    const GAS float* LF = WSP(float, WS_LF); const GAS bf16_t* P = WSP(bf16_t, WS_P);
    const int k = F.tid & 127, seg = F.tid >> 7;
    float lf[16]; u32x4 vreg[2];
#pragma unroll
    for (int j = 0; j < 16; ++j) { const int row = hg_row(dir, b, p, seg * 16 + j); lf[j] = LF[(size_t)row * 1024 + dir * 512 + h * 128 + k]; }
#pragma unroll
    for (int i = 0; i < 2; ++i) { const int idx8 = F.tid + NT * i; const int rho = idx8 >> 4, c8 = (idx8 & 15) * 8; const int row = hg_row(dir, b, p, rho);
        vreg[i] = *(const GAS u32x4*)(P + (size_t)row * PC + P_I + h * 128 + c8); }
    float cs[16]; float run = 0.f;
#pragma unroll
    for (int j = 0; j < 16; ++j) { run += lf[j]; cs[j] = run; }
    tot[seg * 128 + k] = run;
#pragma unroll
    for (int i = 0; i < 2; ++i) { const int idx8 = F.tid + NT * i; const int rho = idx8 >> 4, c8 = (idx8 & 15) * 8; LAS bf16_t* vt = VT + c8 * 72 + (rho ^ (((c8 >> 3) & 7) << 3));
        vt[0 * 72] = (bf16_t)(vreg[i].x & 0xFFFF); vt[1 * 72] = (bf16_t)(vreg[i].x >> 16); vt[2 * 72] = (bf16_t)(vreg[i].y & 0xFFFF); vt[3 * 72] = (bf16_t)(vreg[i].y >> 16);
        vt[4 * 72] = (bf16_t)(vreg[i].z & 0xFFFF); vt[5 * 72] = (bf16_t)(vreg[i].z >> 16); vt[6 * 72] = (bf16_t)(vreg[i].w & 0xFFFF); vt[7 * 72] = (bf16_t)(vreg[i].w >> 16); }
    __syncthreads();
    { const float t0 = tot[k], t1 = tot[128 + k], t2 = tot[256 + k], t3 = tot[384 + k];
      const float off = seg == 0 ? 0.f : (seg == 1 ? t0 : (seg == 2 ? t0 + t1 : t0 + t1 + t2)); const float rem = (t0 + t1 + t2 + t3) - off;
      if (seg == 0) WSP(float, WS_DEC)[(size_t)u * 128 + k] = __expf(rem);
      float kt[16];
#pragma unroll
      for (int j = 0; j < 16; ++j) kt[j] = (1.0f - __expf(lf[j])) * __expf(rem - cs[j]);
      *(LAS u32x4*)(KT + k * 72 + seg * 16) = pack8(kt, 0); *(LAS u32x4*)(KT + k * 72 + seg * 16 + 8) = pack8(kt, 8); }
    __syncthreads();
    { const int r = F.lane & 31, hh = F.lane >> 5; const int mt = F.wave >> 1, nt0 = (F.wave & 1) * 2;
      LAS bf16_t* stg = (LAS bf16_t*)(F.lds + 40960);
#pragma unroll
      for (int q = 0; q < 2; ++q) { const int nt = nt0 + q; f32x16 acc;
#pragma unroll
          for (int e = 0; e < 16; ++e) acc[e] = 0.f;
#pragma unroll
          for (int ks = 0; ks < 4; ++ks) { const bf16x8 A = *(const LAS bf16x8*)(VT + (32 * mt + r) * 72 + ((16 * ks + 8 * hh) ^ ((((32 * mt + r) >> 3) & 7) << 3))); const bf16x8 B = *(const LAS bf16x8*)(KT + (32 * nt + r) * 72 + 16 * ks + 8 * hh);
              acc = MFMA32(A, B, acc); }
#pragma unroll
          for (int e = 0; e < 16; e += 2) { const int vrow = 32 * mt + (e & 3) + 8 * (e >> 2) + 4 * hh; const unsigned w = pk2(acc[e], acc[e + 1]);
              stg[vrow * 136 + 32 * nt + r] = (bf16_t)(w & 0xFFFFu); stg[(vrow + 1) * 136 + 32 * nt + r] = (bf16_t)(w >> 16); } } }
    __syncthreads();
    { GAS bf16_t* dst = WSP(bf16_t, WS_DS) + (size_t)u * 16384; const LAS bf16_t* stg = (const LAS bf16_t*)(F.lds + 40960);
#pragma unroll
      for (int i = 0; i < 4; ++i) { const int idx = F.tid + NT * i; const int v = idx >> 4, k8 = (idx & 15) * 8; *(GAS u32x4*)(dst + v * 128 + k8) = *(const LAS u32x4*)(stg + v * 136 + k8); } }
    __syncthreads();
}
static __device__ __noinline__ void h2_phase(const Frame F) {
    LAS float* dcs = (LAS float*)F.lds;
    const int bidu = __builtin_amdgcn_readfirstlane(F.bid), Gu = __builtin_amdgcn_readfirstlane(F.G);
    for (int e0 = bidu * NT; e0 < 131072; e0 += Gu * NT) {
        const int ch = e0 >> 13; const unsigned el = (unsigned)(((e0 + F.tid) & 8191) * 2); const int k = el & 127;
        { const GAS float* DEC = WSP(float, WS_DEC) + (size_t)ch * NCH * 128;
          for (int idx = F.tid; idx < NCH * 32; idx += NT) *(LAS f32x4*)(dcs + idx * 4) = *(const GAS f32x4*)(DEC + idx * 4); }
        float s0 = 0.f, s1 = 0.f;
        const GAS bf16_t* DSu = WSP(bf16_t, WS_DS) + (size_t)ch * NCH * 16384; GAS bf16_t* STu = WSP(bf16_t, WS_ST) + (size_t)ch * NCH * 16384;
        unsigned ds[44];
#pragma unroll
        for (int j = 0; j < 44; ++j) ds[j] = *(const GAS unsigned*)(DSu + (size_t)j * 16384 + el);
        __syncthreads();
#pragma unroll 1
        for (int p0 = 0; p0 < NCH; p0 += 44) {
            const bool more = p0 + 44 < NCH;
#pragma unroll
            for (int j = 0; j < 44; ++j) { const f2 dc = *(const LAS f2*)(dcs + (p0 + j) * 128 + k); *(GAS unsigned*)(STu + (size_t)(p0 + j) * 16384 + el) = pk2(s0, s1); s0 = dc.x * s0 + lo16(ds[j]); s1 = dc.y * s1 + hi16(ds[j]);
                if (more) ds[j] = *(const GAS unsigned*)(DSu + (size_t)(p0 + 44 + j) * 16384 + el); }
        }
        __syncthreads();
    }
}
static __device__ __noinline__ void h3_unit(const Frame F, int u) {
    const int ch = u / NCH, p = u - ch * NCH; const int dir = ch >> 3, b = (ch >> 2) & 1, h = ch & 3;
    LAS float* bs = (LAS float*)F.lds;
    LAS bf16_t* ATT = (LAS bf16_t*)F.lds;
    LAS bf16_t* QF = (LAS bf16_t*)(F.lds + 32768);
    LAS bf16_t* QS = (LAS bf16_t*)(F.lds + 32768 + 17408);
    LAS bf16_t* KS = (LAS bf16_t*)(F.lds + 32768 + 2 * 17408);
    LAS bf16_t* VT = (LAS bf16_t*)(F.lds + 32768 + 2 * 17408 + 43520);
    const GAS float* LF = WSP(float, WS_LF); const GAS bf16_t* P = WSP(bf16_t, WS_P);
    f2 lfr[8]; unsigned qr[8]; bf16x8 sB[8];
    const int k2 = (F.tid & 63) * 2;
#pragma unroll
    for (int i = 0; i < 8; ++i) { const int rho = (F.tid >> 6) + 8 * i; const int row = hg_row(dir, b, p, rho);
        lfr[i] = *(const GAS f2*)(LF + (size_t)row * 1024 + dir * 512 + h * 128 + k2); qr[i] = *(const GAS unsigned*)(P + (size_t)row * PC + P_HQ + h * 128 + k2); }
    { const int r = F.lane & 31, hh = F.lane >> 5; const int nt = F.wave >> 1; const GAS bf16_t* ST = WSP(bf16_t, WS_ST) + (size_t)u * 16384;
#pragma unroll
      for (int ks = 0; ks < 8; ++ks) sB[ks] = *(const GAS bf16x8*)(ST + (32 * nt + r) * 128 + 16 * ks + 8 * hh); }
    f32x4 lfv[4]; u32x4 vvv[2];
#pragma unroll
    for (int i = 0; i < 4; ++i) { const int idx = F.tid + NT * i; const int rho = idx >> 5, k4 = (idx & 31) * 4; const int row = hg_row(dir, b, p, rho);
        lfv[i] = *(const GAS f32x4*)(LF + (size_t)row * 1024 + dir * 512 + h * 128 + k4); }
#pragma unroll
    for (int i = 0; i < 2; ++i) { const int idx8 = F.tid + NT * i; const int rho = idx8 >> 4, c8 = (idx8 & 15) * 8; const int row = hg_row(dir, b, p, rho);
        vvv[i] = *(const GAS u32x4*)(P + (size_t)row * PC + P_I + h * 128 + c8); }
    asm volatile("" ::: "memory");
#pragma unroll
    for (int i = 0; i < 4; ++i) { const int idx = F.tid + NT * i; const int rho = idx >> 5, k4 = (idx & 31) * 4; *(LAS f32x4*)(bs + rho * 128 + k4) = lfv[i]; }
#pragma unroll
    for (int i = 0; i < 2; ++i) { const int idx8 = F.tid + NT * i; const int rho = idx8 >> 4, c8 = (idx8 & 15) * 8;
        const u32x4 vv = vvv[i];
        LAS bf16_t* vt = VT + c8 * 72 + (rho ^ (((c8 >> 3) & 7) << 3));
        vt[0 * 72] = (bf16_t)(vv.x & 0xFFFF); vt[1 * 72] = (bf16_t)(vv.x >> 16); vt[2 * 72] = (bf16_t)(vv.y & 0xFFFF); vt[3 * 72] = (bf16_t)(vv.y >> 16);
        vt[4 * 72] = (bf16_t)(vv.z & 0xFFFF); vt[5 * 72] = (bf16_t)(vv.z >> 16); vt[6 * 72] = (bf16_t)(vv.w & 0xFFFF); vt[7 * 72] = (bf16_t)(vv.w >> 16); }
    __syncthreads();
    { const int kq = F.tid & 127, sg = F.tid >> 7; float cv[16];
#pragma unroll
      for (int j = 0; j < 16; ++j) cv[j] = bs[(16 * sg + j) * 128 + kq];
      float run = 0.f;
#pragma unroll
      for (int j = 0; j < 16; ++j) { run += cv[j]; cv[j] = run; }
#pragma unroll
      for (int j = 0; j < 16; ++j) bs[(16 * sg + j) * 128 + kq] = cv[j]; }
    __syncthreads();
    { const f2 t0 = *(const LAS f2*)(bs + 15 * 128 + k2), t1 = *(const LAS f2*)(bs + 31 * 128 + k2), t2 = *(const LAS f2*)(bs + 47 * 128 + k2);
      const f2 r1 = t0, r2 = mk2(t0.x + t1.x, t0.y + t1.y), r3 = mk2(t0.x + t1.x + t2.x, t0.y + t1.y + t2.y);
#pragma unroll
      for (int i = 0; i < 8; ++i) { const int rho = (F.tid >> 6) + 8 * i; const int i4 = rho >> 4;
        const f2 lf = lfr[i]; const float kc0 = 1.0f - __expf(lf.x), kc1 = 1.0f - __expf(lf.y);
        const float q0 = lo16(qr[i]), q1 = hi16(qr[i]);
        const f2 ri = i4 == 0 ? mk2(0.f, 0.f) : (i4 == 1 ? r1 : (i4 == 2 ? r2 : r3));
        const f2 bl = *(const LAS f2*)(bs + rho * 128 + k2); const f2 bb = mk2(bl.x + ri.x, bl.y + ri.y);
        *(LAS unsigned*)(QF + rho * 136 + k2) = pk2(q0 * __expf(bb.x), q1 * __expf(bb.y)); *(LAS unsigned*)(QS + rho * 136 + k2) = pk2(q0 * __expf(bb.x - ri.x), q1 * __expf(bb.y - ri.y));
        if (i4 <= 0) *(LAS unsigned*)(KS + (0 + rho) * 136 + k2) = pk2(kc0 * __expf(0.f - bb.x), kc1 * __expf(0.f - bb.y));
        if (i4 <= 1) *(LAS unsigned*)(KS + (16 + rho) * 136 + k2) = pk2(kc0 * __expf(r1.x - bb.x), kc1 * __expf(r1.y - bb.y));
        if (i4 <= 2) *(LAS unsigned*)(KS + (48 + rho) * 136 + k2) = pk2(kc0 * __expf(r2.x - bb.x), kc1 * __expf(r2.y - bb.y));
        *(LAS unsigned*)(KS + (96 + rho) * 136 + k2) = pk2(kc0 * __expf(r3.x - bb.x), kc1 * __expf(r3.y - bb.y)); } }
    __syncthreads();
    for (int idx = F.tid; idx < 4096; idx += NT) { const int t = idx >> 6, s = idx & 63; if ((s >> 4) > (t >> 4)) ATT[t * 72 + s] = 0; }
    { const int c16 = F.lane & 15, g = F.lane >> 4;
      for (int bl = F.wave; bl < 10; bl += 8) {
          const int bi = bl < 1 ? 0 : (bl < 3 ? 1 : (bl < 6 ? 2 : 3)); const int bj = bl - (bi * (bi + 1)) / 2; const int kbase = bi == 0 ? 0 : (bi == 1 ? 16 : (bi == 2 ? 48 : 96));
          f32x4 acc = {0.f, 0.f, 0.f, 0.f};
#pragma unroll
          for (int ks = 0; ks < 4; ++ks) { const bf16x8 A = *(const LAS bf16x8*)(QS + (16 * bi + c16) * 136 + 32 * ks + 8 * g); const bf16x8 B = *(const LAS bf16x8*)(KS + (kbase + 16 * bj + c16) * 136 + 32 * ks + 8 * g);
              acc = MFMA16(A, B, acc); }
#pragma unroll
          for (int e = 0; e < 4; ++e) { const int t = 4 * g + e, s = c16; const float val = (bi == bj && s > t) ? 0.f : acc[e]; ATT[(16 * bi + t) * 72 + 16 * bj + s] = f2bf(val); } } }
    __syncthreads();
    { const int r = F.lane & 31, hh = F.lane >> 5; const int mt = F.wave & 1, nt = F.wave >> 1;
      const GAS bf16_t* ST = WSP(bf16_t, WS_ST) + (size_t)u * 16384;
      f32x16 acc;
#pragma unroll
      for (int e = 0; e < 16; ++e) acc[e] = 0.f;
#pragma unroll
      for (int ks = 0; ks < 8; ++ks) { const bf16x8 A = *(const LAS bf16x8*)(QF + (32 * mt + r) * 136 + 16 * ks + 8 * hh); acc = MFMA32(A, sB[ks], acc); }
#pragma unroll
      for (int ks = 0; ks < 4; ++ks) { const bf16x8 A = *(const LAS bf16x8*)(ATT + (32 * mt + r) * 72 + 16 * ks + 8 * hh); const bf16x8 B = *(const LAS bf16x8*)(VT + (32 * nt + r) * 72 + ((16 * ks + 8 * hh) ^ ((((32 * nt + r) >> 3) & 7) << 3)));
          acc = MFMA32(A, B, acc); }
      GAS float* OH = WSP(float, WS_OH) + (size_t)dir * R * 512;
#pragma unroll
      for (int e = 0; e < 16; ++e) { const int t = 32 * mt + (e & 3) + 8 * (e >> 2) + 4 * hh; const int row = hg_row(dir, b, p, t); OH[(size_t)row * 512 + h * 128 + 32 * nt + r] = acc[e]; } }
    __syncthreads();
}
static __device__ __noinline__ void h4_phase(const Frame F, int l) {
    const GAS float* OH = WSP(float, WS_OH); const GAS bf16_t* P = WSP(bf16_t, WS_P); GAS bf16_t* MIX = WSP(bf16_t, WS_MIX);
    const int nrows = (l == 0) ? R : RL; const int c = 8 * F.lane; const int step = F.G * 8;
    for (int row0 = F.bid * 8 + F.wave; row0 < nrows; row0 += 4 * step) {
        f32x4 a0[4], a1[4], b0[4], b1[4]; u32x4 gt[4];
#pragma unroll
        for (int j = 0; j < 4; ++j) { const int row = row0 + j * step; if (row < nrows) {
            a0[j] = *(const GAS f32x4*)(OH + (size_t)row * 512 + c); a1[j] = *(const GAS f32x4*)(OH + (size_t)row * 512 + c + 4);
            b0[j] = *(const GAS f32x4*)(OH + ((size_t)R + row) * 512 + c); b1[j] = *(const GAS f32x4*)(OH + ((size_t)R + row) * 512 + c + 4);
            gt[j] = *(const GAS u32x4*)(P + (size_t)row * PC + P_HG + c); } }
#pragma unroll
        for (int j = 0; j < 4; ++j) { const int row = row0 + j * step; if (row < nrows) {
            const f32x4 o0 = a0[j] + b0[j], o1 = a1[j] + b1[j];
            float ss = o0[0] * o0[0] + o0[1] * o0[1] + o0[2] * o0[2] + o0[3] * o0[3] + o1[0] * o1[0] + o1[1] * o1[1] + o1[2] * o1[2] + o1[3] * o1[3];
            ss += __shfl_xor(ss, 1); ss += __shfl_xor(ss, 2); ss += __shfl_xor(ss, 4); ss += __shfl_xor(ss, 8);
            const float rn = rsqrtf(ss * (1.0f / 128.0f) + EPS);
            u32x4 w; w.x = pk2(o0[0] * rn * lo16(gt[j].x), o0[1] * rn * hi16(gt[j].x)); w.y = pk2(o0[2] * rn * lo16(gt[j].y), o0[3] * rn * hi16(gt[j].y));
            w.z = pk2(o1[0] * rn * lo16(gt[j].z), o1[1] * rn * hi16(gt[j].z)); w.w = pk2(o1[2] * rn * lo16(gt[j].w), o1[3] * rn * hi16(gt[j].w));
            *(GAS u32x4*)(MIX + (size_t)row * 1536 + c) = w; } }
    }
}

__device__ __forceinline__ void na_norm_g(const u32x4 ra, const u32x4 rb, const f32x4 ga0, const f32x4 ga1, const f32x4 gb0, const f32x4 gb1, float (&a)[8], float (&bq)[8]) {
    a[0] = lo16(ra.x); a[1] = hi16(ra.x); a[2] = lo16(ra.y); a[3] = hi16(ra.y); a[4] = lo16(ra.z); a[5] = hi16(ra.z); a[6] = lo16(ra.w); a[7] = hi16(ra.w);
    bq[0] = lo16(rb.x); bq[1] = hi16(rb.x); bq[2] = lo16(rb.y); bq[3] = hi16(rb.y); bq[4] = lo16(rb.z); bq[5] = hi16(rb.z); bq[6] = lo16(rb.w); bq[7] = hi16(rb.w);
    float ss = 0.f;
#pragma unroll
    for (int j = 0; j < 8; ++j) ss += a[j] * a[j] + bq[j] * bq[j];
    ss += __shfl_xor(ss, 1); ss += __shfl_xor(ss, 2);
    const float rn = rsqrtf(ss * (1.0f / 64.0f) + EPS);
#pragma unroll
    for (int j = 0; j < 4; ++j) { a[j] *= rn * ga0[j]; a[4 + j] *= rn * ga1[j]; bq[j] *= rn * gb0[j]; bq[4 + j] *= rn * gb1[j]; }
}
__device__ __forceinline__ void na_norm(const u32x4 ra, const u32x4 rb, int hf, int sub, const GAS float* gain, float (&a)[8], float (&bq)[8]) {
    a[0] = lo16(ra.x); a[1] = hi16(ra.x); a[2] = lo16(ra.y); a[3] = hi16(ra.y); a[4] = lo16(ra.z); a[5] = hi16(ra.z); a[6] = lo16(ra.w); a[7] = hi16(ra.w);
    bq[0] = lo16(rb.x); bq[1] = hi16(rb.x); bq[2] = lo16(rb.y); bq[3] = hi16(rb.y); bq[4] = lo16(rb.z); bq[5] = hi16(rb.z); bq[6] = lo16(rb.w); bq[7] = hi16(rb.w);
    float ss = 0.f;
#pragma unroll
    for (int j = 0; j < 8; ++j) ss += a[j] * a[j] + bq[j] * bq[j];
    ss += __shfl_xor(ss, 1); ss += __shfl_xor(ss, 2);
    const float rn = rsqrtf(ss * (1.0f / 64.0f) + EPS);
#pragma unroll
    for (int j = 0; j < 8; ++j) { a[j] *= rn * gain[32 * hf + 8 * sub + j]; bq[j] *= rn * gain[32 * hf + 16 + 8 * sub + j]; }
}
__device__ __forceinline__ void na_store16(LAS bf16_t* dst, const float (&a)[8], const float (&bq)[8], float sc) {
    u32x4 w; w.x = pk2(a[0] * sc, a[1] * sc); w.y = pk2(a[2] * sc, a[3] * sc); w.z = pk2(a[4] * sc, a[5] * sc); w.w = pk2(a[6] * sc, a[7] * sc);
    *(LAS u32x4*)dst = w;
    w.x = pk2(bq[0] * sc, bq[1] * sc); w.y = pk2(bq[2] * sc, bq[3] * sc); w.z = pk2(bq[4] * sc, bq[5] * sc); w.w = pk2(bq[6] * sc, bq[7] * sc);
    *(LAS u32x4*)(dst + 16) = w;
}
__device__ __forceinline__ void na_rope(float (&a)[8], float (&bq)[8], const LAS f2* rt, int sub) {
#pragma unroll
    for (int j = 0; j < 8; ++j) { const f2 cs = rt[8 * sub + j]; const float x = a[j], y = bq[j]; a[j] = x * cs.x - y * cs.y; bq[j] = x * cs.y + y * cs.x; }
}
static __device__ __noinline__ void nk_unit(const Frame F, int l, int u) {
    GAS bf16_t* P = WSP(bf16_t, WS_P); const GAS f2* ROPE = WSP(f2, WS_ROPE); const GAS float* kg = F.in[I_KG] + (size_t)l * 64;
    const int row = u * 16 + (F.tid >> 5), head = (F.tid >> 2) & 7, part = F.tid & 3, hf = part >> 1, sub = part & 1;
    GAS bf16_t* kp = P + (size_t)row * PC + P_NK + head * 64 + 32 * hf + 8 * sub;
    const u32x4 ra = *(const GAS u32x4*)kp, rb = *(const GAS u32x4*)(kp + 16);
    const bool lat = row < RL; const int rr = lat ? ((row >> 6) & 127) : 0, cc = lat ? (row & 63) : 0;
    const GAS f2* rt = ROPE + (hf == 0 ? rr * 16 : 128 * 16 + cc * 16) + 8 * sub;
    f2 csv[8];
#pragma unroll
    for (int j = 0; j < 8; ++j) csv[j] = rt[j];
    asm volatile("" ::: "memory");
    float a[8], bq[8];
    na_norm(ra, rb, hf, sub, kg, a, bq);
    if (lat) {
#pragma unroll
        for (int j = 0; j < 8; ++j) { const f2 cs = csv[j]; const float x = a[j], y = bq[j]; a[j] = x * cs.x - y * cs.y; bq[j] = x * cs.y + y * cs.x; } }
    u32x4 w; w.x = pk2(a[0], a[1]); w.y = pk2(a[2], a[3]); w.z = pk2(a[4], a[5]); w.w = pk2(a[6], a[7]);
    *(GAS u32x4*)kp = w;
    w.x = pk2(bq[0], bq[1]); w.y = pk2(bq[2], bq[3]); w.z = pk2(bq[4], bq[5]); w.w = pk2(bq[6], bq[7]);
    *(GAS u32x4*)(kp + 16) = w;
}
static __device__ __noinline__ void na_unit(const Frame F, int l, int u, bool ctxq) {
    const int hp = u & 3, br = u >> 2; const int b = ctxq ? (br >> 2) : (br >> 7); const int r = ctxq ? (br & 3) : (br & 127);
    const int wv = __builtin_amdgcn_readfirstlane(F.tid >> 6); const int hs = wv >> 2, head = hp * 2 + hs, wq = wv & 3, tl = F.tid & 255, lane = F.tid & 63;
    LAS unsigned char* hb = F.lds + hs * 68096;
    LAS bf16_t* QR = (LAS bf16_t*)hb; LAS bf16_t* QP = (LAS bf16_t*)(hb + 9216); LAS unsigned char* KB = hb + 18432; LAS bf16_t* VT = (LAS bf16_t*)(hb + 51200);
    LAS float* rpb = (LAS float*)(F.lds + 136192) + hs * 465;
    const GAS bf16_t* P = WSP(bf16_t, WS_P); const GAS f2* ROPE = WSP(f2, WS_ROPE);
    const GAS float* qg = F.in[I_QG] + (size_t)l * 64;
    const int rs = min(max(r - 4, 0), 120);
    const size_t qrow0 = ctxq ? (size_t)RL + (size_t)b * CTX + (size_t)r * 64 : (size_t)b * SEQ + (size_t)r * 64;
    u32x4 vr[2][2];
#define NA_ROW(KT, kap) ((KT) < 4 ? (size_t)b * SEQ + (size_t)(rs + 2 * (KT) + ((kap) >> 6)) * 64 + ((kap) & 63) : (size_t)RL + (size_t)b * CTX + (size_t)((KT) - 4) * 128 + (kap))
#define NA_LOADV(KT) do { _Pragma("unroll") for (int it = 0; it < 2; ++it) { const int item = tl + 256 * it; const int kap = item >> 2, part = item & 3, hf = part >> 1, sub = part & 1; \
        const GAS bf16_t* vp = P + NA_ROW(KT, kap) * PC + P_NV + head * 64 + 32 * hf + 8 * sub; vr[it][0] = *(const GAS u32x4*)(vp); vr[it][1] = *(const GAS u32x4*)(vp + 16); } } while (0)
#define NA_DMAK(KT, BUF) do { _Pragma("unroll") for (int ii = 0; ii < 4; ++ii) { const int q8 = 4 * wq + ii; const int kap = 8 * q8 + (lane >> 3); \
        const GAS bf16_t* kp = P + NA_ROW(KT, kap) * PC + P_NK + head * 64 + 8 * ((lane & 7) ^ (lane >> 3)); \
        __builtin_amdgcn_global_load_lds((const unsigned*)(const void*)kp, (LAS unsigned*)(KB + (BUF) * 16384 + q8 * 1024), 16, 0, 0); } } while (0)
    const int kt0 = ctxq ? 4 : 0;
    NA_DMAK(kt0, 0); NA_LOADV(kt0);
    { const int qi = tl >> 2, part = tl & 3, hf = part >> 1, sub = part & 1;
      const GAS bf16_t* qp = P + (qrow0 + qi) * PC + P_NQ + head * 64 + 32 * hf + 8 * sub;
      const u32x4 qra = *(const GAS u32x4*)qp, qrb = *(const GAS u32x4*)(qp + 16);
      const GAS float* gq = qg + 32 * hf + 8 * sub;
      const f32x4 ga0 = *(const GAS f32x4*)gq, ga1 = *(const GAS f32x4*)(gq + 4), gb0 = *(const GAS f32x4*)(gq + 16), gb1 = *(const GAS f32x4*)(gq + 20);
      const GAS f2* rt = ROPE + ((ctxq || hf != 0) ? 128 * 16 + (ctxq ? 0 : qi) * 16 : r * 16) + 8 * sub;
      f2 csq[8];
#pragma unroll
      for (int j = 0; j < 8; ++j) csq[j] = rt[j];
      const GAS float* rbg = F.in[I_RPB] + ((size_t)l * 8 + head) * 465;
      const float rp0 = rbg[tl], rp1 = rbg[tl + 256 < 465 ? tl + 256 : 464];
      asm volatile("" ::: "memory");
      rpb[tl] = rp0; if (tl + 256 < 465) rpb[tl + 256] = rp1;
      float a[8], bq[8];
      na_norm_g(qra, qrb, ga0, ga1, gb0, gb1, a, bq);
      na_store16(QP + qi * 72 + 32 * hf + 8 * sub, a, bq, 0.125f);
      if (!ctxq) {
#pragma unroll
          for (int j = 0; j < 8; ++j) { const f2 cs = csq[j]; const float x = a[j], y = bq[j]; a[j] = x * cs.x - y * cs.y; bq[j] = x * cs.y + y * cs.x; }
          na_store16(QR + qi * 72 + 32 * hf + 8 * sub, a, bq, 0.125f); } }
    const int c16 = lane & 15, g = lane >> 4;
    f32x4 O[4];
#pragma unroll
    for (int dt = 0; dt < 4; ++dt) O[dt] = (f32x4){0.f, 0.f, 0.f, 0.f};
    float m_run = -1e30f, l_run = 0.f;
    const int qc = 16 * wq + c16;
    const int cs = min(max(qc - 8, 0), 48);
    const int kx = (g ^ (c16 & 7)) * 8;
    int kb = 0;
    for (int kt = kt0; kt < 6; ++kt) {
        const bool win = kt < 4;
#pragma unroll
        for (int it = 0; it < 2; ++it) { const int item = tl + 256 * it; const int kap = item >> 2, part = item & 3, hf = part >> 1, sub = part & 1;
            const u32x4 va = vr[it][0], vb = vr[it][1];
            LAS bf16_t* vt = VT + (32 * hf + 8 * sub) * 132 + (kap ^ (hf << 4));
            vt[0 * 132] = (bf16_t)(va.x & 0xFFFF); vt[1 * 132] = (bf16_t)(va.x >> 16); vt[2 * 132] = (bf16_t)(va.y & 0xFFFF); vt[3 * 132] = (bf16_t)(va.y >> 16);
            vt[4 * 132] = (bf16_t)(va.z & 0xFFFF); vt[5 * 132] = (bf16_t)(va.z >> 16); vt[6 * 132] = (bf16_t)(va.w & 0xFFFF); vt[7 * 132] = (bf16_t)(va.w >> 16);
            vt += 16 * 132;
            vt[0 * 132] = (bf16_t)(vb.x & 0xFFFF); vt[1 * 132] = (bf16_t)(vb.x >> 16); vt[2 * 132] = (bf16_t)(vb.y & 0xFFFF); vt[3 * 132] = (bf16_t)(vb.y >> 16);
            vt[4 * 132] = (bf16_t)(vb.z & 0xFFFF); vt[5 * 132] = (bf16_t)(vb.z >> 16); vt[6 * 132] = (bf16_t)(vb.w & 0xFFFF); vt[7 * 132] = (bf16_t)(vb.w >> 16); }
        asm volatile("s_waitcnt vmcnt(0) lgkmcnt(0)" ::: "memory"); __builtin_amdgcn_s_barrier(); asm volatile("" ::: "memory");
        if (kt + 1 < 6) { NA_DMAK(kt + 1, kb ^ 1); NA_LOADV(kt + 1); }
        const LAS bf16_t* KT = (const LAS bf16_t*)(KB + kb * 16384);
        f32x4 s[8];
        float mt_max = -1e30f;
        const unsigned skS = (unsigned)__builtin_amdgcn_readfirstlane(win ? (wq == 0 ? 0xCC : (wq == 3 ? 0x33 : (wq == 1 ? 0x88 : 0x11))) : 0);
        const unsigned skP = (unsigned)__builtin_amdgcn_readfirstlane(win ? (wq == 0 ? 0xA : (wq == 3 ? 0x5 : 0)) : 0);
        const LAS bf16_t* QX = win ? QR : QP;
        const bf16x8 q0 = *(const LAS bf16x8*)(QX + (16 * wq + c16) * 72 + 8 * g), q1 = *(const LAS bf16x8*)(QX + (16 * wq + c16) * 72 + 32 + 8 * g);
#pragma unroll
        for (int mt = 0; mt < 8; ++mt) {
            f32x4 acc = {0.f, 0.f, 0.f, 0.f};
            const bf16x8 A0 = *(const LAS bf16x8*)(KT + (16 * mt + c16) * 64 + kx), A1 = *(const LAS bf16x8*)(KT + (16 * mt + c16) * 64 + (kx ^ 32));
            acc = MFMA16(A0, q0, acc); acc = MFMA16(A1, q1, acc);
            if (win) { const int kr = rs + 2 * kt + (mt >> 2);
                const LAS float* bp = rpb + ((kr - r + 7) * 31 + (4 * g - qc + 15)) + 16 * (mt & 3);
                float bv[4];
#pragma unroll
                for (int e = 0; e < 4; ++e) bv[e] = bp[e];
#pragma unroll
                for (int e = 0; e < 4; ++e) { const int kc = 16 * (mt & 3) + 4 * g + e; const bool valid = (unsigned)(kc - cs) < 16u;
                    const float sv = acc[e] + bv[e]; acc[e] = valid ? sv : -1e30f; } }
            s[mt] = acc;
            mt_max = fmaxf(mt_max, fmaxf(fmaxf(acc[0], acc[1]), fmaxf(acc[2], acc[3])));
        }
        mt_max = fmaxf(mt_max, __shfl_xor(mt_max, 16)); mt_max = fmaxf(mt_max, __shfl_xor(mt_max, 32));
        const float m_new = fmaxf(m_run, mt_max); const float alpha = __expf(m_run - m_new); m_run = m_new;
        float psum = 0.f;
#pragma unroll
        for (int mt = 0; mt < 8; ++mt)
#pragma unroll
            for (int e = 0; e < 4; ++e) { const float pv = __expf(s[mt][e] - m_new); s[mt][e] = pv; psum += pv; }
        l_run = l_run * alpha + psum;
#pragma unroll
        for (int dt = 0; dt < 4; ++dt) O[dt] *= alpha;
#pragma unroll
        for (int k2 = 0; k2 < 4; ++k2) {
            u32x4 pw; pw.x = pk2(s[2 * k2][0], s[2 * k2][1]); pw.y = pk2(s[2 * k2][2], s[2 * k2][3]); pw.z = pk2(s[2 * k2 + 1][0], s[2 * k2 + 1][1]); pw.w = pk2(s[2 * k2 + 1][2], s[2 * k2 + 1][3]);
            bf16x8 pf; __builtin_memcpy(&pf, &pw, 16);
#pragma unroll
            for (int dt = 0; dt < 4; ++dt) {
                const u32x2 lo = *(const LAS u32x2*)(VT + (16 * dt + c16) * 132 + 32 * k2 + 4 * g + (dt >= 2 ? 16 : 0)), hi = *(const LAS u32x2*)(VT + (16 * dt + c16) * 132 + 32 * k2 + 4 * g + (dt >= 2 ? 0 : 16));
                u32x4 aw; aw.x = lo.x; aw.y = lo.y; aw.z = hi.x; aw.w = hi.y; bf16x8 af; __builtin_memcpy(&af, &aw, 16);
                O[dt] = MFMA16(af, pf, O[dt]); } }
        asm volatile("s_waitcnt lgkmcnt(0)" ::: "memory"); __builtin_amdgcn_s_barrier(); asm volatile("" ::: "memory");
        kb ^= 1;
    }
#undef NA_ROW
#undef NA_LOADV
#undef NA_DMAK
    l_run += __shfl_xor(l_run, 16); l_run += __shfl_xor(l_run, 32);
    const float inv = 1.0f / l_run;
    GAS bf16_t* MIX = WSP(bf16_t, WS_MIX) + (qrow0 + qc) * 1536 + 512 + head * 64;
#pragma unroll
    for (int dt = 0; dt < 4; ++dt) { u32x2 w; w.x = pk2(O[dt][0] * inv, O[dt][1] * inv); w.y = pk2(O[dt][2] * inv, O[dt][3] * inv); *(GAS u32x2*)(MIX + 16 * dt + 4 * g) = w; }
    asm volatile("s_waitcnt vmcnt(0)" ::: "memory");
    __syncthreads();
}


static __device__ __noinline__ void gs_phase(const Frame F, int l) {
    const GAS bf16_t* T = WSP(bf16_t, WS_T); const GAS bf16_t* P = WSP(bf16_t, WS_P); GAS bf16_t* M = WSP(bf16_t, WS_HX);
    const int nrows = (l == 0) ? R : RL; const int step = F.G * 8;
    for (int row0 = F.bid * 8 + F.wave; row0 < nrows; row0 += 2 * step) {
        u32x4 t[2][3][2], g[2][3][2];
#pragma unroll
        for (int j = 0; j < 2; ++j) { const int row = row0 + j * step; if (row < nrows) {
            const GAS bf16_t* tp = T + (size_t)row * 3072 + 8 * F.lane; const GAS bf16_t* gp = P + (size_t)row * PC + P_GATE + 8 * F.lane;
#pragma unroll
            for (int br = 0; br < 3; ++br)
#pragma unroll
                for (int i = 0; i < 2; ++i) { t[j][br][i] = *(const GAS u32x4*)(tp + 1024 * br + 512 * i); g[j][br][i] = *(const GAS u32x4*)(gp + 1024 * br + 512 * i); } } }
#pragma unroll
        for (int j = 0; j < 2; ++j) { const int row = row0 + j * step; if (row < nrows) {
#pragma unroll
            for (int i = 0; i < 2; ++i) { u32x4 w;
#define GS_MIX(F_) (lo16(t[j][0][i].F_) * lo16(g[j][0][i].F_) + lo16(t[j][1][i].F_) * lo16(g[j][1][i].F_) + lo16(t[j][2][i].F_) * lo16(g[j][2][i].F_))
#define GS_MIXH(F_) (hi16(t[j][0][i].F_) * hi16(g[j][0][i].F_) + hi16(t[j][1][i].F_) * hi16(g[j][1][i].F_) + hi16(t[j][2][i].F_) * hi16(g[j][2][i].F_))
                w.x = pk2(GS_MIX(x), GS_MIXH(x)); w.y = pk2(GS_MIX(y), GS_MIXH(y)); w.z = pk2(GS_MIX(z), GS_MIXH(z)); w.w = pk2(GS_MIX(w), GS_MIXH(w));
#undef GS_MIX
#undef GS_MIXH
                *(GAS u32x4*)(M + (size_t)row * 1024 + 8 * F.lane + 512 * i) = w; } } }
    }
}

struct EpiNull {
    static constexpr bool PERM = true;
    __device__ __forceinline__ void operator()(const f32x4 (&acc)[2][2][4][2], const pg8::Unit& u, int wr, int wc, int fr, int fq) const {
#pragma unroll
        for (int ai = 0; ai < 2; ++ai)
#pragma unroll
            for (int bj = 0; bj < 2; ++bj)
#pragma unroll
                for (int m = 0; m < 4; ++m)
#pragma unroll
                    for (int n = 0; n < 2; ++n) asm volatile("" :: "v"(acc[ai][bj][m][n]));
    }
};
template <int MODE>
static __device__ __forceinline__ void gemm_run_t(Frame F, int l) {
    asm volatile("" : "+s"(F.ws), "+s"(l));
    const bool ctx_on = (l == 0);
    if constexpr (MODE == 0) {
        pg8::Gemm g{1024, 1024, 1024};
        SchedIn S{(const char*)WSP(bf16_t, WS_HX), (const char*)(WSP(bf16_t, WS_WIN) + (size_t)l * INC * 1024), F.G, F.bid, ctx_on ? 34 : 10};
        EpiIn E{WSP(float, WS_LF), WSP(bf16_t, WS_P), WSP(f2, WS_LBC) + (size_t)l * 1024};
        pg8::gemm_phase(F.lds, g, S, E, true);
    } else if constexpr (MODE == 1) {
        pg8::Gemm g{1536, 512, 512};
        SchedBr S{(const char*)WSP(bf16_t, WS_MIX), (const char*)(WSP(bf16_t, WS_WBR) + (size_t)l * 3 * 1024 * 512), F.G, F.bid, ctx_on ? 66 : 64};
        EpiBr E{WSP(bf16_t, WS_T), WSP(bf16_t, WS_P)};
        pg8::gemm_phase(F.lds, g, S, E, true);
    } else if constexpr (MODE == 2) {
        pg8::Gemm g{1024, 3072, 1024};
        SchedOut S{(const char*)WSP(bf16_t, WS_HX), (const char*)(WSP(bf16_t, WS_WO3) + (size_t)l * 1024 * 3072), F.G, F.bid, ctx_on ? 66 : 64};
        EpiOut E{WSP(bf16_t, WS_T)};
        pg8::gemm_phase(F.lds, g, S, E, true);
    } else if constexpr (MODE == 6) {
        pg8::Gemm g{1024, 1024, 1024};
        SchedGU S{(const char*)WSP(bf16_t, WS_XG), (const char*)WSP(bf16_t, WS_WGU), F.G, F.bid, ctx_on ? 9 : 8};
        EpiNull E{};
        pg8::gemm_phase(F.lds, g, S, E, true);
    } else if constexpr (MODE == 7) {
        pg8::Gemm g{FF, FF, FF};
        SchedDn S{(const char*)WSP(bf16_t, WS_H), (const char*)WSP(bf16_t, WS_WDN), F.G, F.bid, ctx_on ? 9 : 8};
        EpiNull E{};
        pg8::gemm_phase(F.lds, g, S, E, true);
    } else if constexpr (MODE == 3) {
        pg8::Gemm g{1024, 1024, 1024};
        SchedGU S{(const char*)WSP(bf16_t, WS_XG), (const char*)WSP(bf16_t, WS_WGU), F.G, F.bid, ctx_on ? 9 : 8};
        EpiGU E{WSP(bf16_t, WS_H)};
        pg8::gemm_phase(F.lds, g, S, E, true);
    } else {
        pg8::Gemm g{FF, FF, FF};
        SchedDn S{(const char*)WSP(bf16_t, WS_H), (const char*)WSP(bf16_t, WS_WDN), F.G, F.bid, ctx_on ? 9 : 8};
        EpiDn E{WSP(bf16_t, WS_Y)};
        pg8::gemm_phase(F.lds, g, S, E, true);
    }
}

constexpr int NPH_LAYER = 15, NPHASES = 1 + 2 * NPH_LAYER;
__global__ void __launch_bounds__(NT, 2) fwd_kernel(KArgs args) {
    extern __shared__ __attribute__((aligned(16))) unsigned char smem[];
    Frame F; F.in = (const GAS float* LAS*)((LAS unsigned char*)smem + LDS_MISC + 64); F.out = (GAS float*)args.out; F.ws = (GAS unsigned char*)args.ws; F.lds = (LAS unsigned char*)smem; F.tid = threadIdx.x; F.lane = F.tid & 63; F.wave = __builtin_amdgcn_readfirstlane(F.tid >> 6);
    F.G = gridDim.x; F.bid = blockIdx.x;
    volatile LAS unsigned* misc = (volatile LAS unsigned*)(F.lds + LDS_MISC);
    if (F.tid < 4) misc[F.tid] = 0u;
    if (F.tid == 0) {
#pragma unroll
        for (int i = 0; i < 31; ++i) F.in[i] = (const GAS float*)args.in[i];
    }
    __syncthreads();
    const int lo = args.ph_lo, hi = args.ph_hi;
    XcdBarrier bar; bar.bar = (unsigned*)(args.ws + WS_CTL); bar.x = 0; bar.st = misc;
    if (hi - lo > 1) bar = xcd_barrier_post((unsigned*)(args.ws + WS_CTL), misc);
#ifndef PHASE_MASK
#define PHASE_MASK 0xFFFF
#endif
#define PH_ON(j) (((PHASE_MASK) >> (j)) & 1)
#ifndef DUP_MASK
#define DUP_MASK 0
#endif
#define REPS(j) ((((DUP_MASK) >> (j)) & 1) ? 2 : 1)

#define IN(k) (lo <= (k) && (k) < hi)
#define SEAM(k) do { if ((k) + 1 < hi) xcd_barrier(bar); } while (0)
    const int G = F.G, bid = F.bid;

    if (PH_ON(15) && IN(0)) { for (int rep = 0; rep < REPS(15); ++rep) prologue_phase(F); SEAM(0); }

    for (int l = 0; l < 2; ++l) {
        const int pb = 1 + NPH_LAYER * l;
        const bool ctx_on = (l == 0);
        const int pre1 = (G & 7) == 0 ? 2112 : 0;
        const int e2u = ctx_on ? 64 : 32, e2idle = G > e2u ? G - e2u : 0, bgc2 = 8448 - e2idle * 3;
        const bool g256 = G == 256;
        const int tA2_first = ctx_on ? 196 : 148, tA2_n = g256 ? (256 - tA2_first) * 4 : 0, tG1_n = (g256 && ctx_on) ? 232 * 2 : 0, tG2_n = (g256 && ctx_on) ? 248 * 4 : 0;
        const int tA2_lo = l == 0 ? 0 : pre1, tG1_lo = tA2_lo + tA2_n, tG2_lo = tG1_lo + tG1_n;
        const int bgc0 = tG2_lo + tG2_n, bgc1 = l == 0 ? (g256 ? 4200 : 2816) : 4500;
#define TAILC(first_idle, lo_, cnt_) do { if ((cnt_) > 0 && bid >= (first_idle)) { int b2 = bid; asm volatile("" : "+s"(b2)); conv_stream(F, 1, l, (lo_) + b2 - (first_idle), (lo_) + (cnt_), 256 - (first_idle)); } } while (0)
        if (PH_ON(0) && IN(pb + 0) && !(l == 1 && g256)) { for (int rep = 0; rep < REPS(0); ++rep) {
            for (int u = bid; u < 512; u += G) f2_unit(F, l, u);
            SREP(2) if (l == 0) norm1_rows(F, l);
            } SEAM(pb + 0);
        }
        if (PH_ON(1) && IN(pb + 1)) { for (int rep = 0; rep < REPS(1); ++rep) {
            gemm_run_t<0>(F, l);
            TAILC(tA2_first, tA2_lo, tA2_n);
            } SEAM(pb + 1);
        }
        if (PH_ON(2) && IN(pb + 2)) { for (int rep = 0; rep < REPS(2); ++rep) {
#ifndef M1_MASK
#define M1_MASK 31
#endif
#define BGC(slot, pos) do { if ((bid & 3) == (pos)) conv_stream(F, 1, l, ((slot) == 0 ? bgc0 : bgc1) + bid, (slot) == 0 ? bgc1 : bgc2, G); } while (0)
            BGC(0, 0);
            SREP(3) if (M1_MASK & 1) { for (int u = bid; u < R / 16; u += G) nk_unit(F, l, u); }
            BGC(0, 1);
            SREP(4) if (M1_MASK & 4) for (int u = (bid + 160) % G; u < NCHAIN * NCH; u += G) h1_unit(F, u);
            BGC(0, 2);
            SREP(5) if (M1_MASK & 8) for (int u = bid; u < 2048; u += G) y1_unit(F, l, u);
            BGC(0, 3);
            SREP(6) if ((M1_MASK & 16) && ctx_on) for (int u = (bid + 64) % G; u < 128; u += G) yctx_unit(F, u);
            } SEAM(pb + 2);
        }
        if (PH_ON(3) && IN(pb + 3)) { for (int rep = 0; rep < REPS(3); ++rep) {
            BGC(1, 0);
            { const int nna = 1024 + (ctx_on ? 32 : 0); for (int u = bid; u < nna; u += G) na_unit(F, l, u < 1024 ? u : u - 1024, u >= 1024); }
            SREP(7) for (int u = bid; u < 512; u += G) { y2_unit(F, u); if (u < G) BGC(1, 1); }
            BGC(1, 2);
            SREP(8) h2_phase(F);
            BGC(1, 3);
            } SEAM(pb + 3);
        }
        if (PH_ON(4) && IN(pb + 4)) { for (int rep = 0; rep < REPS(4); ++rep) {
            SREP(9) { if (ctx_on) { for (int u = bid; u < NCHAIN * NCH; u += G) h3_unit(F, u); }
            else { for (int v = bid; v < NCHAIN * 128; v += G) h3_unit(F, (v >> 7) * NCH + 4 + (v & 127)); } }
            SREP(10) for (int u = (bid + 64) % G; u < 2048; u += G) y3_unit(F, l, u);
            } SEAM(pb + 4);
        }
        if (PH_ON(5) && IN(pb + 5)) { for (int rep = 0; rep < REPS(5); ++rep) { h4_phase(F, l); } SEAM(pb + 5); }
        if (PH_ON(6) && IN(pb + 6)) { for (int rep = 0; rep < REPS(6); ++rep) {
            gemm_run_t<1>(F, l);
            TAILC(24, tG1_lo, tG1_n);
            } SEAM(pb + 6);
        }
        if (PH_ON(7) && IN(pb + 7)) { for (int rep = 0; rep < REPS(7); ++rep) { gs_phase(F, l); } SEAM(pb + 7); }
        if (PH_ON(8) && IN(pb + 8)) { for (int rep = 0; rep < REPS(8); ++rep) {
            gemm_run_t<2>(F, l);
            TAILC(8, tG2_lo, tG2_n);
            if (g256 && ctx_on && bid >= 8 && bid < 40) { int b2 = bid; asm volatile("" : "+s"(b2)); f2_unit(F, 1, 480 + b2 - 8); }
            } SEAM(pb + 8);
        }
        if (PH_ON(9) && IN(pb + 9)) { for (int rep = 0; rep < REPS(9); ++rep) { e1_phase(F, l); } SEAM(pb + 9); }
        if (PH_ON(10) && IN(pb + 10)) { for (int rep = 0; rep < REPS(10); ++rep) { for (int u = bid; u < e2u; u += G) e2_unit(F, u & 31, u >= 32);
            if (bid >= e2u) { int b2 = bid; asm volatile("" : "+s"(b2)); conv_stream(F, 1, l, bgc2 + b2 - e2u, 8448, e2idle); } } SEAM(pb + 10); }
        if (PH_ON(11) && IN(pb + 11)) { for (int rep = 0; rep < REPS(11); ++rep) { e3_phase(F, l); } SEAM(pb + 11); }
        if (PH_ON(12) && IN(pb + 12)) { for (int rep = 0; rep < REPS(12); ++rep) {
            gemm_run_t<3>(F, l);
            if (l == 0 && g256 && (bid & 7) >= 3) { int b2 = bid; asm volatile("" : "+s"(b2)); __syncthreads(); for (int u = (b2 >> 3) * 5 + (b2 & 7) - 3; u < 480; u += 160) f2_unit(F, 1, u); }
#ifdef PROBE_GEMM_E
            gemm_run_t<6>(F, l);
#endif
            } SEAM(pb + 12);
        }
        if (PH_ON(13) && IN(pb + 13)) { for (int rep = 0; rep < REPS(13); ++rep) {
            gemm_run_t<4>(F, l);
#ifdef PROBE_GEMM_E
            gemm_run_t<7>(F, l);
#endif
            if (l == 0 && pre1 && (bid & 7) >= 2) { int b2 = bid; asm volatile("" : "+s"(b2)); conv_stream(F, 1, 1, (b2 >> 3) * 6 + (b2 & 7) - 2, pre1, (G >> 3) * 6); }
            } SEAM(pb + 13);
        }
        if (PH_ON(14) && IN(pb + 14)) { for (int rep = 0; rep < REPS(14); ++rep) { e6_phase(F, l); } SEAM(pb + 14); }
    }
#undef IN
#undef SEAM
}

extern "C" void kernel_launch(void* const* d_in, const int* in_sizes, int n_in, void* d_out, int out_size, void* d_ws, size_t ws_size, hipStream_t stream) {
    static int grid = 0;
    if (grid == 0) {
        if (n_in != 31 || out_size != RL * D || ws_size < WS_END) { fprintf(stderr, "kernel_launch: unexpected shapes (n_in %d out %d ws %zu need %zu)\n", n_in, out_size, ws_size, (size_t)WS_END); grid = -1; return; }
        int dev = 0, cus = 0, per_cu = 0;
        if (hipGetDevice(&dev) != hipSuccess || hipDeviceGetAttribute(&cus, hipDeviceAttributeMultiprocessorCount, dev) != hipSuccess) { grid = -1; return; }
        if (hipFuncSetAttribute((const void*)fwd_kernel, hipFuncAttributeMaxDynamicSharedMemorySize, LDS_BYTES) != hipSuccess) { fprintf(stderr, "kernel_launch: hipFuncSetAttribute failed\n"); grid = -1; return; }
        if (hipOccupancyMaxActiveBlocksPerMultiprocessor(&per_cu, (const void*)fwd_kernel, NT, LDS_BYTES) != hipSuccess || per_cu < 1) fprintf(stderr, "kernel_launch: occupancy query says %d\n", per_cu);
        (void)hipGetLastError();
        grid = cus;
    }
    if (grid < 0) return;
    (void)hipMemsetAsync((char*)d_ws + WS_CTL, 0, 16384, stream);
    KArgs a{};
    for (int i = 0; i < 31; ++i) a.in[i] = (const float*)d_in[i];
    a.out = (float*)d_out; a.ws = (unsigned char*)d_ws;
#if N_LAUNCH_MODE == 1
    a.ph_lo = 0; a.ph_hi = NPHASES;
    hipLaunchKernelGGL(fwd_kernel, dim3(grid), dim3(NT), LDS_BYTES, stream, a);
#else
    for (int ph = 0; ph < NPHASES; ++ph) { a.ph_lo = ph; a.ph_hi = ph + 1; hipLaunchKernelGGL(fwd_kernel, dim3(grid), dim3(NT), LDS_BYTES, stream, a); }
#endif
}
```
